# Optimizing an MI355X kernel written in HIP

```python
import jax, jax.numpy as jnp
from jax import lax
import numpy as np

D_MODEL = 1024
BATCH = 8
SEQ = 2048
DEPTH = 1

HGRN_HEADS = 4
HGRN_DK = 128
HGRN_DV = 128
HGRN_WIDTH = HGRN_HEADS * HGRN_DK
CHUNK = 64
ATTN_HEADS = 8
ATTN_KV_HEADS = 2
ATTN_GROUP = ATTN_HEADS // ATTN_KV_HEADS
ATTN_HD = 64
ATTN_WIDTH = ATTN_HEADS * ATTN_HD
KV_WIDTH = ATTN_KV_HEADS * ATTN_HD
WINDOW = 128
BLOCK = 128
MIX_WIDTH = HGRN_HEADS * HGRN_DV + ATTN_WIDTH
PROJ_WIDTH = 4 * HGRN_WIDTH + ATTN_WIDTH + 2 * KV_WIDTH
SPLITS = [HGRN_WIDTH, 2 * HGRN_WIDTH, 3 * HGRN_WIDTH, 4 * HGRN_WIDTH,
          4 * HGRN_WIDTH + ATTN_WIDTH, 4 * HGRN_WIDTH + ATTN_WIDTH + KV_WIDTH]
D_FF = -(-8 * D_MODEL // (3 * 256)) * 256
EPS = 1e-6
NEG_INF = -1e30

kernel_name = "hymba_hgrn2_swa_sink_block"


def rms_norm(x, gain):
    xf = x.astype(jnp.float32)
    y = xf * lax.rsqrt(jnp.mean(xf * xf, axis=-1, keepdims=True) + EPS)
    return (y * gain.astype(jnp.float32)).astype(x.dtype)


def hgrn2_mixer(q, f_logit, i, g, lb, out_gain):
    B, S, _ = q.shape
    f32 = jnp.float32
    lb = lb.astype(f32)
    q = jax.nn.silu(q.astype(f32)) * (HGRN_DK ** -0.5)
    f = lb + (1.0 - lb) * jax.nn.sigmoid(f_logit.astype(f32))
    k = 1.0 - f
    logf = jnp.log(f)
    v = i.astype(f32)
    nc = S // CHUNK

    def to_chunks(t, d):
        return t.reshape(B, nc, CHUNK, HGRN_HEADS, d).transpose(1, 0, 3, 2, 4)

    xs = (to_chunks(q, HGRN_DK), to_chunks(k, HGRN_DK), to_chunks(v, HGRN_DV), to_chunks(logf, HGRN_DK))
    causal = jnp.tril(jnp.ones((CHUNK, CHUNK), dtype=bool))[:, :, None]

    def step(state, inp):
        qb, kb, vb, gb = inp
        bcum = jnp.cumsum(gb, axis=2)
        diff = bcum[:, :, :, None, :] - bcum[:, :, None, :, :]
        decay = jnp.exp(jnp.where(causal, diff, NEG_INF))
        scores = jnp.einsum('bhtc,bhsc,bhtsc->bhts', qb, kb, decay)
        o_intra = jnp.einsum('bhts,bhsv->bhtv', scores, vb)
        o_inter = jnp.einsum('bhtc,bhcv->bhtv', qb * jnp.exp(bcum), state)
        btot = bcum[:, :, -1:, :]
        k_dec = kb * jnp.exp(btot - bcum)
        new_state = jnp.exp(btot[:, :, 0, :])[..., None] * state + jnp.einsum('bhsc,bhsv->bhcv', k_dec, vb)
        return new_state, o_intra + o_inter

    s0 = jnp.zeros((B, HGRN_HEADS, HGRN_DK, HGRN_DV), f32)
    _, o = lax.scan(step, s0, xs)
    o = o.transpose(1, 0, 3, 2, 4).reshape(B, S, HGRN_HEADS, HGRN_DV)
    o = rms_norm(o, out_gain).reshape(B, S, HGRN_HEADS * HGRN_DV)
    return o * jax.nn.silu(g.astype(f32))


def swa_sink_mixer(q, k, v, q_gain, k_gain, sinks):
    B, S, _ = q.shape
    f32 = jnp.float32
    q = rms_norm(q.astype(f32).reshape(B, S, ATTN_KV_HEADS, ATTN_GROUP, ATTN_HD), q_gain) * (ATTN_HD ** -0.5)
    k = rms_norm(k.astype(f32).reshape(B, S, ATTN_KV_HEADS, ATTN_HD), k_gain)
    v = v.astype(f32).reshape(B, S, ATTN_KV_HEADS, ATTN_HD)
    nb = S // BLOCK

    def band(t):
        prev = jnp.pad(t, ((0, 0), (BLOCK, 0), (0, 0), (0, 0)))[:, :S]
        cur_b = t.reshape(B, nb, BLOCK, ATTN_KV_HEADS, ATTN_HD)
        prev_b = prev.reshape(B, nb, BLOCK, ATTN_KV_HEADS, ATTN_HD)
        return jnp.concatenate([prev_b, cur_b], axis=2)

    kb, vb = band(k), band(v)
    qb = q.reshape(B, nb, BLOCK, ATTN_KV_HEADS, ATTN_GROUP, ATTN_HD)
    scores = jnp.einsum('bnqhgd,bnkhd->bnhgqk', qb, kb)
    n_idx = jnp.arange(nb)[:, None, None]
    qpos = n_idx * BLOCK + jnp.arange(BLOCK)[None, :, None]
    kpos = n_idx * BLOCK - BLOCK + jnp.arange(2 * BLOCK)[None, None, :]
    rel = qpos - kpos
    mask = (rel >= 0) & (rel < WINDOW) & (kpos >= 0)
    scores = jnp.where(mask[None, :, None, None], scores, NEG_INF)
    s = sinks.astype(f32).reshape(ATTN_KV_HEADS, ATTN_GROUP)[None, None, :, :, None, None]
    m = jnp.maximum(jnp.max(scores, axis=-1, keepdims=True), s)
    p = jnp.exp(scores - m)
    denom = jnp.sum(p, axis=-1, keepdims=True) + jnp.exp(s - m)
    out = jnp.einsum('bnhgqk,bnkhd->bnqhgd', p / denom, vb)
    return out.reshape(B, S, ATTN_WIDTH)


def setup_inputs(seed: int = 0) -> dict:
    key = jax.random.key(seed)
    ks = jax.random.split(key, 14)
    f32 = jnp.float32
    nrm = lambda k, shape, scale: jax.random.normal(k, shape, f32) * scale
    return {
        "x": jax.random.normal(ks[0], (BATCH, SEQ, D_MODEL), f32),
        "norm1_gain": 1.0 + nrm(ks[1], (DEPTH, D_MODEL), 0.02),
        "w_in": nrm(ks[2], (DEPTH, D_MODEL, PROJ_WIDTH), D_MODEL ** -0.5),
        "hgrn_lb_logits": nrm(ks[3], (DEPTH + 1, HGRN_WIDTH), 0.5),
        "hgrn_out_gain": 1.0 + nrm(ks[4], (DEPTH, HGRN_DV), 0.02),
        "q_norm_gain": 1.0 + nrm(ks[5], (DEPTH, ATTN_HD), 0.02),
        "k_norm_gain": 1.0 + nrm(ks[6], (DEPTH, ATTN_HD), 0.02),
        "attn_sinks": nrm(ks[7], (DEPTH, ATTN_HEADS), 0.5),
        "w_out": nrm(ks[8], (DEPTH, MIX_WIDTH, D_MODEL), MIX_WIDTH ** -0.5),
        "norm2_gain": 1.0 + nrm(ks[9], (DEPTH, D_MODEL), 0.02),
        "w_ffn_gate": nrm(ks[10], (DEPTH, D_MODEL, D_FF), D_MODEL ** -0.5),
        "w_ffn_up": nrm(ks[11], (DEPTH, D_MODEL, D_FF), D_MODEL ** -0.5),
        "w_ffn_down": nrm(ks[12], (DEPTH, D_FF, D_MODEL), D_FF ** -0.5),
    }


def reference(x, norm1_gain, w_in, hgrn_lb_logits, hgrn_out_gain, q_norm_gain, k_norm_gain,
              attn_sinks, w_out, norm2_gain, w_ffn_gate, w_ffn_up, w_ffn_down):
    h = x
    lb_all = jnp.cumsum(jax.nn.softmax(hgrn_lb_logits.astype(jnp.float32), axis=0), axis=0)
    for l in range(DEPTH):
        u = rms_norm(h, norm1_gain[l])
        proj = u @ w_in[l]
        hq, hf, hi, hg, aq, ak, av = jnp.split(proj, SPLITS, axis=-1)
        o_rec = hgrn2_mixer(hq, hf, hi, hg, lb_all[l], hgrn_out_gain[l])
        o_att = swa_sink_mixer(aq, ak, av, q_norm_gain[l], k_norm_gain[l], attn_sinks[l])
        mixed = jnp.concatenate([o_rec, o_att], axis=-1).astype(h.dtype)
        h = h + mixed @ w_out[l]
        u = rms_norm(h, norm2_gain[l])
        h = h + (jax.nn.silu(u @ w_ffn_gate[l]) * (u @ w_ffn_up[l])) @ w_ffn_down[l]
    return h
```

```cpp
#include <hip/hip_runtime.h>
#include <hip/hip_cooperative_groups.h>
#include <cstdio>
#include <cstdint>
namespace cg = cooperative_groups;
namespace pg8 {
#define PG8_LAS __attribute__((address_space(3)))
typedef unsigned short bf16_t;
typedef short bf16x8 __attribute__((ext_vector_type(8)));
typedef float f32x4 __attribute__((ext_vector_type(4)));
typedef unsigned u32x4 __attribute__((ext_vector_type(4)));
constexpr int BM = 256, BK = 64, HALF = 128, HTB = HALF * BK * 2  , STAGE_BYTES = 8 * HTB, NXCD = 8, WGM = 8;

__host__ __device__ __forceinline__ int lds_byte(int r, int c) { const int st = (r >> 4) * 2 + (c >> 5), rr = r & 15, cc = c & 31, ob = rr * 64 + cc * 2; return st * 1024 + (ob ^ (((ob >> 9) & 1) << 5)); }
__host__ __device__ __forceinline__ void stage_rc(int b, int& R, int& C) { const int st = b / 1024, sb = b % 1024, swz = sb ^ (((sb >> 9) & 1) << 5); R = (st >> 1) * 16 + swz / 64; C = (st & 1) * 32 + (swz % 64) / 2; }
__host__ __device__ __forceinline__ int perm32(int rho) { const int n = rho >> 4, i = rho & 15; return 8 * (i >> 2) + 4 * n + (i & 3); }

struct Unit { int pm, pn; };
struct Gemm { const bf16_t* A; const bf16_t* Bt; int M, N, K; };

struct StaticOrder {
    int nM, nN, nwg, G, c;
    __host__ __device__ void init(int M, int N, int G_, int c_) { nM = M / BM; nN = N / BM; nwg = nM * nN; G = G_; c = c_; }
    __host__ __device__ bool next(int i, Unit& u) const {
        const long L = (long)i * G + c; if (L >= nwg) return false;
        int wgid = (int)L; { const int q = nwg / NXCD, r = nwg % NXCD, xcd = wgid % NXCD, off = wgid / NXCD; wgid = (xcd < r ? xcd * (q + 1) : r * (q + 1) + (xcd - r) * q) + off; }
        const int nig = WGM * nN, gid = wgid / nig, fm = gid * WGM, gsz = (nM - fm) < WGM ? (nM - fm) : WGM;
        u.pm = fm + ((wgid % nig) % gsz); u.pn = (wgid % nig) / gsz; return true;
    }
    __device__ __forceinline__ void a_ready(const Unit&) const {}
    __device__ __forceinline__ void done(const Unit&) const {}
};

typedef float f32x2 __attribute__((ext_vector_type(2)));
__device__ __forceinline__ unsigned cvt_pk_bf16(float lo, float hi) { unsigned r; asm volatile("v_cvt_pk_bf16_f32 %0, %1, %2" : "=v"(r) : "v"(lo), "v"(hi)); return r; }
typedef __bf16 nbf16x2 __attribute__((ext_vector_type(2)));
__device__ __forceinline__ unsigned cvt_pk_native(float lo, float hi) { f32x2 v = {lo, hi}; return __builtin_bit_cast(unsigned, __builtin_convertvector(v, nbf16x2)); }
typedef float f32x2 __attribute__((ext_vector_type(2)));
template <class Epi, class Sched, bool ALIGN_EPI = false, bool SP2 = false>
__device__ __forceinline__ void gemm_phase(PG8_LAS unsigned char* lds, const Gemm g, const Sched& S, const Epi& E) {
    const int tid = threadIdx.x, wid = __builtin_amdgcn_readfirstlane(tid >> 6), lane = tid & 63, wr = wid >> 2, wc = wid & 3, fr = lane & 15, fq = lane >> 4;
    const int K = g.K, nt = K / BK;
    unsigned voffA[2], voffB[2];
#pragma unroll
    for (int i = 0; i < 2; ++i) { int R, C; stage_rc(tid * 16 + i * 8192, R, C); const int Rb = Epi::PERM ? ((R & ~31) + perm32(R & 31)) : R;
        voffA[i] = (unsigned)(R * K + C) * 2u; voffB[i] = (unsigned)(Rb * K + C) * 2u; }
    const size_t kstep = (size_t)(BK * 2);
    const size_t hstep = (size_t)HALF * K * 2;
    const size_t tstep = 2 * hstep;
    const unsigned ldsw = (unsigned)wid * 1024u;
    const int aoff = lds_byte(wr * 64 + fr, fq * 8), boff = lds_byte(wc * 32 + fr, fq * 8);
#define PG8_SA(b, h) (((b) * 2 + (h)) * HTB)
#define PG8_SB(b, h) ((4 + (b) * 2 + (h)) * HTB)
#define PG8_STAGE(bufoff, gbase, voff) do { _Pragma("unroll") for (int _i = 0; _i < 2; ++_i) \
        __builtin_amdgcn_global_load_lds((const unsigned*)((const char*)(gbase) + (voff)[_i]), (PG8_LAS unsigned*)(lds + (bufoff) + ldsw + _i * 8192), 16, 0, 0); } while (0)
#define PG8_LDA(dst, b, h) do { _Pragma("unroll") for (int m = 0; m < 4; ++m) _Pragma("unroll") for (int k = 0; k < 2; ++k) dst[m][k] = *(const PG8_LAS bf16x8*)(lds + PG8_SA(b, h) + aoff + m * 2048 + k * 1024); } while (0)
#define PG8_LDB(dst, b, h) do { _Pragma("unroll") for (int n = 0; n < 2; ++n) _Pragma("unroll") for (int k = 0; k < 2; ++k) dst[n][k] = *(const PG8_LAS bf16x8*)(lds + PG8_SB(b, h) + boff + n * 2048 + k * 1024); } while (0)
#define PG8_MMA(ai, bj, At, Bt) do { __builtin_amdgcn_s_setprio(1); _Pragma("unroll") for (int m = 0; m < 4; ++m) _Pragma("unroll") for (int n = 0; n < 2; ++n) _Pragma("unroll") for (int k = 0; k < 2; ++k) \
        acc[ai][bj][m][n] = __builtin_amdgcn_mfma_f32_16x16x32_bf16(Bt[n][k], At[m][k], acc[ai][bj][m][n], 0, 0, 0); __builtin_amdgcn_s_setprio(0); } while (0)
#define PG8_WAIT_V(n) asm volatile("s_waitcnt vmcnt(" #n ")" ::: "memory")
#define PG8_WAIT_L(n) asm volatile("s_waitcnt lgkmcnt(" #n ")" ::: "memory")
#define PG8_BAR __builtin_amdgcn_s_barrier()
#define PG8_SCHED __builtin_amdgcn_sched_barrier(0)
    Unit cur, nxt; int ui = 0;
    if (!S.next(0, cur)) return;
    f32x4 acc[2][2][4][2];
#pragma unroll
    for (int a = 0; a < 2; ++a)
#pragma unroll
        for (int b = 0; b < 2; ++b)
#pragma unroll
            for (int m = 0; m < 4; ++m)
#pragma unroll
                for (int n = 0; n < 2; ++n) acc[a][b][m][n] = (f32x4){0.f, 0.f, 0.f, 0.f};
    bf16x8 At[4][2], B0[2][2], B1[2][2];
    const char* cA = (const char*)g.A + (size_t)cur.pm * tstep; const char* cB = (const char*)g.Bt + (size_t)cur.pn * tstep;
    S.a_ready(cur);
    if constexpr (SP2) {
        PG8_STAGE(PG8_SB(0, 0), cB, voffB); PG8_STAGE(PG8_SB(0, 1), cB + hstep, voffB); PG8_STAGE(PG8_SA(0, 0), cA, voffA); PG8_STAGE(PG8_SA(0, 1), cA + hstep, voffA);
        if (wr == 1) PG8_BAR;
        PG8_WAIT_V(2); PG8_BAR;
        PG8_STAGE(PG8_SB(1, 0), cB + kstep, voffB); PG8_STAGE(PG8_SA(1, 0), cA + kstep, voffA); PG8_STAGE(PG8_SB(1, 1), cB + hstep + kstep, voffB);
        PG8_WAIT_V(6); PG8_BAR;
    } else {
        PG8_STAGE(PG8_SB(0, 0), cB, voffB); PG8_STAGE(PG8_SA(0, 0), cA, voffA); PG8_STAGE(PG8_SB(0, 1), cB + hstep, voffB); PG8_STAGE(PG8_SA(0, 1), cA + hstep, voffA);
        if (wr == 1) PG8_BAR;
        PG8_WAIT_V(4); PG8_BAR;
        PG8_STAGE(PG8_SB(1, 0), cB + kstep, voffB); PG8_STAGE(PG8_SA(1, 0), cA + kstep, voffA); PG8_STAGE(PG8_SB(1, 1), cB + hstep + kstep, voffB);
        PG8_WAIT_V(6); PG8_BAR;
    }
    for (;;) {
        const bool has_next = S.next(ui + 1, nxt);
        const char* nA = has_next ? (const char*)g.A + (size_t)nxt.pm * tstep : cA; const char* nB = has_next ? (const char*)g.Bt + (size_t)nxt.pn * tstep : cB;
        for (int t = 0; t < nt; t += 2) {
            const bool last = (t == nt - 2);
            const char* a1 = cA + (size_t)(t + 1) * kstep;
            const char* a2 = last ? nA : cA + (size_t)(t + 2) * kstep; const char* b2 = last ? nB : cB + (size_t)(t + 2) * kstep;
            const char* a3 = a2 + kstep; const char* b3 = b2 + kstep;
            if (last && has_next) S.a_ready(nxt);
            if constexpr (SP2) {
            PG8_LDB(B0, 0, 0); PG8_LDB(B1, 0, 1); PG8_SCHED; PG8_LDA(At, 0, 0); PG8_STAGE(PG8_SA(1, 1), a1 + hstep, voffA);
            PG8_WAIT_V(8); PG8_WAIT_L(0); PG8_BAR; PG8_MMA(0, 0, At, B0); PG8_MMA(0, 1, At, B1); PG8_BAR; PG8_SCHED;
            PG8_LDA(At, 0, 1); PG8_STAGE(PG8_SB(0, 0), b2, voffB); PG8_STAGE(PG8_SB(0, 1), b2 + hstep, voffB); PG8_STAGE(PG8_SA(0, 0), a2, voffA);
            PG8_WAIT_V(8); PG8_WAIT_L(0); PG8_BAR; PG8_MMA(1, 0, At, B0); PG8_MMA(1, 1, At, B1); PG8_BAR; PG8_SCHED;
            PG8_LDB(B0, 1, 0); PG8_LDB(B1, 1, 1); PG8_SCHED; PG8_LDA(At, 1, 0); PG8_STAGE(PG8_SA(0, 1), a2 + hstep, voffA);
            PG8_WAIT_V(8); PG8_WAIT_L(0); PG8_BAR; PG8_MMA(0, 0, At, B0); PG8_MMA(0, 1, At, B1); PG8_BAR; PG8_SCHED;
            PG8_LDA(At, 1, 1); PG8_STAGE(PG8_SB(1, 0), b3, voffB); PG8_STAGE(PG8_SB(1, 1), b3 + hstep, voffB); PG8_STAGE(PG8_SA(1, 0), a3, voffA);
            PG8_WAIT_V(8); PG8_WAIT_L(0); PG8_BAR; PG8_MMA(1, 0, At, B0); PG8_MMA(1, 1, At, B1); PG8_BAR; PG8_SCHED;
            } else {
            PG8_LDB(B0, 0, 0); PG8_SCHED; PG8_LDA(At, 0, 0); PG8_STAGE(PG8_SA(1, 1), a1 + hstep, voffA);
            PG8_WAIT_L(8); PG8_BAR; PG8_WAIT_L(0); PG8_MMA(0, 0, At, B0); PG8_BAR; PG8_SCHED;
            PG8_LDB(B1, 0, 1); PG8_STAGE(PG8_SB(0, 0), b2, voffB);
            PG8_BAR; PG8_WAIT_L(0); PG8_MMA(0, 1, At, B1); PG8_BAR;
            PG8_LDA(At, 0, 1); PG8_STAGE(PG8_SA(0, 0), a2, voffA);
            PG8_BAR; PG8_WAIT_L(0); PG8_MMA(1, 0, At, B0); PG8_BAR; PG8_SCHED;
            PG8_STAGE(PG8_SB(0, 1), b2 + hstep, voffB);
            PG8_WAIT_V(6); PG8_BAR; PG8_MMA(1, 1, At, B1); PG8_BAR;
            PG8_LDB(B0, 1, 0); PG8_SCHED; PG8_LDA(At, 1, 0); PG8_STAGE(PG8_SA(0, 1), a2 + hstep, voffA);
            PG8_WAIT_L(8); PG8_BAR; PG8_WAIT_L(0); PG8_MMA(0, 0, At, B0); PG8_BAR; PG8_SCHED;
            PG8_LDB(B1, 1, 1); PG8_STAGE(PG8_SB(1, 0), b3, voffB);
            PG8_BAR; PG8_WAIT_L(0); PG8_MMA(0, 1, At, B1); PG8_BAR;
            PG8_LDA(At, 1, 1); PG8_STAGE(PG8_SA(1, 0), a3, voffA);
            PG8_BAR; PG8_WAIT_L(0); PG8_MMA(1, 0, At, B0); PG8_BAR; PG8_SCHED;
            PG8_STAGE(PG8_SB(1, 1), b3 + hstep, voffB);
            PG8_WAIT_V(6); PG8_BAR; PG8_MMA(1, 1, At, B1); PG8_BAR;
            }
        }
        if constexpr (ALIGN_EPI) { if (wr == 0) PG8_BAR; }
        if constexpr (!Epi::AFTER_DRAIN) { E(acc, cur, wr, wc, fr, fq); S.done(cur); }
        if (!has_next) break;
#pragma unroll
        for (int a = 0; a < 2; ++a)
#pragma unroll
            for (int b = 0; b < 2; ++b)
#pragma unroll
                for (int m = 0; m < 4; ++m)
#pragma unroll
                    for (int n = 0; n < 2; ++n) acc[a][b][m][n] = (f32x4){0.f, 0.f, 0.f, 0.f};
        cur = nxt; cA = nA; cB = nB; ++ui;
        if constexpr (ALIGN_EPI) { if (wr == 1) PG8_BAR; }
    }
    PG8_WAIT_V(0);
    if constexpr (!ALIGN_EPI) { if (wr == 0) PG8_BAR; }
    PG8_BAR;
    if constexpr (Epi::AFTER_DRAIN) { E.fused(acc, cur, wr, wc, fr, fq, lds, wid, lane); S.done(cur); }
#undef PG8_SA
#undef PG8_SB
#undef PG8_STAGE
#undef PG8_LDA
#undef PG8_LDB
#undef PG8_MMA
#undef PG8_WAIT_V
#undef PG8_WAIT_L
#undef PG8_BAR
#undef PG8_SCHED
}
}

#define GAS __attribute__((address_space(1)))
#define LAS __attribute__((address_space(3)))
typedef unsigned short bf16;
typedef unsigned v4u __attribute__((ext_vector_type(4)));
typedef unsigned v2u __attribute__((ext_vector_type(2)));
typedef float f32x4 __attribute__((ext_vector_type(4)));
typedef short bf16x8 __attribute__((ext_vector_type(8)));
typedef short bf16x4 __attribute__((ext_vector_type(4)));

constexpr int NWAVES = 8;
constexpr int NB = 8, SEQ = 2048, D = 1024, M = NB * SEQ;
constexpr int PW = 2816, FF = 2816, NGU = 2 * FF;
constexpr int HH = 4, DK = 128, DV = 128, HW = 512;
constexpr int AH = 8, KVH = 2, AG = 4, HD = 64;
constexpr int C_Q = 0, C_F = 512, C_I = 1024, C_G = 1536, C_AQ = 2048, C_AK = 2560, C_AV = 2688;
constexpr float EPS = 1e-6f;

constexpr size_t MiB = 1u << 20;
constexpr size_t WS_CTL = 0;
constexpr size_t WS_WIN = 2 * MiB, WS_WOUT = 8 * MiB, WS_WGU = 10 * MiB, WS_WDN = 21 * MiB;
constexpr size_t WS_RSTD1 = 27 * MiB, WS_PART = 28 * MiB, WS_DTOT = 29 * MiB;
constexpr size_t WS_XB = 32 * MiB;
constexpr size_t WS_OLOC = 184 * MiB;
constexpr size_t WS_PROJ = 64 * MiB;
constexpr size_t WS_ACT = 64 * MiB;
constexpr size_t WS_MIXED = 152 * MiB;
constexpr size_t WS_HB = 184 * MiB;
constexpr size_t WS_LBUF = 216 * MiB;
constexpr size_t WS_QDS = 232 * MiB;
constexpr size_t WS_END = 256 * MiB;

constexpr int LDS_BYTES = 147456;

#define LDS_WAIT() asm volatile("s_waitcnt lgkmcnt(0)" ::: "memory")
#define VM_WAIT() asm volatile("s_waitcnt vmcnt(0)" ::: "memory")
__device__ __forceinline__ unsigned f2bf(float f) { unsigned u = __builtin_bit_cast(unsigned, f); return (u + 0x7fffu + ((u >> 16) & 1u)) >> 16; }
__device__ __forceinline__ unsigned pk2(float lo, float hi) { return f2bf(lo) | (f2bf(hi) << 16); }
__device__ __forceinline__ float bf2f(unsigned short b) { return __builtin_bit_cast(float, (unsigned)b << 16); }
__device__ __forceinline__ float bflo(unsigned w) { return __builtin_bit_cast(float, w << 16); }
__device__ __forceinline__ float bfhi(unsigned w) { return __builtin_bit_cast(float, w & 0xffff0000u); }
__device__ __forceinline__ float wave_sum(float v) {
#pragma unroll
    for (int o = 1; o < 64; o <<= 1) v += __shfl_xor(v, o);
    return v;
}
__device__ __forceinline__ float silu_f(float v) { return v / (1.0f + __expf(-v)); }

struct Frame {
    LAS unsigned char* lds;
    int tid, lane, wave, G;
    const float *x, *g1, *w_in, *lbl, *ogain, *qg, *kg, *sinks, *w_out, *g2, *w_gate, *w_up, *w_down;
    float* out;
    bf16 *WIN, *WOUT, *WGU, *WDN, *XB, *PROJ, *ACT, *MIXED, *HB, *QDS;
    float *RSTD1, *PART, *DTOT, *OLOC, *LBUF;
};

namespace pg8 {
struct EpiProj {
    static constexpr bool PERM = true, AFTER_DRAIN = false;
    bf16_t* O; const float* rstd; const float* lbl;
    __device__ __forceinline__ void operator()(const f32x4 (&acc)[2][2][4][2], const Unit& u, int wr, int wc, int fr, int fq) const {
        const int row0 = u.pm * BM + wr * 64 + fr;
#pragma unroll
        for (int bj = 0; bj < 2; ++bj) {
            const int col0 = u.pn * BM + bj * HALF + wc * 32 + 8 * fq;
            const int seg = __builtin_amdgcn_readfirstlane(col0 >> 9);
            float lb[8];
            { const int ci = col0 & 511;
#pragma unroll
              for (int i = 0; i < 8; ++i) { const float l0 = lbl[ci + i], l1 = lbl[512 + ci + i]; lb[i] = __builtin_amdgcn_rcpf(1.0f + __expf(l1 - l0)); } }
#pragma unroll
            for (int ai = 0; ai < 2; ++ai)
#pragma unroll
                for (int m = 0; m < 4; ++m) {
                    const int row = row0 + ai * HALF + m * 16; const float rs = rstd[row];
                    float v[8];
#pragma unroll
                    for (int i = 0; i < 4; ++i) { v[i] = acc[ai][bj][m][0][i] * rs; v[4 + i] = acc[ai][bj][m][1][i] * rs; }
                    if (seg == 0) {
#pragma unroll
                        for (int i = 0; i < 8; ++i) v[i] = v[i] * __builtin_amdgcn_rcpf(1.0f + __expf(-v[i])) * 0.08838834764831845f;
                    } else if (seg == 1) {
#pragma unroll
                        for (int i = 0; i < 8; ++i) { const float s = __builtin_amdgcn_rcpf(1.0f + __expf(-v[i])); v[i] = __logf(lb[i] + (1.0f - lb[i]) * s); }
                    } else if (seg == 3) {
#pragma unroll
                        for (int i = 0; i < 8; ++i) v[i] = v[i] * __builtin_amdgcn_rcpf(1.0f + __expf(-v[i]));
                    }
                    u32x4 w; w.x = cvt_pk_bf16(v[0], v[1]); w.y = cvt_pk_bf16(v[2], v[3]); w.z = cvt_pk_bf16(v[4], v[5]); w.w = cvt_pk_bf16(v[6], v[7]);
                    *(u32x4*)(O + (size_t)row * 2816 + col0) = w;
                }
        }
    }
};
struct EpiOut {
    static constexpr bool PERM = true, AFTER_DRAIN = false;
    const bf16_t* x; float* out; bf16_t* hb; float* part;
    __device__ __forceinline__ void operator()(const f32x4 (&acc)[2][2][4][2], const Unit& u, int wr, int wc, int fr, int fq) const {
        const int row0 = u.pm * BM + wr * 64 + fr;
#pragma unroll
        for (int ai = 0; ai < 2; ++ai)
#pragma unroll
            for (int m = 0; m < 4; ++m) {
                const int row = row0 + ai * HALF + m * 16; float ss = 0.f;
#pragma unroll
                for (int bj = 0; bj < 2; ++bj) {
                    const size_t off = (size_t)row * 1024 + u.pn * BM + bj * HALF + wc * 32 + 8 * fq;
                    const u32x4 xw = *(const u32x4*)(x + off);
                    f32x4 x0, x1;
                    x0[0] = __builtin_bit_cast(float, xw.x << 16); x0[1] = __builtin_bit_cast(float, xw.x & 0xffff0000u); x0[2] = __builtin_bit_cast(float, xw.y << 16); x0[3] = __builtin_bit_cast(float, xw.y & 0xffff0000u);
                    x1[0] = __builtin_bit_cast(float, xw.z << 16); x1[1] = __builtin_bit_cast(float, xw.z & 0xffff0000u); x1[2] = __builtin_bit_cast(float, xw.w << 16); x1[3] = __builtin_bit_cast(float, xw.w & 0xffff0000u);
                    const f32x4 h0 = x0 + acc[ai][bj][m][0], h1 = x1 + acc[ai][bj][m][1];
                    u32x4 w; w.x = cvt_pk_bf16(h0[0], h0[1]); w.y = cvt_pk_bf16(h0[2], h0[3]); w.z = cvt_pk_bf16(h1[0], h1[1]); w.w = cvt_pk_bf16(h1[2], h1[3]);
                    *(u32x4*)(hb + off) = w;
                    ss += ((h0[0] * h0[0] + h0[1] * h0[1]) + (h0[2] * h0[2] + h0[3] * h0[3])) + ((h1[0] * h1[0] + h1[1] * h1[1]) + (h1[2] * h1[2] + h1[3] * h1[3]));
                }
                ss += __shfl_xor(ss, 16); ss += __shfl_xor(ss, 32);
                if (fq == 0) part[(size_t)row * 16 + u.pn * 4 + wc] = ss;
            }
    }
};
struct EpiGU {
    static constexpr bool PERM = true, AFTER_DRAIN = false;
    bf16_t* O; const float* part;
    __device__ __forceinline__ void operator()(const f32x4 (&acc)[2][2][4][2], const Unit& u, int wr, int wc, int fr, int fq) const {
        const int row0 = u.pm * BM + wr * 64 + fr;
#pragma unroll
        for (int ai = 0; ai < 2; ++ai)
#pragma unroll
            for (int m = 0; m < 4; ++m) {
                const int row = row0 + ai * HALF + m * 16;
                const f32x4* pp = (const f32x4*)(part + (size_t)row * 16);
                const f32x4 p0 = pp[0], p1 = pp[1], p2 = pp[2], p3 = pp[3];
                const float ssq = ((p0[0] + p0[1]) + (p0[2] + p0[3])) + ((p1[0] + p1[1]) + (p1[2] + p1[3])) + ((p2[0] + p2[1]) + (p2[2] + p2[3])) + ((p3[0] + p3[1]) + (p3[2] + p3[3]));
                const float rs = __builtin_amdgcn_rsqf(ssq * (1.0f / 1024.0f) + 1e-6f);
                const float c1 = rs * -1.4426950408889634f, rs2 = rs * rs;
                float v[8];
#pragma unroll
                for (int n = 0; n < 2; ++n)
#pragma unroll
                    for (int i = 0; i < 4; ++i) { const float g = acc[ai][0][m][n][i], up = acc[ai][1][m][n][i];
                        v[4 * n + i] = (g * up) * (rs2 * __builtin_amdgcn_rcpf(1.0f + __builtin_amdgcn_exp2f(g * c1))); }
                u32x4 w; w.x = cvt_pk_bf16(v[0], v[1]); w.y = cvt_pk_bf16(v[2], v[3]); w.z = cvt_pk_bf16(v[4], v[5]); w.w = cvt_pk_bf16(v[6], v[7]);
                *(u32x4*)(O + (size_t)row * 2816 + u.pn * HALF + wc * 32 + 8 * fq) = w;
            }
    }
};
struct EpiDown {
    static constexpr bool PERM = true, AFTER_DRAIN = false;
    float* out; const bf16_t* hb;
    __device__ __forceinline__ void operator()(const f32x4 (&acc)[2][2][4][2], const Unit& u, int wr, int wc, int fr, int fq) const {
        const int row0 = u.pm * BM + wr * 64 + fr;
#pragma unroll
        for (int ai = 0; ai < 2; ++ai)
#pragma unroll
            for (int m = 0; m < 4; ++m) {
                const int row = row0 + ai * HALF + m * 16;
#pragma unroll
                for (int bj = 0; bj < 2; ++bj) {
                    const size_t off = (size_t)row * 1024 + u.pn * BM + bj * HALF + wc * 32 + 8 * fq;
                    const u32x4 hw = *(const u32x4*)(hb + off);
                    f32x4 h0, h1;
                    h0[0] = __builtin_bit_cast(float, hw.x << 16); h0[1] = __builtin_bit_cast(float, hw.x & 0xffff0000u); h0[2] = __builtin_bit_cast(float, hw.y << 16); h0[3] = __builtin_bit_cast(float, hw.y & 0xffff0000u);
                    h1[0] = __builtin_bit_cast(float, hw.z << 16); h1[1] = __builtin_bit_cast(float, hw.z & 0xffff0000u); h1[2] = __builtin_bit_cast(float, hw.w << 16); h1[3] = __builtin_bit_cast(float, hw.w & 0xffff0000u);
                    __builtin_nontemporal_store(h0 + acc[ai][bj][m][0], (f32x4*)(out + off));
                    __builtin_nontemporal_store(h1 + acc[ai][bj][m][1], (f32x4*)(out + off + 4));
                }
            }
    }
};
}

__device__ __forceinline__ void p0_transpose_item(const float* W, int K, int N, bf16* WT, const float* gain, int mode, LAS float* scr, int item, int lane) {
    const int nblk = N / 32, kb = item / nblk, nb = item % nblk, k0 = 64 * kb, n0 = 32 * nb;
#pragma unroll 8
    for (int i = 0; i < 32; ++i) { const int kk = 2 * i + (lane >> 5); scr[kk * 33 + (lane & 31)] = __builtin_nontemporal_load(W + (size_t)(k0 + kk) * N + n0 + (lane & 31)); }
    LDS_WAIT(); asm volatile("" ::: "memory");
    const int c = lane & 7;
    float g[8];
#pragma unroll
    for (int i = 0; i < 8; ++i) g[i] = gain ? gain[k0 + 8 * c + i] : 1.0f;
    const int rbase = (mode == 0) ? n0 : (256 * (n0 >> 7) + (n0 & 127) + (mode == 2 ? 128 : 0));
#pragma unroll
    for (int j = 0; j < 4; ++j) { const int n = (lane >> 3) + 8 * j; const LAS float* s = scr + (8 * c) * 33 + n;
        v4u o; o.x = pk2(s[0 * 33] * g[0], s[1 * 33] * g[1]); o.y = pk2(s[2 * 33] * g[2], s[3 * 33] * g[3]); o.z = pk2(s[4 * 33] * g[4], s[5 * 33] * g[5]); o.w = pk2(s[6 * 33] * g[6], s[7 * 33] * g[7]);
        *(GAS v4u*)(WT + (size_t)(rbase + n) * K + k0 + 8 * c) = o; }
    LDS_WAIT(); asm volatile("" ::: "memory");
}
__device__ __forceinline__ void p0_weights_late(Frame& F, int first_block, int which) {
    int wv = threadIdx.x >> 6, ln = threadIdx.x & 63;
    asm volatile("" : "+v"(wv), "+v"(ln));
    wv = __builtin_amdgcn_readfirstlane(wv);
    LAS float* scr = (LAS float*)(F.lds + wv * 16384);
    const int gw = (blockIdx.x - first_block) * NWAVES + wv, NGW = (F.G - first_block) * NWAVES;
    constexpr int I_OUT = (D / 64) * (D / 32), I_G = (D / 64) * (FF / 32), I_DN = (FF / 64) * (D / 32);
    if (which == 0) {
        for (int it = gw; it < I_OUT + 2 * I_G; it += NGW) {
            int r = it;
            if (r < I_OUT) { p0_transpose_item(F.w_out, D, D, F.WOUT, nullptr, 0, scr, r, ln); continue; } r -= I_OUT;
            if (r < I_G) { p0_transpose_item(F.w_gate, D, FF, F.WGU, F.g2, 1, scr, r, ln); continue; } r -= I_G;
            p0_transpose_item(F.w_up, D, FF, F.WGU, F.g2, 2, scr, r, ln);
        }
    } else {
        for (int it = gw; it < I_DN; it += NGW) p0_transpose_item(F.w_down, FF, D, F.WDN, nullptr, 0, scr, it, ln);
    }
}
__device__ __forceinline__ void p0_prologue(Frame& F) {
    LAS float* scr = (LAS float*)(F.lds + F.wave * 16384);
    const int gw = blockIdx.x * NWAVES + F.wave, NGW = F.G * NWAVES;
    constexpr int I_IN = (D / 64) * (PW / 32);
    for (int it = gw; it < I_IN; it += NGW) p0_transpose_item(F.w_in, D, PW, F.WIN, F.g1, 0, scr, it, F.lane);
    for (int m = gw; m < M; m += NGW) {
        const GAS f32x4* xr = (const GAS f32x4*)(F.x + (size_t)m * D) + F.lane;
        f32x4 v[4]; float s = 0.f;
#pragma unroll
        for (int j = 0; j < 4; ++j) { v[j] = __builtin_nontemporal_load(xr + 64 * j); s += (v[j].x * v[j].x + v[j].y * v[j].y) + (v[j].z * v[j].z + v[j].w * v[j].w); }
        s = wave_sum(s);
        if (F.lane == 0) F.RSTD1[m] = 1.0f / sqrtf(s * (1.0f / D) + EPS);
        GAS unsigned long long* o8 = (GAS unsigned long long*)(F.XB + (size_t)m * D) + F.lane;
#pragma unroll
        for (int j = 0; j < 4; ++j) o8[64 * j] = (unsigned long long)pk2(v[j].x, v[j].y) | ((unsigned long long)pk2(v[j].z, v[j].w) << 32);
    }
}

#define XB_TMO      128
#define XB_XCNT(j)  (256  + 64 * (j))
#define XB_XSUB(j)  (1280 + 64 * (j))
#define XB_XGEN(j)  (2304 + 64 * (j))
#define XB_TOP      3328
#define XB_TOPGEN   3392
#define XCD_BAR_WORDS 3456
#define XB_SPIN_CAP (1u << 18)

__device__ __forceinline__ unsigned xb_ld(unsigned* p)              { return __hip_atomic_load(p, __ATOMIC_RELAXED, __HIP_MEMORY_SCOPE_AGENT); }
__device__ __forceinline__ unsigned xb_add(unsigned* p, unsigned v) { return __hip_atomic_fetch_add(p, v, __ATOMIC_RELAXED, __HIP_MEMORY_SCOPE_AGENT); }
__device__ __forceinline__ unsigned xb_xcc_id() { return (unsigned)__builtin_amdgcn_s_getreg((3 << 11) | 20) & 0xFu; }
#define XB_SPIN(cond, bar) do { unsigned _sp = 0; while (cond) { __builtin_amdgcn_s_sleep(1); \
    if ((++_sp & 255u) == 0u) { if (xb_ld(&(bar)[XB_TMO])) break; if (_sp > XB_SPIN_CAP) { atomicAdd(&(bar)[XB_TMO], 1u); break; } } } } while (0)

struct XcdBarrier {
    unsigned* bar; unsigned x;
    volatile LAS unsigned* st;
};

__device__ __forceinline__ XcdBarrier xcd_barrier_post(unsigned* bar, volatile LAS unsigned* st) {
    XcdBarrier b; b.bar = bar; b.x = xb_xcc_id(); b.st = st;
    if (threadIdx.x == 0) (void)xb_add(&bar[XB_XCNT(b.x)], 1u);
    return b;
}
__device__ __forceinline__ void xcd_barrier_complete(unsigned* bar, unsigned x, unsigned& nloc, unsigned& nx) {
    const unsigned G = gridDim.x * gridDim.y * gridDim.z;
    unsigned sum, cnt, mine, sp = 0u;
    for (;;) {
        sum = 0u; cnt = 0u; mine = 0u;
#pragma unroll
        for (unsigned j = 0; j < 16; ++j) { const unsigned c = xb_ld(&bar[XB_XCNT(j)]); sum += c; cnt += (c > 0u) ? 1u : 0u; mine = (j == x) ? c : mine; }
        if (sum == G) break;
        __builtin_amdgcn_s_sleep(1);
        if ((++sp & 255u) == 0u) { if (xb_ld(&bar[XB_TMO])) break; if (sp > XB_SPIN_CAP) { atomicAdd(&bar[XB_TMO], 1u); break; } }
    }
    nloc = mine > 0u ? mine : 1u; nx = cnt > 0u ? cnt : 1u;
}

__device__ __forceinline__ void xcd_barrier(const XcdBarrier& b) {
    asm volatile("s_waitcnt vmcnt(0)" ::: "memory");
    __syncthreads();
    if (threadIdx.x == 0) {
        unsigned* bar = b.bar;
        __builtin_amdgcn_s_waitcnt(0);
        unsigned nloc = b.st[0], nx = b.st[1];
        if (nloc == 0u) { xcd_barrier_complete(bar, b.x, nloc, nx); b.st[0] = nloc; b.st[1] = nx; }
        const unsigned old = xb_add(&bar[XB_XSUB(b.x)], 1u);
        const unsigned gen = old / nloc;
        if (old + 1u == (gen + 1u) * nloc) {
            __builtin_amdgcn_fence(__ATOMIC_RELEASE, "agent");
            asm volatile("s_waitcnt vmcnt(0)" ::: "memory");
            const unsigned og = xb_add(&bar[XB_TOP], 1u);
            const unsigned tg = og / nx;
            if (og + 1u == (tg + 1u) * nx) xb_add(&bar[XB_TOPGEN], 1u);
            else XB_SPIN(xb_ld(&bar[XB_TOPGEN]) == tg, bar);
            __builtin_amdgcn_fence(__ATOMIC_ACQUIRE, "agent");
            xb_add(&bar[XB_XGEN(b.x)], 1u);
            asm volatile("s_waitcnt vmcnt(0)" ::: "memory");
        } else {
            XB_SPIN(xb_ld(&bar[XB_XGEN(b.x)]) == gen, bar);
            __builtin_amdgcn_fence(__ATOMIC_ACQUIRE, "agent");
            asm volatile("s_waitcnt vmcnt(0)" ::: "memory");
        }
    }
    __syncthreads();
}
#define NAIVE_ATTN 0
#define NAIVE_HGRN 0

__device__ __forceinline__ void hgrn_naive(Frame& F) {
    if (blockIdx.x >= 64 || F.wave != 0) return;
    const int item = blockIdx.x; const int b = item >> 3, h = (item >> 1) & 3, v = (item & 1) * 64 + F.lane;
    float S[128];
#pragma unroll
    for (int c = 0; c < 128; ++c) S[c] = 0.f;
    for (int t = 0; t < SEQ; ++t) {
        const size_t row = (size_t)b * SEQ + t; const bf16* pr = F.PROJ + row * PW;
        const float vv = bf2f(pr[C_I + h * 128 + v]);
        float o = 0.f;
#pragma unroll
        for (int c8 = 0; c8 < 16; ++c8) {
            const v4u qw = *(const v4u*)(pr + C_Q + h * 128 + c8 * 8); const v4u fw = *(const v4u*)(pr + C_F + h * 128 + c8 * 8);
#pragma unroll
            for (int i = 0; i < 4; ++i) {
                const float q0 = bflo(qw[i]), q1 = bfhi(qw[i]); const float f0 = __expf(bflo(fw[i])), f1 = __expf(bfhi(fw[i]));
                S[c8 * 8 + 2 * i] = f0 * S[c8 * 8 + 2 * i] + (1.0f - f0) * vv; o += q0 * S[c8 * 8 + 2 * i];
                S[c8 * 8 + 2 * i + 1] = f1 * S[c8 * 8 + 2 * i + 1] + (1.0f - f1) * vv; o += q1 * S[c8 * 8 + 2 * i + 1];
            }
        }
        F.OLOC[row * 512 + h * 128 + v] = o;
    }
}
__device__ __forceinline__ void attn_naive(Frame& F) {
    for (int id = blockIdx.x * 512 + F.tid; id < NB * AH * SEQ; id += F.G * 512) {
        const int t = id & 2047, qh = (id >> 11) & 7, b = id >> 14, kvh = qh >> 2;
        const size_t row = (size_t)b * SEQ + t;
        float q[64]; float ss = 0.f;
        { const bf16* qr = F.PROJ + row * PW + C_AQ + qh * 64;
#pragma unroll
          for (int d8 = 0; d8 < 8; ++d8) { const v4u w = *(const v4u*)(qr + d8 * 8);
#pragma unroll
              for (int i = 0; i < 4; ++i) { q[d8 * 8 + 2 * i] = bflo(w[i]); q[d8 * 8 + 2 * i + 1] = bfhi(w[i]); } }
#pragma unroll
          for (int d = 0; d < 64; ++d) ss += q[d] * q[d];
          const float rs = 1.0f / sqrtf(ss * (1.0f / 64.0f) + EPS);
#pragma unroll
          for (int d = 0; d < 64; ++d) q[d] = q[d] * rs * F.qg[d] * 0.125f * F.kg[d]; }
        float m = F.sinks[qh], l = 1.0f; float acc[64];
#pragma unroll
        for (int d = 0; d < 64; ++d) acc[d] = 0.f;
        const int k0 = t - 127 < 0 ? 0 : t - 127;
        for (int kp = k0; kp <= t; ++kp) {
            const bf16* kr = F.PROJ + ((size_t)b * SEQ + kp) * PW + C_AK + kvh * 64;
            float kss = 0.f, dot = 0.f;
#pragma unroll
            for (int d8 = 0; d8 < 8; ++d8) { const v4u w = *(const v4u*)(kr + d8 * 8);
#pragma unroll
                for (int i = 0; i < 4; ++i) { const float a = bflo(w[i]), c = bfhi(w[i]); kss += a * a + c * c; dot += q[d8 * 8 + 2 * i] * a + q[d8 * 8 + 2 * i + 1] * c; } }
            const float s = dot / sqrtf(kss * (1.0f / 64.0f) + EPS);
            const float mn = fmaxf(m, s), sc = __expf(m - mn), p = __expf(s - mn);
            l = l * sc + p; m = mn;
            const bf16* vr = F.PROJ + ((size_t)b * SEQ + kp) * PW + C_AV + kvh * 64;
#pragma unroll
            for (int d8 = 0; d8 < 8; ++d8) { const v4u w = *(const v4u*)(vr + d8 * 8);
#pragma unroll
                for (int i = 0; i < 4; ++i) { acc[d8 * 8 + 2 * i] = acc[d8 * 8 + 2 * i] * sc + p * bflo(w[i]); acc[d8 * 8 + 2 * i + 1] = acc[d8 * 8 + 2 * i + 1] * sc + p * bfhi(w[i]); } }
        }
        const float il = 1.0f / l;
        bf16* orow = F.MIXED + row * D + 512 + qh * 64;
#pragma unroll
        for (int d8 = 0; d8 < 8; ++d8) { v4u w;
#pragma unroll
            for (int i = 0; i < 4; ++i) w[i] = pk2(acc[d8 * 8 + 2 * i] * il, acc[d8 * 8 + 2 * i + 1] * il);
            *(v4u*)(orow + d8 * 8) = w; }
    }
}
__device__ __forceinline__ void hgrn_norm_naive(Frame& F) {
    const int gw = blockIdx.x * NWAVES + F.wave, NGW = F.G * NWAVES;
    for (int it = gw; it < M * 4; it += NGW) {
        const int row = it >> 2, h = it & 3;
        const float* o = F.OLOC + (size_t)row * 512 + h * 128;
        const float a = o[F.lane], c = o[64 + F.lane];
        const float ss = wave_sum(a * a + c * c); const float rs = 1.0f / sqrtf(ss * (1.0f / 128.0f) + EPS);
        const bf16* gr = F.PROJ + (size_t)row * PW + C_G + h * 128;
        bf16* mr = F.MIXED + (size_t)row * D + h * 128;
        mr[F.lane] = (bf16)f2bf(a * rs * F.ogain[F.lane] * bf2f(gr[F.lane]));
        mr[64 + F.lane] = (bf16)f2bf(c * rs * F.ogain[64 + F.lane] * bf2f(gr[64 + F.lane]));
    }
}

#ifndef PROBE_DUP
#define PROBE_DUP 0
#endif
#ifndef HGRN_WS
#define HGRN_WS 1
#endif
__device__ __forceinline__ bf16x8 pack8(const f32x4 a, const f32x4 b) {
    v4u w; w.x = pg8::cvt_pk_native(a[0], a[1]); w.y = pg8::cvt_pk_native(a[2], a[3]); w.z = pg8::cvt_pk_native(b[0], b[1]); w.w = pg8::cvt_pk_native(b[2], b[3]);
    return __builtin_bit_cast(bf16x8, w);
}
__device__ __forceinline__ bf16x8 join8(const v2u lo, const v2u hi) { v4u w; w.x = lo.x; w.y = lo.y; w.z = hi.x; w.w = hi.y; return __builtin_bit_cast(bf16x8, w); }
#define MFMA16(a, b, c) __builtin_amdgcn_mfma_f32_16x16x32_bf16((a), (b), (c), 0, 0, 0)
#define LDS_BARRIER() do { asm volatile("s_waitcnt lgkmcnt(0)" ::: "memory"); __builtin_amdgcn_s_barrier(); asm volatile("" ::: "memory"); } while (0)

constexpr int KS_STRIDE = 72, VT2_STRIDE = 264;
constexpr int AT_KS = 0, AT_VT = 256 * KS_STRIDE * 2;
__device__ __forceinline__ void attn_item(Frame& F, int item) {
    const int b = item >> 5, kvh = (item >> 4) & 1, qb = item & 15, p0 = qb * 128;
    const int tid = F.tid, lane = F.lane, w = F.wave, quad = lane >> 4, l15 = lane & 15;
    LAS bf16* Ks = (LAS bf16*)(F.lds + AT_KS); LAS bf16* Vt = (LAS bf16*)(F.lds + AT_VT);
    const size_t row = (size_t)b * SEQ + p0 + 16 * w + l15;
    {
        const int key = tid >> 1, half = tid & 1, pos = p0 - 128 + key;
        v4u kw[4], vw[4];
        if (pos >= 0) {
            const v4u* kr = (const v4u*)(F.PROJ + ((size_t)b * SEQ + pos) * PW + C_AK + kvh * 64 + half * 32);
            const v4u* vr = (const v4u*)(F.PROJ + ((size_t)b * SEQ + pos) * PW + C_AV + kvh * 64 + half * 32);
#pragma unroll
            for (int i = 0; i < 4; ++i) { kw[i] = kr[i]; vw[i] = vr[i]; }
        } else {
#pragma unroll
            for (int i = 0; i < 4; ++i) { kw[i] = (v4u){0u, 0u, 0u, 0u}; vw[i] = (v4u){0u, 0u, 0u, 0u}; }
        }
        float ss = 0.f;
#pragma unroll
        for (int i = 0; i < 4; ++i)
#pragma unroll
            for (int j = 0; j < 4; ++j) { const float a = bflo(kw[i][j]), c = bfhi(kw[i][j]); ss += a * a + c * c; }
        ss += __shfl_xor(ss, 1);
        const float rs = 1.0f / sqrtf(ss * (1.0f / 64.0f) + EPS);
#pragma unroll
        for (int i = 0; i < 4; ++i) {
            const f32x4 g0 = *(const f32x4*)(F.kg + half * 32 + 8 * i), g1 = *(const f32x4*)(F.kg + half * 32 + 8 * i + 4);
            v4u o;
            o.x = pk2(bflo(kw[i][0]) * rs * g0[0], bfhi(kw[i][0]) * rs * g0[1]); o.y = pk2(bflo(kw[i][1]) * rs * g0[2], bfhi(kw[i][1]) * rs * g0[3]);
            o.z = pk2(bflo(kw[i][2]) * rs * g1[0], bfhi(kw[i][2]) * rs * g1[1]); o.w = pk2(bflo(kw[i][3]) * rs * g1[2], bfhi(kw[i][3]) * rs * g1[3]);
            *(LAS v4u*)(Ks + key * KS_STRIDE + half * 32 + 8 * i) = o;
#pragma unroll
            for (int j = 0; j < 4; ++j) {
                Vt[(half * 32 + 8 * i + 2 * j) * VT2_STRIDE + key] = (bf16)(vw[i][j] & 0xffffu);
                Vt[(half * 32 + 8 * i + 2 * j + 1) * VT2_STRIDE + key] = (bf16)(vw[i][j] >> 16);
            }
        }
    }
    __syncthreads();
    bf16x8 kf[9][2];
#pragma unroll
    for (int kt = 0; kt < 9; ++kt)
#pragma unroll
        for (int ks = 0; ks < 2; ++ks) kf[kt][ks] = *(const LAS bf16x8*)(Ks + (16 * w + 16 * kt + l15) * KS_STRIDE + 32 * ks + 8 * quad);
    const float NEG = -1e30f;
    for (int g = 0; g < AG; ++g) {
        const int qh = kvh * AG + g;
        bf16x8 bq[2];
        {
            v4u qw[2]; float ss = 0.f;
#pragma unroll
            for (int ks = 0; ks < 2; ++ks) { qw[ks] = *(const v4u*)(F.PROJ + row * PW + C_AQ + qh * 64 + 32 * ks + 8 * quad);
#pragma unroll
                for (int j = 0; j < 4; ++j) { const float a = bflo(qw[ks][j]), c = bfhi(qw[ks][j]); ss += a * a + c * c; } }
            ss += __shfl_xor(ss, 16); ss += __shfl_xor(ss, 32);
            const float rs = 0.125f / sqrtf(ss * (1.0f / 64.0f) + EPS);
#pragma unroll
            for (int ks = 0; ks < 2; ++ks) {
                const f32x4 g0 = *(const f32x4*)(F.qg + 32 * ks + 8 * quad), g1 = *(const f32x4*)(F.qg + 32 * ks + 8 * quad + 4);
                v4u o;
                o.x = pk2(bflo(qw[ks][0]) * rs * g0[0], bfhi(qw[ks][0]) * rs * g0[1]); o.y = pk2(bflo(qw[ks][1]) * rs * g0[2], bfhi(qw[ks][1]) * rs * g0[3]);
                o.z = pk2(bflo(qw[ks][2]) * rs * g1[0], bfhi(qw[ks][2]) * rs * g1[1]); o.w = pk2(bflo(qw[ks][3]) * rs * g1[2], bfhi(qw[ks][3]) * rs * g1[3]);
                bq[ks] = __builtin_bit_cast(bf16x8, o);
            }
        }
        f32x4 sc[9];
#pragma unroll
        for (int kt = 0; kt < 9; ++kt) { sc[kt] = (f32x4){0.f, 0.f, 0.f, 0.f};
#pragma unroll
            for (int ks = 0; ks < 2; ++ks) sc[kt] = MFMA16(kf[kt][ks], bq[ks], sc[kt]); }
#pragma unroll
        for (int r = 0; r < 4; ++r) { if (!(l15 < 4 * quad + r)) sc[0][r] = NEG; if (!(l15 >= 4 * quad + r)) sc[8][r] = NEG; }
        if (qb == 0) {
#pragma unroll
            for (int kt = 0; kt < 9; ++kt)
#pragma unroll
                for (int r = 0; r < 4; ++r) if (16 * w + 16 * kt + 4 * quad + r < 128) sc[kt][r] = NEG;
        }
        const float sink = F.sinks[qh];
        float m = sink;
#pragma unroll
        for (int kt = 0; kt < 9; ++kt)
#pragma unroll
            for (int r = 0; r < 4; ++r) m = fmaxf(m, sc[kt][r]);
        m = fmaxf(m, __shfl_xor(m, 16)); m = fmaxf(m, __shfl_xor(m, 32));
        float l = 0.f;
#pragma unroll
        for (int kt = 0; kt < 9; ++kt)
#pragma unroll
            for (int r = 0; r < 4; ++r) { const float p = __expf(sc[kt][r] - m); sc[kt][r] = p; l += p; }
        l += __shfl_xor(l, 16); l += __shfl_xor(l, 32);
        l += __expf(sink - m);
        const float il = 1.0f / l;
        bf16x8 pf[5];
#pragma unroll
        for (int kk = 0; kk < 4; ++kk) pf[kk] = pack8(sc[2 * kk], sc[2 * kk + 1]);
        pf[4] = pack8(sc[8], (f32x4){0.f, 0.f, 0.f, 0.f});
#pragma unroll
        for (int dt = 0; dt < 4; ++dt) {
            f32x4 o = (f32x4){0.f, 0.f, 0.f, 0.f};
            const LAS bf16* vrow = Vt + (16 * dt + l15) * VT2_STRIDE + 16 * w + 4 * quad;
#pragma unroll
            for (int kk = 0; kk < 5; ++kk) {
                const v2u lo = *(const LAS v2u*)(vrow + 32 * kk);
                v2u hi = (v2u){0u, 0u}; if (kk < 4) hi = *(const LAS v2u*)(vrow + 32 * kk + 16);
                o = MFMA16(join8(lo, hi), pf[kk], o);
            }
            v2u ow; ow.x = pk2(o[0] * il, o[1] * il); ow.y = pk2(o[2] * il, o[3] * il);
            *(v2u*)(F.MIXED + row * D + 512 + qh * 64 + 16 * dt + 4 * quad) = ow;
        }
    }
    __syncthreads();
}

constexpr int QD_STRIDE = 136, KT_STRIDE = 40;
#define QDOFF(t) ((t) * QD_STRIDE + ((t) >> 3) * 16)
#define VTOFF(v) ((v) * KT_STRIDE + ((v) >> 3) * 32)
constexpr int HB_QD = 0, HB_KH = 8832, HB_KDT = 17664, HB_VT = 27904, HB_DEC = 39104, HB_BYTES = 39616;
static_assert(31 * QD_STRIDE + 3 * 16 + 128 <= (HB_KH - HB_QD) / 2 && 127 * KT_STRIDE + 15 * 32 + 32 <= (HB_DEC - HB_VT) / 2 && 128 * KT_STRIDE * 2 <= HB_VT - HB_KDT && 2 * HB_BYTES <= 131072, "HGRN LDS map");
__device__ __forceinline__ void hgrn_local(Frame& F, int item) {
    const int b = item >> 5, h = (item >> 3) & 3, seg = item & 7;
    const int tid = F.tid, lane = F.lane, w = F.wave, quad = lane >> 4, l15 = lane & 15;
    const int c = tid >> 2, part = tid & 3;
    const int vt_t = tid & 31, vt_v8 = tid >> 5;
    const size_t row0 = (size_t)b * SEQ + seg * 256;
    const bf16* pq = F.PROJ + row0 * PW + C_Q + h * 128 + c;
    const bf16* pf = F.PROJ + row0 * PW + C_F + h * 128 + c;
    const bf16* pv = F.PROJ + row0 * PW + C_I + h * 128 + vt_v8 * 8;
    f32x4 S[8];
#pragma unroll
    for (int i = 0; i < 8; ++i) S[i] = (f32x4){0.f, 0.f, 0.f, 0.f};
    float Bprev = 0.f;
    bf16 rq[8], rf[8]; v4u rv;
#define HG_LOAD_RAW(ch) do { _Pragma("unroll") for (int j = 0; j < 8; ++j) { const size_t t_ = (size_t)((ch) * 32 + 8 * part + j); rq[j] = pq[t_ * PW]; rf[j] = pf[t_ * PW]; } \
        rv = *(const v4u*)(pv + (size_t)((ch) * 32 + vt_t) * PW); } while (0)
#define HG_ELEM(ch) do { \
        LAS unsigned char* bb_ = F.lds + ((ch) & 1) * HB_BYTES; \
        LAS bf16* QD_ = (LAS bf16*)(bb_ + HB_QD); LAS bf16* KH_ = (LAS bf16*)(bb_ + HB_KH); LAS bf16* KDT_ = (LAS bf16*)(bb_ + HB_KDT); LAS bf16* VT_ = (LAS bf16*)(bb_ + HB_VT); LAS float* DEC_ = (LAS float*)(bb_ + HB_DEC); \
        float lf_[8], bl_[8]; float run_ = 0.f; \
        _Pragma("unroll") for (int j = 0; j < 8; ++j) { lf_[j] = bf2f(rf[j]); run_ += lf_[j]; bl_[j] = run_; } \
        const int b4_ = lane & ~3; \
        const float t0_ = __shfl(run_, b4_), t1_ = __shfl(run_, b4_ + 1), t2_ = __shfl(run_, b4_ + 2), t3_ = __shfl(run_, b4_ + 3); \
        const float pre_ = (part > 0 ? t0_ : 0.f) + (part > 1 ? t1_ : 0.f) + (part > 2 ? t2_ : 0.f); \
        const float btot_ = (t0_ + t1_) + (t2_ + t3_); \
        const float eprev_ = __expf(Bprev); \
        float kd_[8]; const float ebtot_ = __expf(btot_); float eip_ = __builtin_amdgcn_rcpf(__expf(pre_)); \
        _Pragma("unroll") for (int j = 0; j < 8; ++j) { const int t_ = 8 * part + j; const float bt_ = pre_ + bl_[j]; \
            const float e_ = __expf(bt_), ei_ = __builtin_amdgcn_rcpf(e_); \
            const float k_ = 1.0f - e_ * eip_; eip_ = ei_; const float qd_ = bf2f(rq[j]) * e_; const float kh_ = k_ * ei_; \
            const unsigned pw_ = pg8::cvt_pk_native(qd_, kh_); \
            QD_[QDOFF(t_) + c] = (bf16)(pw_ & 0xffffu); KH_[QDOFF(t_) + c] = (bf16)(pw_ >> 16); kd_[j] = kh_ * ebtot_; \
            F.QDS[(row0 + (size_t)((ch) * 32 + t_)) * 512 + h * 128 + c] = (bf16)f2bf(qd_ * eprev_); } \
        { v4u o_; o_.x = pk2(kd_[0], kd_[1]); o_.y = pk2(kd_[2], kd_[3]); o_.z = pk2(kd_[4], kd_[5]); o_.w = pk2(kd_[6], kd_[7]); *(LAS v4u*)(KDT_ + c * KT_STRIDE + 8 * part) = o_; } \
        if (part == 0) DEC_[c] = ebtot_; \
        Bprev += btot_; \
        _Pragma("unroll") for (int i = 0; i < 4; ++i) { VT_[VTOFF(8 * vt_v8 + 2 * i) + vt_t] = (bf16)(rv[i] & 0xffffu); VT_[VTOFF(8 * vt_v8 + 2 * i + 1) + vt_t] = (bf16)(rv[i] >> 16); } \
    } while (0)

    HG_LOAD_RAW(0);
    HG_ELEM(0);
    HG_LOAD_RAW(1);
    LDS_BARRIER();
    for (int ch = 0; ch < 8; ++ch) {
        if (ch + 1 < 8) { HG_ELEM(ch + 1); if (ch + 2 < 8) HG_LOAD_RAW(ch + 2); }
        const LAS unsigned char* bb = F.lds + (ch & 1) * HB_BYTES;
        const LAS bf16* QD = (const LAS bf16*)(bb + HB_QD); const LAS bf16* KH = (const LAS bf16*)(bb + HB_KH); const LAS bf16* KDT = (const LAS bf16*)(bb + HB_KDT);
        const LAS bf16* VT = (const LAS bf16*)(bb + HB_VT); const LAS float* DEC = (const LAS float*)(bb + HB_DEC);
        f32x4 T00 = (f32x4){0.f, 0.f, 0.f, 0.f}, T01 = T00, T11 = T00;
#pragma unroll
        for (int kk = 0; kk < 4; ++kk) {
            const bf16x8 kh0 = *(const LAS bf16x8*)(KH + QDOFF(l15) + 32 * kk + 8 * quad), kh1 = *(const LAS bf16x8*)(KH + QDOFF(16 + l15) + 32 * kk + 8 * quad);
            const bf16x8 q0 = *(const LAS bf16x8*)(QD + QDOFF(l15) + 32 * kk + 8 * quad), q1 = *(const LAS bf16x8*)(QD + QDOFF(16 + l15) + 32 * kk + 8 * quad);
            T00 = MFMA16(kh0, q0, T00); T01 = MFMA16(kh0, q1, T01); T11 = MFMA16(kh1, q1, T11);
        }
#pragma unroll
        for (int r = 0; r < 4; ++r) { if (4 * quad + r > l15) { T00[r] = 0.f; T11[r] = 0.f; } }
        const bf16x8 a0 = pack8(T00, (f32x4){0.f, 0.f, 0.f, 0.f}), a1 = pack8(T01, T11);
        const LAS bf16* vrow = VT + VTOFF(16 * w + l15);
        const bf16x8 bv = join8(*(const LAS v2u*)(vrow + 4 * quad), *(const LAS v2u*)(vrow + 16 + 4 * quad));
        f32x4 O0 = (f32x4){0.f, 0.f, 0.f, 0.f}, O1 = O0;
#pragma unroll
        for (int kk = 0; kk < 4; ++kk) {
            const bf16x8 aq0 = join8(*(const LAS v2u*)(QD + QDOFF(l15) + 32 * kk + 4 * quad), *(const LAS v2u*)(QD + QDOFF(l15) + 32 * kk + 16 + 4 * quad));
            const bf16x8 aq1 = join8(*(const LAS v2u*)(QD + QDOFF(16 + l15) + 32 * kk + 4 * quad), *(const LAS v2u*)(QD + QDOFF(16 + l15) + 32 * kk + 16 + 4 * quad));
            const bf16x8 bs = pack8(S[2 * kk], S[2 * kk + 1]);
            O0 = MFMA16(aq0, bs, O0); O1 = MFMA16(aq1, bs, O1);
        }
        O0 = MFMA16(a0, bv, O0); O1 = MFMA16(a1, bv, O1);
        {
            float* op = F.OLOC + (row0 + (size_t)(ch * 32 + 4 * quad)) * 512 + h * 128 + 16 * w + l15;
#pragma unroll
            for (int r = 0; r < 4; ++r) { op[(size_t)r * 512] = O0[r]; op[(size_t)(16 + r) * 512] = O1[r]; }
        }
        const bf16x8 bvn = *(const LAS bf16x8*)(vrow + 8 * quad);
#pragma unroll
        for (int tc = 0; tc < 8; ++tc) {
            const f32x4 dec = *(const LAS f32x4*)(DEC + 16 * tc + 4 * quad);
            S[tc] = S[tc] * dec;
            const bf16x8 ak = *(const LAS bf16x8*)(KDT + (16 * tc + l15) * KT_STRIDE + 8 * quad);
            S[tc] = MFMA16(ak, bvn, S[tc]);
        }
        LDS_BARRIER();
    }
#undef HG_LOAD_RAW
#undef HG_ELEM
    {
        f32x4* Lp = (f32x4*)F.LBUF + (size_t)(item * 8 + w) * 8 * 64 + lane;
#pragma unroll
        for (int tc = 0; tc < 8; ++tc) {
            const f32x4 val = S[tc] + 0.0f;
            asm volatile("global_store_dwordx4 %0, %1, off sc0 sc1\n\ts_nop 1" :: "v"(Lp + tc * 64), "v"(val) : "memory");
        }
        if (part == 0) { const float val = __expf(Bprev); asm volatile("global_store_dword %0, %1, off sc0 sc1" :: "v"(F.DTOT + item * 128 + c), "v"(val) : "memory"); }
    }
}
__device__ __forceinline__ void hgrn_local_ws2(Frame& F, int item) {
    const int b = item >> 5, h = (item >> 3) & 3, seg = item & 7;
    const int tid = F.tid, lane = F.lane, w = F.wave, quad = lane >> 4, l15 = lane & 15;
    const int c = tid >> 2, part = tid & 3;
    const int vt_t = tid & 31, vt_v8 = tid >> 5;
    const size_t row0 = (size_t)b * SEQ + seg * 256;
    const bf16* pq = F.PROJ + row0 * PW + C_Q + h * 128 + c;
    const bf16* pf = F.PROJ + row0 * PW + C_F + h * 128 + c;
    const bf16* pv = F.PROJ + row0 * PW + C_I + h * 128 + vt_v8 * 8;
    f32x4 S[2][8];
#pragma unroll
    for (int g = 0; g < 2; ++g)
#pragma unroll
        for (int i = 0; i < 8; ++i) S[g][i] = (f32x4){0.f, 0.f, 0.f, 0.f};
    float Bprev = 0.f;
    bf16 rq[8], rf[8]; v4u rv;
#define HG_LOAD_RAW(ch) do { _Pragma("unroll") for (int j = 0; j < 8; ++j) { const size_t t_ = (size_t)((ch) * 32 + 8 * part + j); rq[j] = pq[t_ * PW]; rf[j] = pf[t_ * PW]; } \
        rv = *(const v4u*)(pv + (size_t)((ch) * 32 + vt_t) * PW); } while (0)
#define HG_ELEM(ch) do { \
        LAS unsigned char* bb_ = F.lds + ((ch) & 1) * HB_BYTES; \
        LAS bf16* QD_ = (LAS bf16*)(bb_ + HB_QD); LAS bf16* KH_ = (LAS bf16*)(bb_ + HB_KH); LAS bf16* KDT_ = (LAS bf16*)(bb_ + HB_KDT); LAS bf16* VT_ = (LAS bf16*)(bb_ + HB_VT); LAS float* DEC_ = (LAS float*)(bb_ + HB_DEC); \
        float lf_[8], bl_[8]; float run_ = 0.f; \
        _Pragma("unroll") for (int j = 0; j < 8; ++j) { lf_[j] = bf2f(rf[j]); run_ += lf_[j]; bl_[j] = run_; } \
        const int b4_ = lane & ~3; \
        const float t0_ = __shfl(run_, b4_), t1_ = __shfl(run_, b4_ + 1), t2_ = __shfl(run_, b4_ + 2), t3_ = __shfl(run_, b4_ + 3); \
        const float pre_ = (part > 0 ? t0_ : 0.f) + (part > 1 ? t1_ : 0.f) + (part > 2 ? t2_ : 0.f); \
        const float btot_ = (t0_ + t1_) + (t2_ + t3_); \
        const float eprev_ = __expf(Bprev); \
        float kd_[8]; const float ebtot_ = __expf(btot_); float eip_ = __builtin_amdgcn_rcpf(__expf(pre_)); \
        _Pragma("unroll") for (int j = 0; j < 8; ++j) { const int t_ = 8 * part + j; const float bt_ = pre_ + bl_[j]; \
            const float e_ = __expf(bt_), ei_ = __builtin_amdgcn_rcpf(e_); \
            const float k_ = 1.0f - e_ * eip_; eip_ = ei_; const float qd_ = bf2f(rq[j]) * e_; const float kh_ = k_ * ei_; \
            const unsigned pw_ = pg8::cvt_pk_native(qd_, kh_); \
            QD_[QDOFF(t_) + c] = (bf16)(pw_ & 0xffffu); KH_[QDOFF(t_) + c] = (bf16)(pw_ >> 16); kd_[j] = kh_ * ebtot_; \
            F.QDS[(row0 + (size_t)((ch) * 32 + t_)) * 512 + h * 128 + c] = (bf16)f2bf(qd_ * eprev_); } \
        { v4u o_; o_.x = pk2(kd_[0], kd_[1]); o_.y = pk2(kd_[2], kd_[3]); o_.z = pk2(kd_[4], kd_[5]); o_.w = pk2(kd_[6], kd_[7]); *(LAS v4u*)(KDT_ + c * KT_STRIDE + 8 * part) = o_; } \
        if (part == 0) DEC_[c] = ebtot_; \
        Bprev += btot_; \
        _Pragma("unroll") for (int i = 0; i < 4; ++i) { VT_[VTOFF(8 * vt_v8 + 2 * i) + vt_t] = (bf16)(rv[i] & 0xffffu); VT_[VTOFF(8 * vt_v8 + 2 * i + 1) + vt_t] = (bf16)(rv[i] >> 16); } \
    } while (0)

    HG_LOAD_RAW(0);
    HG_ELEM(0);
    HG_LOAD_RAW(1);
    LDS_BARRIER();
    for (int ch = 0; ch < 8; ++ch) {
        if (w >= 4) { if (ch + 1 < 8) { HG_ELEM(ch + 1); if (ch + 2 < 8) HG_LOAD_RAW(ch + 2); } }
        if (w < 4) {
            const LAS unsigned char* bb = F.lds + (ch & 1) * HB_BYTES;
            const LAS bf16* QD = (const LAS bf16*)(bb + HB_QD); const LAS bf16* KH = (const LAS bf16*)(bb + HB_KH); const LAS bf16* KDT = (const LAS bf16*)(bb + HB_KDT);
            const LAS bf16* VT = (const LAS bf16*)(bb + HB_VT); const LAS float* DEC = (const LAS float*)(bb + HB_DEC);
            f32x4 T00 = (f32x4){0.f, 0.f, 0.f, 0.f}, T01 = T00, T11 = T00;
#pragma unroll
            for (int kk = 0; kk < 4; ++kk) {
                const bf16x8 kh0 = *(const LAS bf16x8*)(KH + QDOFF(l15) + 32 * kk + 8 * quad), kh1 = *(const LAS bf16x8*)(KH + QDOFF(16 + l15) + 32 * kk + 8 * quad);
                const bf16x8 q0 = *(const LAS bf16x8*)(QD + QDOFF(l15) + 32 * kk + 8 * quad), q1 = *(const LAS bf16x8*)(QD + QDOFF(16 + l15) + 32 * kk + 8 * quad);
                T00 = MFMA16(kh0, q0, T00); T01 = MFMA16(kh0, q1, T01); T11 = MFMA16(kh1, q1, T11);
            }
#pragma unroll
            for (int r = 0; r < 4; ++r) { if (4 * quad + r > l15) { T00[r] = 0.f; T11[r] = 0.f; } }
            const bf16x8 a0 = pack8(T00, (f32x4){0.f, 0.f, 0.f, 0.f}), a1 = pack8(T01, T11);
            f32x4 O[2][2];
#pragma unroll
            for (int g = 0; g < 2; ++g) { O[g][0] = (f32x4){0.f, 0.f, 0.f, 0.f}; O[g][1] = O[g][0]; }
#pragma unroll
            for (int kk = 0; kk < 4; ++kk) {
                const bf16x8 aq0 = join8(*(const LAS v2u*)(QD + QDOFF(l15) + 32 * kk + 4 * quad), *(const LAS v2u*)(QD + QDOFF(l15) + 32 * kk + 16 + 4 * quad));
                const bf16x8 aq1 = join8(*(const LAS v2u*)(QD + QDOFF(16 + l15) + 32 * kk + 4 * quad), *(const LAS v2u*)(QD + QDOFF(16 + l15) + 32 * kk + 16 + 4 * quad));
#pragma unroll
                for (int g = 0; g < 2; ++g) { const bf16x8 bs = pack8(S[g][2 * kk], S[g][2 * kk + 1]); O[g][0] = MFMA16(aq0, bs, O[g][0]); O[g][1] = MFMA16(aq1, bs, O[g][1]); }
            }
#pragma unroll
            for (int g = 0; g < 2; ++g) {
                const LAS bf16* vrow = VT + VTOFF(32 * w + 16 * g + l15);
                const bf16x8 bv = join8(*(const LAS v2u*)(vrow + 4 * quad), *(const LAS v2u*)(vrow + 16 + 4 * quad));
                O[g][0] = MFMA16(a0, bv, O[g][0]); O[g][1] = MFMA16(a1, bv, O[g][1]);
                float* op = F.OLOC + (row0 + (size_t)(ch * 32 + 4 * quad)) * 512 + h * 128 + 32 * w + 16 * g + l15;
#pragma unroll
                for (int r = 0; r < 4; ++r) { op[(size_t)r * 512] = O[g][0][r]; op[(size_t)(16 + r) * 512] = O[g][1][r]; }
            }
            const bf16x8 bvn0 = *(const LAS bf16x8*)(VT + VTOFF(32 * w + l15) + 8 * quad), bvn1 = *(const LAS bf16x8*)(VT + VTOFF(32 * w + 16 + l15) + 8 * quad);
#pragma unroll
            for (int tc = 0; tc < 8; ++tc) {
                const f32x4 dec = *(const LAS f32x4*)(DEC + 16 * tc + 4 * quad);
                const bf16x8 ak = *(const LAS bf16x8*)(KDT + (16 * tc + l15) * KT_STRIDE + 8 * quad);
                S[0][tc] = S[0][tc] * dec; S[1][tc] = S[1][tc] * dec;
                S[0][tc] = MFMA16(ak, bvn0, S[0][tc]); S[1][tc] = MFMA16(ak, bvn1, S[1][tc]);
            }
            if (ch + 1 < 8) { HG_ELEM(ch + 1); if (ch + 2 < 8) HG_LOAD_RAW(ch + 2); }
        }
        LDS_BARRIER();
    }
#undef HG_LOAD_RAW
#undef HG_ELEM
    if (w < 4) {
#pragma unroll
        for (int g = 0; g < 2; ++g) {
            f32x4* Lp = (f32x4*)F.LBUF + (size_t)(item * 8 + 2 * w + g) * 8 * 64 + lane;
#pragma unroll
            for (int tc = 0; tc < 8; ++tc) {
                const f32x4 val = S[g][tc] + 0.0f;
                asm volatile("global_store_dwordx4 %0, %1, off sc0 sc1\n\ts_nop 1" :: "v"(Lp + tc * 64), "v"(val) : "memory");
            }
        }
    }
    if (part == 0) { const float val = __expf(Bprev); asm volatile("global_store_dword %0, %1, off sc0 sc1" :: "v"(F.DTOT + item * 128 + c), "v"(val) : "memory"); }
}
__device__ __forceinline__ void hgrn_publish(Frame& F, unsigned* cnt, int item) {
    asm volatile("s_waitcnt vmcnt(0)" ::: "memory");
    __syncthreads();
    if (F.tid == 0) __hip_atomic_fetch_add(cnt + 64 * (item >> 3), 1u, __ATOMIC_RELAXED, __HIP_MEMORY_SCOPE_AGENT);
}
__device__ __forceinline__ void hgrn_wait(Frame& F, unsigned* cnt, int item) {
    if (F.tid == 0) {
        unsigned sp = 0;
        while (__hip_atomic_load(cnt + 64 * (item >> 3), __ATOMIC_RELAXED, __HIP_MEMORY_SCOPE_AGENT) < 8u) { __builtin_amdgcn_s_sleep(2); if (++sp > (1u << 22)) break; }
        __builtin_amdgcn_fence(__ATOMIC_ACQUIRE, "agent");
        asm volatile("s_waitcnt vmcnt(0)" ::: "memory");
    }
    __syncthreads();
}

constexpr int ST_STRIDE = 136;
__device__ __forceinline__ void hgrn_correct(Frame& F, int item) {
    const int b = item >> 5, h = (item >> 3) & 3, seg = item & 7;
    const int lane = F.lane, w = F.wave, quad = lane >> 4, l15 = lane & 15;
    const size_t row0 = (size_t)b * SEQ + seg * 256;
    LAS bf16* ST = (LAS bf16*)F.lds;
    v4u qf[2][4];
    if (seg > 0) {
#pragma unroll
        for (int tt = 0; tt < 2; ++tt)
#pragma unroll
            for (int kk = 0; kk < 4; ++kk) qf[tt][kk] = *(const v4u*)(F.QDS + (row0 + 32 * w + 16 * tt + l15) * 512 + h * 128 + 32 * kk + 8 * quad);
    }
    if (seg > 0) {
        f32x4 S[8];
#pragma unroll
        for (int i = 0; i < 8; ++i) S[i] = (f32x4){0.f, 0.f, 0.f, 0.f};
        f32x4 Lc[8], Dc[8];
        {
            const int im = item - seg;
            const f32x4* Lp = (const f32x4*)F.LBUF + (size_t)(im * 8 + w) * 8 * 64 + lane; const float* Dp = F.DTOT + im * 128;
#pragma unroll
            for (int tc = 0; tc < 8; ++tc) { Dc[tc] = *(const f32x4*)(Dp + 16 * tc + 4 * quad); Lc[tc] = Lp[tc * 64]; }
        }
        for (int m = 0; m < seg; ++m) {
            f32x4 Ln[8], Dn[8];
            const int im = item - seg + (m + 1 < seg ? m + 1 : m);
            const f32x4* Lp = (const f32x4*)F.LBUF + (size_t)(im * 8 + w) * 8 * 64 + lane; const float* Dp = F.DTOT + im * 128;
#pragma unroll
            for (int tc = 0; tc < 8; ++tc) { Dn[tc] = *(const f32x4*)(Dp + 16 * tc + 4 * quad); Ln[tc] = Lp[tc * 64]; }
#pragma unroll
            for (int tc = 0; tc < 8; ++tc) { S[tc] = Dc[tc] * S[tc] + Lc[tc]; Lc[tc] = Ln[tc]; Dc[tc] = Dn[tc]; }
        }
#pragma unroll
        for (int tc = 0; tc < 8; ++tc) { v2u o; o.x = pg8::cvt_pk_native(S[tc][0], S[tc][1]); o.y = pg8::cvt_pk_native(S[tc][2], S[tc][3]);
            *(LAS v2u*)(ST + (16 * w + l15) * ST_STRIDE + 16 * tc + 4 * quad) = o; }
    }
    f32x4 OL[2][8]; v2u GW[2][8];
#pragma unroll
    for (int tt = 0; tt < 2; ++tt) {
        const size_t row = row0 + 32 * w + 16 * tt + l15;
#pragma unroll
        for (int vt = 0; vt < 8; ++vt) { OL[tt][vt] = *(const f32x4*)(F.OLOC + row * 512 + h * 128 + 4 * quad + 16 * vt); GW[tt][vt] = *(const v2u*)(F.PROJ + row * PW + C_G + h * 128 + 4 * quad + 16 * vt); }
    }
    __syncthreads();
    f32x4 O[8][2];
#pragma unroll
    for (int vt = 0; vt < 8; ++vt) { O[vt][0] = (f32x4){0.f, 0.f, 0.f, 0.f}; O[vt][1] = O[vt][0]; }
    if (seg > 0) {
#pragma unroll
        for (int vt = 0; vt < 8; ++vt)
#pragma unroll
            for (int kk = 0; kk < 4; ++kk) {
                const bf16x8 a = *(const LAS bf16x8*)(ST + (16 * vt + l15) * ST_STRIDE + 32 * kk + 8 * quad);
                O[vt][0] = MFMA16(a, __builtin_bit_cast(bf16x8, qf[0][kk]), O[vt][0]);
                O[vt][1] = MFMA16(a, __builtin_bit_cast(bf16x8, qf[1][kk]), O[vt][1]);
            }
    }
#pragma unroll
    for (int tt = 0; tt < 2; ++tt) {
        const size_t row = row0 + 32 * w + 16 * tt + l15;
        float ss = 0.f;
#pragma unroll
        for (int vt = 0; vt < 8; ++vt) { const f32x4 o = O[vt][tt] + OL[tt][vt]; O[vt][tt] = o; ss += (o[0] * o[0] + o[1] * o[1]) + (o[2] * o[2] + o[3] * o[3]); }
        ss += __shfl_xor(ss, 16); ss += __shfl_xor(ss, 32);
        const float rs = 1.0f / sqrtf(ss * (1.0f / 128.0f) + EPS);
        bf16* mp = F.MIXED + row * D + h * 128 + 4 * quad;
#pragma unroll
        for (int vt = 0; vt < 8; ++vt) {
            const v2u gw = GW[tt][vt];
            const f32x4 og = *(const f32x4*)(F.ogain + 16 * vt + 4 * quad);
            const f32x4 o = O[vt][tt];
            v2u ow; ow.x = pk2(o[0] * rs * og[0] * bflo(gw.x), o[1] * rs * og[1] * bfhi(gw.x)); ow.y = pk2(o[2] * rs * og[2] * bflo(gw.y), o[3] * rs * og[3] * bfhi(gw.y));
            *(v2u*)(mp + 16 * vt) = ow;
        }
    }
    __syncthreads();
}
__device__ __forceinline__ int mix_first_item(const Frame& F) { const int bx = blockIdx.x; return (F.G == 256) ? (bx & 7) * 32 + (bx >> 3) : bx; }
__device__ __forceinline__ void mix_phase_a(Frame& F, bool handoff, unsigned* cnt) {
#if !NAIVE_HGRN
    for (int it = mix_first_item(F); it < NB * HH * 8; it += F.G) {
#if HGRN_WS
        hgrn_local_ws2(F, it);
#else
        hgrn_local(F, it);
#endif
        if (handoff) hgrn_publish(F, cnt, it); }
    __syncthreads();
#else
    hgrn_naive(F); __syncthreads();
#endif
#if !NAIVE_ATTN
    for (int it = mix_first_item(F); it < NB * KVH * 16; it += F.G) attn_item(F, it);
#else
    attn_naive(F); __syncthreads();
#endif
}
__device__ __forceinline__ void mix_phase_b(Frame& F, bool handoff, unsigned* cnt) {
#if !NAIVE_HGRN
    for (int it = mix_first_item(F); it < NB * HH * 8; it += F.G) { if (handoff) hgrn_wait(F, cnt, it); hgrn_correct(F, it); }
#else
    hgrn_norm_naive(F);
#endif
}
#define MK_N_LAUNCHES 1
#define NAIVE_MIX 0

#ifndef MK_N_LAUNCHES
#define MK_N_LAUNCHES 1
#endif
#ifndef NAIVE_MIX
#define NAIVE_MIX 0
#endif
constexpr int N_PHASES = 7;
struct Args { const float* in[13]; float* out; unsigned char* ws; int ph_lo, ph_hi; };
template <bool COOP>
__global__ void __launch_bounds__(NWAVES * 64, 2) fwd(Args args) {
    extern __shared__ __attribute__((aligned(16))) unsigned char lds[];
    Frame F;
    F.lds = (LAS unsigned char*)lds;
    F.tid = threadIdx.x; F.lane = F.tid & 63; F.wave = __builtin_amdgcn_readfirstlane(F.tid >> 6); F.G = gridDim.x;
    unsigned char* ws = args.ws;
    F.x = args.in[0]; F.g1 = args.in[1]; F.w_in = args.in[2]; F.lbl = args.in[3]; F.ogain = args.in[4]; F.qg = args.in[5]; F.kg = args.in[6];
    F.sinks = args.in[7]; F.w_out = args.in[8]; F.g2 = args.in[9]; F.w_gate = args.in[10]; F.w_up = args.in[11]; F.w_down = args.in[12]; F.out = args.out;
    F.WIN = (bf16*)(ws + WS_WIN); F.WOUT = (bf16*)(ws + WS_WOUT); F.WGU = (bf16*)(ws + WS_WGU); F.WDN = (bf16*)(ws + WS_WDN);
    F.XB = (bf16*)(ws + WS_XB); F.PROJ = (bf16*)(ws + WS_PROJ); F.ACT = (bf16*)(ws + WS_ACT); F.MIXED = (bf16*)(ws + WS_MIXED); F.HB = (bf16*)(ws + WS_HB); F.QDS = (bf16*)(ws + WS_QDS);
    F.RSTD1 = (float*)(ws + WS_RSTD1); F.PART = (float*)(ws + WS_PART); F.DTOT = (float*)(ws + WS_DTOT); F.OLOC = (float*)(ws + WS_OLOC); F.LBUF = (float*)(ws + WS_LBUF);
    const int lo = args.ph_lo, hi = args.ph_hi;
#define IN(k) (lo <= (k) && (k) < hi)
#ifndef USE_CG_SYNC
#define USE_CG_SYNC 0
#endif
    XcdBarrier bar; bar.bar = (unsigned*)(ws + WS_CTL) + 4096; bar.x = 0; bar.st = nullptr;
    if constexpr (COOP) {
        for (int u = F.tid; u < (LDS_BYTES - 131072) / 4; u += NWAVES * 64) ((LAS unsigned*)(F.lds + 131072))[u] = 0u;
        __syncthreads();
        bar = xcd_barrier_post((unsigned*)(ws + WS_CTL) + 4096, (volatile LAS unsigned*)(F.lds + 131072 + 352));
    }
#define SEAM(k) do { if constexpr (COOP) { if (IN(k) && IN((k) + 1)) { if (USE_CG_SYNC) cg::this_grid().sync(); else xcd_barrier(bar); } } } while (0)

#ifndef PROBE_DUP
#define PROBE_DUP 0
#endif
#ifndef PROBE_SYNC
#define PROBE_SYNC 0
#endif
    const bool handoff23 = COOP && !NAIVE_MIX && !NAIVE_HGRN && (F.G == NB * HH * 8) && IN(2) && IN(3);
    unsigned* cnt23 = (unsigned*)(ws + WS_CTL) + 8192;
    if (IN(0)) { p0_prologue(F); if (PROBE_DUP & 1) { __syncthreads(); p0_prologue(F); } SEAM(0); if constexpr (COOP) { for (int i_ = 0; i_ < PROBE_SYNC; ++i_) xcd_barrier(bar); } }
    if (IN(1)) {
        pg8::Gemm g{F.XB, F.WIN, M, PW, D}; pg8::StaticOrder S; S.init(M, PW, F.G, (int)blockIdx.x);
        pg8::EpiProj E{F.PROJ, F.RSTD1, F.lbl};
        pg8::gemm_phase<pg8::EpiProj, pg8::StaticOrder, true, true>(F.lds, g, S, E);
        if (PROBE_DUP & 2) { __syncthreads(); pg8::gemm_phase<pg8::EpiProj, pg8::StaticOrder, true, true>(F.lds, g, S, E); }
        {
            const int nwg = (M / 256) * (PW / 256), rem = nwg % F.G;
            const int first_late = (rem == 0) ? 0 : rem;
            if ((int)blockIdx.x >= first_late) { __syncthreads(); p0_weights_late(F, first_late, 0); }
        }
        SEAM(1);
    }
    if (IN(2)) {
#if NAIVE_MIX
        attn_naive(F); hgrn_naive(F);
#else
        mix_phase_a(F, handoff23, cnt23);
#endif
        if (!handoff23) SEAM(2);
    }
    if (IN(3)) {
#if NAIVE_MIX
        hgrn_norm_naive(F);
#else
        mix_phase_b(F, handoff23, cnt23);
#endif

        SEAM(3);
    }
    if (IN(4)) {
        pg8::Gemm g{F.MIXED, F.WOUT, M, D, D}; pg8::StaticOrder S; S.init(M, D, F.G, (int)blockIdx.x);
        pg8::EpiOut E{F.XB, F.out, F.HB, F.PART};
        pg8::gemm_phase<pg8::EpiOut, pg8::StaticOrder, true, true>(F.lds, g, S, E);
        if (PROBE_DUP & 16) { __syncthreads(); pg8::gemm_phase<pg8::EpiOut, pg8::StaticOrder, true, true>(F.lds, g, S, E); }
        SEAM(4);
    }
    if (IN(5)) {
        pg8::Gemm g{F.HB, F.WGU, M, NGU, D}; pg8::StaticOrder S; S.init(M, NGU, F.G, (int)blockIdx.x);
        pg8::EpiGU E{F.ACT, F.PART};
        pg8::gemm_phase<pg8::EpiGU, pg8::StaticOrder, true, true>(F.lds, g, S, E);
        if (PROBE_DUP & 32) { __syncthreads(); pg8::gemm_phase<pg8::EpiGU, pg8::StaticOrder, true, true>(F.lds, g, S, E); }
        {
            const int nwg = (M / 256) * (NGU / 256), rem = nwg % F.G;
            const int first_late = (rem == 0) ? 0 : rem;
            if ((int)blockIdx.x >= first_late) { __syncthreads(); p0_weights_late(F, first_late, 1); }
        }
        SEAM(5);
    }
    if (IN(6)) {
        pg8::Gemm g{F.ACT, F.WDN, M, D, FF}; pg8::StaticOrder S; S.init(M, D, F.G, (int)blockIdx.x);
        pg8::EpiDown E{F.out, F.HB};
        pg8::gemm_phase<pg8::EpiDown, pg8::StaticOrder, true, true>(F.lds, g, S, E);
        if (PROBE_DUP & 256) { __syncthreads(); pg8::gemm_phase<pg8::EpiDown, pg8::StaticOrder, true, true>(F.lds, g, S, E); }
    }
#undef IN
#undef SEAM
}

extern "C" void kernel_launch(void* const* d_in, const int* in_sizes, int n_in, void* d_out, int out_size, void* d_ws, size_t ws_size, hipStream_t stream) {
    static int grid = 0;
    if (grid == 0) {
        if (n_in != 13 || in_sizes[0] != M * D || out_size != M * D || ws_size < WS_END) { fprintf(stderr, "kernel_launch: unexpected shapes (n_in %d, in0 %d, out %d, ws %zu)\n", n_in, n_in > 0 ? in_sizes[0] : -1, out_size, ws_size); grid = -1; return; }
        int dev = 0, cus = 0, per_cu = 0;
        if (hipGetDevice(&dev) != hipSuccess || hipDeviceGetAttribute(&cus, hipDeviceAttributeMultiprocessorCount, dev) != hipSuccess) { grid = -1; return; }
        (void)hipFuncSetAttribute((const void*)fwd<true>, hipFuncAttributeMaxDynamicSharedMemorySize, LDS_BYTES);
        (void)hipFuncSetAttribute((const void*)fwd<false>, hipFuncAttributeMaxDynamicSharedMemorySize, LDS_BYTES);
        if (hipOccupancyMaxActiveBlocksPerMultiprocessor(&per_cu, (const void*)fwd<true>, NWAVES * 64, LDS_BYTES) != hipSuccess || per_cu < 1) {
            fprintf(stderr, "kernel_launch: occupancy query reports %d blocks per CU\n", per_cu); per_cu = 1; }
        (void)hipGetLastError();
        grid = cus;
    }
    if (grid < 0) return;
    if (hipMemsetAsync((char*)d_ws + WS_CTL, 0, 65536, stream) != hipSuccess) { fprintf(stderr, "kernel_launch: memset of the barrier words failed\n"); return; }
    Args a{};
    for (int i = 0; i < 13; ++i) a.in[i] = (const float*)d_in[i];
    a.out = (float*)d_out; a.ws = (unsigned char*)d_ws;
#if MK_N_LAUNCHES == 1
    a.ph_lo = 0; a.ph_hi = N_PHASES;
    void* params[] = {&a};
    hipError_t e = hipLaunchCooperativeKernel((const void*)fwd<true>, dim3(grid), dim3(NWAVES * 64), params, LDS_BYTES, stream);
    if (e != hipSuccess) fprintf(stderr, "cooperative launch failed: %s (grid %d)\n", hipGetErrorString(e), grid);
#else
    for (int ph = 0; ph < N_PHASES; ++ph) {
        a.ph_lo = ph; a.ph_hi = ph + 1;
        hipLaunchKernelGGL(fwd<false>, dim3(grid), dim3(NWAVES * 64), LDS_BYTES, stream, a);
    }
#endif
}
```

```cpp
#include <hip/hip_runtime.h>
#include <hip/hip_cooperative_groups.h>
#include <cstdio>
#include <cstdint>
namespace cg = cooperative_groups;
namespace pg8 {
#define PG8_LAS __attribute__((address_space(3)))
typedef unsigned short bf16_t;
typedef short bf16x8 __attribute__((ext_vector_type(8)));
typedef float f32x4 __attribute__((ext_vector_type(4)));
typedef unsigned u32x4 __attribute__((ext_vector_type(4)));
constexpr int BM = 256, BK = 64, HALF = 128, HTB = HALF * BK * 2  , STAGE_BYTES = 8 * HTB, NXCD = 8, WGM = 8;

__host__ __device__ __forceinline__ int lds_byte(int r, int c) { const int st = (r >> 4) * 2 + (c >> 5), rr = r & 15, cc = c & 31, ob = rr * 64 + cc * 2; return st * 1024 + (ob ^ (((ob >> 9) & 1) << 5)); }
__host__ __device__ __forceinline__ void stage_rc(int b, int& R, int& C) { const int st = b / 1024, sb = b % 1024, swz = sb ^ (((sb >> 9) & 1) << 5); R = (st >> 1) * 16 + swz / 64; C = (st & 1) * 32 + (swz % 64) / 2; }
__host__ __device__ __forceinline__ int perm32(int rho) { const int n = rho >> 4, i = rho & 15; return 8 * (i >> 2) + 4 * n + (i & 3); }

struct Unit { int pm, pn; };
struct Gemm { const bf16_t* A; const bf16_t* Bt; int M, N, K; };

struct StaticOrder {
    int nM, nN, nwg, G, c;
    __host__ __device__ void init(int M, int N, int G_, int c_) { nM = M / BM; nN = N / BM; nwg = nM * nN; G = G_; c = c_; }
    __host__ __device__ bool next(int i, Unit& u) const {
        const long L = (long)i * G + c; if (L >= nwg) return false;
        int wgid = (int)L; { const int q = nwg / NXCD, r = nwg % NXCD, xcd = wgid % NXCD, off = wgid / NXCD; wgid = (xcd < r ? xcd * (q + 1) : r * (q + 1) + (xcd - r) * q) + off; }
        const int nig = WGM * nN, gid = wgid / nig, fm = gid * WGM, gsz = (nM - fm) < WGM ? (nM - fm) : WGM;
        u.pm = fm + ((wgid % nig) % gsz); u.pn = (wgid % nig) / gsz; return true;
    }
    __device__ __forceinline__ void a_ready(const Unit&) const {}
    __device__ __forceinline__ void done(const Unit&) const {}
};

typedef float f32x2 __attribute__((ext_vector_type(2)));
__device__ __forceinline__ unsigned cvt_pk_bf16(float lo, float hi) { unsigned r; asm volatile("v_cvt_pk_bf16_f32 %0, %1, %2" : "=v"(r) : "v"(lo), "v"(hi)); return r; }
typedef __bf16 nbf16x2 __attribute__((ext_vector_type(2)));
__device__ __forceinline__ unsigned cvt_pk_native(float lo, float hi) { f32x2 v = {lo, hi}; return __builtin_bit_cast(unsigned, __builtin_convertvector(v, nbf16x2)); }
typedef float f32x2 __attribute__((ext_vector_type(2)));
template <class Epi, class Sched, bool ALIGN_EPI = false, bool SP2 = false>
__device__ __forceinline__ void gemm_phase(PG8_LAS unsigned char* lds, const Gemm g, const Sched& S, const Epi& E) {
    const int tid = threadIdx.x, wid = __builtin_amdgcn_readfirstlane(tid >> 6), lane = tid & 63, wr = wid >> 2, wc = wid & 3, fr = lane & 15, fq = lane >> 4;
    const int K = g.K, nt = K / BK;
    unsigned voffA[2], voffB[2];
#pragma unroll
    for (int i = 0; i < 2; ++i) { int R, C; stage_rc(tid * 16 + i * 8192, R, C); const int Rb = Epi::PERM ? ((R & ~31) + perm32(R & 31)) : R;
        voffA[i] = (unsigned)(R * K + C) * 2u; voffB[i] = (unsigned)(Rb * K + C) * 2u; }
    const size_t kstep = (size_t)(BK * 2);
    const size_t hstep = (size_t)HALF * K * 2;
    const size_t tstep = 2 * hstep;
    const unsigned ldsw = (unsigned)wid * 1024u;
    const int aoff = lds_byte(wr * 64 + fr, fq * 8), boff = lds_byte(wc * 32 + fr, fq * 8);
#define PG8_SA(b, h) (((b) * 2 + (h)) * HTB)
#define PG8_SB(b, h) ((4 + (b) * 2 + (h)) * HTB)
#define PG8_STAGE(bufoff, gbase, voff) do { _Pragma("unroll") for (int _i = 0; _i < 2; ++_i) \
        __builtin_amdgcn_global_load_lds((const unsigned*)((const char*)(gbase) + (voff)[_i]), (PG8_LAS unsigned*)(lds + (bufoff) + ldsw + _i * 8192), 16, 0, 0); } while (0)
#define PG8_LDA(dst, b, h) do { _Pragma("unroll") for (int m = 0; m < 4; ++m) _Pragma("unroll") for (int k = 0; k < 2; ++k) dst[m][k] = *(const PG8_LAS bf16x8*)(lds + PG8_SA(b, h) + aoff + m * 2048 + k * 1024); } while (0)
#define PG8_LDB(dst, b, h) do { _Pragma("unroll") for (int n = 0; n < 2; ++n) _Pragma("unroll") for (int k = 0; k < 2; ++k) dst[n][k] = *(const PG8_LAS bf16x8*)(lds + PG8_SB(b, h) + boff + n * 2048 + k * 1024); } while (0)
#define PG8_MMA(ai, bj, At, Bt) do { __builtin_amdgcn_s_setprio(1); _Pragma("unroll") for (int m = 0; m < 4; ++m) _Pragma("unroll") for (int n = 0; n < 2; ++n) _Pragma("unroll") for (int k = 0; k < 2; ++k) \
        acc[ai][bj][m][n] = __builtin_amdgcn_mfma_f32_16x16x32_bf16(Bt[n][k], At[m][k], acc[ai][bj][m][n], 0, 0, 0); __builtin_amdgcn_s_setprio(0); } while (0)
#define PG8_WAIT_V(n) asm volatile("s_waitcnt vmcnt(" #n ")" ::: "memory")
#define PG8_WAIT_L(n) asm volatile("s_waitcnt lgkmcnt(" #n ")" ::: "memory")
#define PG8_BAR __builtin_amdgcn_s_barrier()
#define PG8_SCHED __builtin_amdgcn_sched_barrier(0)
    Unit cur, nxt; int ui = 0;
    if (!S.next(0, cur)) return;
    f32x4 acc[2][2][4][2];
#pragma unroll
    for (int a = 0; a < 2; ++a)
#pragma unroll
        for (int b = 0; b < 2; ++b)
#pragma unroll
            for (int m = 0; m < 4; ++m)
#pragma unroll
                for (int n = 0; n < 2; ++n) acc[a][b][m][n] = (f32x4){0.f, 0.f, 0.f, 0.f};
    bf16x8 At[4][2], B0[2][2], B1[2][2];
    const char* cA = (const char*)g.A + (size_t)cur.pm * tstep; const char* cB = (const char*)g.Bt + (size_t)cur.pn * tstep;
    S.a_ready(cur);
    if constexpr (SP2) {
        PG8_STAGE(PG8_SB(0, 0), cB, voffB); PG8_STAGE(PG8_SB(0, 1), cB + hstep, voffB); PG8_STAGE(PG8_SA(0, 0), cA, voffA); PG8_STAGE(PG8_SA(0, 1), cA + hstep, voffA);
        if (wr == 1) PG8_BAR;
        PG8_WAIT_V(2); PG8_BAR;
        PG8_STAGE(PG8_SB(1, 0), cB + kstep, voffB); PG8_STAGE(PG8_SA(1, 0), cA + kstep, voffA); PG8_STAGE(PG8_SB(1, 1), cB + hstep + kstep, voffB);
        PG8_WAIT_V(6); PG8_BAR;
    } else {
        PG8_STAGE(PG8_SB(0, 0), cB, voffB); PG8_STAGE(PG8_SA(0, 0), cA, voffA); PG8_STAGE(PG8_SB(0, 1), cB + hstep, voffB); PG8_STAGE(PG8_SA(0, 1), cA + hstep, voffA);
        if (wr == 1) PG8_BAR;
        PG8_WAIT_V(4); PG8_BAR;
        PG8_STAGE(PG8_SB(1, 0), cB + kstep, voffB); PG8_STAGE(PG8_SA(1, 0), cA + kstep, voffA); PG8_STAGE(PG8_SB(1, 1), cB + hstep + kstep, voffB);
        PG8_WAIT_V(6); PG8_BAR;
    }
    for (;;) {
        const bool has_next = S.next(ui + 1, nxt);
        const char* nA = has_next ? (const char*)g.A + (size_t)nxt.pm * tstep : cA; const char* nB = has_next ? (const char*)g.Bt + (size_t)nxt.pn * tstep : cB;
        for (int t = 0; t < nt; t += 2) {
            const bool last = (t == nt - 2);
            const char* a1 = cA + (size_t)(t + 1) * kstep;
            const char* a2 = last ? nA : cA + (size_t)(t + 2) * kstep; const char* b2 = last ? nB : cB + (size_t)(t + 2) * kstep;
            const char* a3 = a2 + kstep; const char* b3 = b2 + kstep;
            if (last && has_next) S.a_ready(nxt);
            if constexpr (SP2) {
            PG8_LDB(B0, 0, 0); PG8_LDB(B1, 0, 1); PG8_SCHED; PG8_LDA(At, 0, 0); PG8_STAGE(PG8_SA(1, 1), a1 + hstep, voffA);
            PG8_WAIT_V(8); PG8_WAIT_L(0); PG8_BAR; PG8_MMA(0, 0, At, B0); PG8_MMA(0, 1, At, B1); PG8_BAR; PG8_SCHED;
            PG8_LDA(At, 0, 1); PG8_STAGE(PG8_SB(0, 0), b2, voffB); PG8_STAGE(PG8_SB(0, 1), b2 + hstep, voffB); PG8_STAGE(PG8_SA(0, 0), a2, voffA);
            PG8_WAIT_V(8); PG8_WAIT_L(0); PG8_BAR; PG8_MMA(1, 0, At, B0); PG8_MMA(1, 1, At, B1); PG8_BAR; PG8_SCHED;
            PG8_LDB(B0, 1, 0); PG8_LDB(B1, 1, 1); PG8_SCHED; PG8_LDA(At, 1, 0); PG8_STAGE(PG8_SA(0, 1), a2 + hstep, voffA);
            PG8_WAIT_V(8); PG8_WAIT_L(0); PG8_BAR; PG8_MMA(0, 0, At, B0); PG8_MMA(0, 1, At, B1); PG8_BAR; PG8_SCHED;
            PG8_LDA(At, 1, 1); PG8_STAGE(PG8_SB(1, 0), b3, voffB); PG8_STAGE(PG8_SB(1, 1), b3 + hstep, voffB); PG8_STAGE(PG8_SA(1, 0), a3, voffA);
            PG8_WAIT_V(8); PG8_WAIT_L(0); PG8_BAR; PG8_MMA(1, 0, At, B0); PG8_MMA(1, 1, At, B1); PG8_BAR; PG8_SCHED;
            } else {
            PG8_LDB(B0, 0, 0); PG8_SCHED; PG8_LDA(At, 0, 0); PG8_STAGE(PG8_SA(1, 1), a1 + hstep, voffA);
            PG8_WAIT_L(8); PG8_BAR; PG8_WAIT_L(0); PG8_MMA(0, 0, At, B0); PG8_BAR; PG8_SCHED;
            PG8_LDB(B1, 0, 1); PG8_STAGE(PG8_SB(0, 0), b2, voffB);
            PG8_BAR; PG8_WAIT_L(0); PG8_MMA(0, 1, At, B1); PG8_BAR;
            PG8_LDA(At, 0, 1); PG8_STAGE(PG8_SA(0, 0), a2, voffA);
            PG8_BAR; PG8_WAIT_L(0); PG8_MMA(1, 0, At, B0); PG8_BAR; PG8_SCHED;
            PG8_STAGE(PG8_SB(0, 1), b2 + hstep, voffB);
            PG8_WAIT_V(6); PG8_BAR; PG8_MMA(1, 1, At, B1); PG8_BAR;
            PG8_LDB(B0, 1, 0); PG8_SCHED; PG8_LDA(At, 1, 0); PG8_STAGE(PG8_SA(0, 1), a2 + hstep, voffA);
            PG8_WAIT_L(8); PG8_BAR; PG8_WAIT_L(0); PG8_MMA(0, 0, At, B0); PG8_BAR; PG8_SCHED;
            PG8_LDB(B1, 1, 1); PG8_STAGE(PG8_SB(1, 0), b3, voffB);
            PG8_BAR; PG8_WAIT_L(0); PG8_MMA(0, 1, At, B1); PG8_BAR;
            PG8_LDA(At, 1, 1); PG8_STAGE(PG8_SA(1, 0), a3, voffA);
            PG8_BAR; PG8_WAIT_L(0); PG8_MMA(1, 0, At, B0); PG8_BAR; PG8_SCHED;
            PG8_STAGE(PG8_SB(1, 1), b3 + hstep, voffB);
            PG8_WAIT_V(6); PG8_BAR; PG8_MMA(1, 1, At, B1); PG8_BAR;
            }
        }
        if constexpr (ALIGN_EPI) { if (wr == 0) PG8_BAR; }
        if constexpr (!Epi::AFTER_DRAIN) { E(acc, cur, wr, wc, fr, fq); S.done(cur); }
        if (!has_next) break;
#pragma unroll
        for (int a = 0; a < 2; ++a)
#pragma unroll
            for (int b = 0; b < 2; ++b)
#pragma unroll
                for (int m = 0; m < 4; ++m)
#pragma unroll
                    for (int n = 0; n < 2; ++n) acc[a][b][m][n] = (f32x4){0.f, 0.f, 0.f, 0.f};
        cur = nxt; cA = nA; cB = nB; ++ui;
        if constexpr (ALIGN_EPI) { if (wr == 1) PG8_BAR; }
    }
    PG8_WAIT_V(0);
    if constexpr (!ALIGN_EPI) { if (wr == 0) PG8_BAR; }
    PG8_BAR;
    if constexpr (Epi::AFTER_DRAIN) { E.fused(acc, cur, wr, wc, fr, fq, lds, wid, lane); S.done(cur); }
#undef PG8_SA
#undef PG8_SB
#undef PG8_STAGE
#undef PG8_LDA
#undef PG8_LDB
#undef PG8_MMA
#undef PG8_WAIT_V
#undef PG8_WAIT_L
#undef PG8_BAR
#undef PG8_SCHED
}
}

#define GAS __attribute__((address_space(1)))
#define LAS __attribute__((address_space(3)))
typedef unsigned short bf16;
typedef unsigned v4u __attribute__((ext_vector_type(4)));
typedef unsigned v2u __attribute__((ext_vector_type(2)));
typedef float f32x4 __attribute__((ext_vector_type(4)));
typedef short bf16x8 __attribute__((ext_vector_type(8)));
typedef short bf16x4 __attribute__((ext_vector_type(4)));

constexpr int NWAVES = 8;
constexpr int NB = 8, SEQ = 2048, D = 1024, M = NB * SEQ;
constexpr int PW = 2816, FF = 2816, NGU = 2 * FF;
constexpr int HH = 4, DK = 128, DV = 128, HW = 512;
constexpr int AH = 8, KVH = 2, AG = 4, HD = 64;
constexpr int C_Q = 0, C_F = 512, C_I = 1024, C_G = 1536, C_AQ = 2048, C_AK = 2560, C_AV = 2688;
constexpr float EPS = 1e-6f;

constexpr size_t MiB = 1u << 20;
constexpr size_t WS_CTL = 0;
constexpr size_t WS_WIN = 2 * MiB, WS_WOUT = 8 * MiB, WS_WGU = 10 * MiB, WS_WDN = 21 * MiB;
constexpr size_t WS_RSTD1 = 27 * MiB, WS_PART = 28 * MiB, WS_DTOT = 29 * MiB;
constexpr size_t WS_XB = 32 * MiB;
constexpr size_t WS_OLOC = 184 * MiB;
constexpr size_t WS_PROJ = 64 * MiB;
constexpr size_t WS_ACT = 64 * MiB;
constexpr size_t WS_MIXED = 152 * MiB;
constexpr size_t WS_HB = 184 * MiB;
constexpr size_t WS_LBUF = 216 * MiB;
constexpr size_t WS_QDS = 232 * MiB;
constexpr size_t WS_END = 256 * MiB;

constexpr int LDS_BYTES = 147456;

#define LDS_WAIT() asm volatile("s_waitcnt lgkmcnt(0)" ::: "memory")
#define VM_WAIT() asm volatile("s_waitcnt vmcnt(0)" ::: "memory")
__device__ __forceinline__ unsigned f2bf(float f) { unsigned u = __builtin_bit_cast(unsigned, f); return (u + 0x7fffu + ((u >> 16) & 1u)) >> 16; }
__device__ __forceinline__ unsigned pk2(float lo, float hi) { return f2bf(lo) | (f2bf(hi) << 16); }
__device__ __forceinline__ float bf2f(unsigned short b) { return __builtin_bit_cast(float, (unsigned)b << 16); }
__device__ __forceinline__ float bflo(unsigned w) { return __builtin_bit_cast(float, w << 16); }
__device__ __forceinline__ float bfhi(unsigned w) { return __builtin_bit_cast(float, w & 0xffff0000u); }
__device__ __forceinline__ float wave_sum(float v) {
#pragma unroll
    for (int o = 1; o < 64; o <<= 1) v += __shfl_xor(v, o);
    return v;
}
__device__ __forceinline__ float silu_f(float v) { return v / (1.0f + __expf(-v)); }

struct Frame {
    LAS unsigned char* lds;
    int tid, lane, wave, G;
    const float *x, *g1, *w_in, *lbl, *ogain, *qg, *kg, *sinks, *w_out, *g2, *w_gate, *w_up, *w_down;
    float* out;
    bf16 *WIN, *WOUT, *WGU, *WDN, *XB, *PROJ, *ACT, *MIXED, *HB, *QDS;
    float *RSTD1, *PART, *DTOT, *OLOC, *LBUF;
};

namespace pg8 {
struct EpiProj {
    static constexpr bool PERM = true, AFTER_DRAIN = false;
    bf16_t* O; const float* rstd; const float* lbl;
    __device__ __forceinline__ void operator()(const f32x4 (&acc)[2][2][4][2], const Unit& u, int wr, int wc, int fr, int fq) const {
        const int row0 = u.pm * BM + wr * 64 + fr;
#pragma unroll
        for (int bj = 0; bj < 2; ++bj) {
            const int col0 = u.pn * BM + bj * HALF + wc * 32 + 8 * fq;
            const int seg = __builtin_amdgcn_readfirstlane(col0 >> 9);
            float lb[8];
#pragma unroll
            for (int i = 0; i < 8; ++i) lb[i] = 0.f;
            if (seg == 1) {
                const int ci = col0 & 511;
#pragma unroll
                for (int i = 0; i < 8; ++i) { const float l0 = lbl[ci + i], l1 = lbl[512 + ci + i]; lb[i] = __builtin_amdgcn_rcpf(1.0f + __expf(l1 - l0)); }
            }
#pragma unroll
            for (int ai = 0; ai < 2; ++ai)
#pragma unroll
                for (int m = 0; m < 4; ++m) {
                    const int row = row0 + ai * HALF + m * 16; const float rs = rstd[row];
                    float v[8];
#pragma unroll
                    for (int i = 0; i < 4; ++i) { v[i] = acc[ai][bj][m][0][i] * rs; v[4 + i] = acc[ai][bj][m][1][i] * rs; }
                    if (seg == 0) {
#pragma unroll
                        for (int i = 0; i < 8; ++i) v[i] = v[i] * __builtin_amdgcn_rcpf(1.0f + __expf(-v[i])) * 0.08838834764831845f;
                    } else if (seg == 1) {
#pragma unroll
                        for (int i = 0; i < 8; ++i) { const float s = __builtin_amdgcn_rcpf(1.0f + __expf(-v[i])); v[i] = __logf(lb[i] + (1.0f - lb[i]) * s); }
                    } else if (seg == 3) {
#pragma unroll
                        for (int i = 0; i < 8; ++i) v[i] = v[i] * __builtin_amdgcn_rcpf(1.0f + __expf(-v[i]));
                    }
                    u32x4 w; w.x = cvt_pk_bf16(v[0], v[1]); w.y = cvt_pk_bf16(v[2], v[3]); w.z = cvt_pk_bf16(v[4], v[5]); w.w = cvt_pk_bf16(v[6], v[7]);
                    *(u32x4*)(O + (size_t)row * 2816 + col0) = w;
                }
        }
    }
};
struct EpiOut {
    static constexpr bool PERM = true, AFTER_DRAIN = false;
    const bf16_t* x; float* out; bf16_t* hb; float* part;
    __device__ __forceinline__ void operator()(const f32x4 (&acc)[2][2][4][2], const Unit& u, int wr, int wc, int fr, int fq) const {
        const int row0 = u.pm * BM + wr * 64 + fr;
#pragma unroll
        for (int ai = 0; ai < 2; ++ai)
#pragma unroll
            for (int m = 0; m < 4; ++m) {
                const int row = row0 + ai * HALF + m * 16; float ss = 0.f;
#pragma unroll
                for (int bj = 0; bj < 2; ++bj) {
                    const size_t off = (size_t)row * 1024 + u.pn * BM + bj * HALF + wc * 32 + 8 * fq;
                    const u32x4 xw = *(const u32x4*)(x + off);
                    f32x4 x0, x1;
                    x0[0] = __builtin_bit_cast(float, xw.x << 16); x0[1] = __builtin_bit_cast(float, xw.x & 0xffff0000u); x0[2] = __builtin_bit_cast(float, xw.y << 16); x0[3] = __builtin_bit_cast(float, xw.y & 0xffff0000u);
                    x1[0] = __builtin_bit_cast(float, xw.z << 16); x1[1] = __builtin_bit_cast(float, xw.z & 0xffff0000u); x1[2] = __builtin_bit_cast(float, xw.w << 16); x1[3] = __builtin_bit_cast(float, xw.w & 0xffff0000u);
                    const f32x4 h0 = x0 + acc[ai][bj][m][0], h1 = x1 + acc[ai][bj][m][1];
                    u32x4 w; w.x = cvt_pk_bf16(h0[0], h0[1]); w.y = cvt_pk_bf16(h0[2], h0[3]); w.z = cvt_pk_bf16(h1[0], h1[1]); w.w = cvt_pk_bf16(h1[2], h1[3]);
                    *(u32x4*)(hb + off) = w;
                    ss += ((h0[0] * h0[0] + h0[1] * h0[1]) + (h0[2] * h0[2] + h0[3] * h0[3])) + ((h1[0] * h1[0] + h1[1] * h1[1]) + (h1[2] * h1[2] + h1[3] * h1[3]));
                }
                ss += __shfl_xor(ss, 16); ss += __shfl_xor(ss, 32);
                if (fq == 0) part[(size_t)row * 16 + u.pn * 4 + wc] = ss;
            }
    }
};
struct EpiGU {
    static constexpr bool PERM = true, AFTER_DRAIN = false;
    bf16_t* O; const float* part;
    __device__ __forceinline__ void operator()(const f32x4 (&acc)[2][2][4][2], const Unit& u, int wr, int wc, int fr, int fq) const {
        const int row0 = u.pm * BM + wr * 64 + fr;
#pragma unroll
        for (int ai = 0; ai < 2; ++ai)
#pragma unroll
            for (int m = 0; m < 4; ++m) {
                const int row = row0 + ai * HALF + m * 16;
                const f32x4* pp = (const f32x4*)(part + (size_t)row * 16);
                const f32x4 p0 = pp[0], p1 = pp[1], p2 = pp[2], p3 = pp[3];
                const float ssq = ((p0[0] + p0[1]) + (p0[2] + p0[3])) + ((p1[0] + p1[1]) + (p1[2] + p1[3])) + ((p2[0] + p2[1]) + (p2[2] + p2[3])) + ((p3[0] + p3[1]) + (p3[2] + p3[3]));
                const float rs = __builtin_amdgcn_rsqf(ssq * (1.0f / 1024.0f) + 1e-6f);
                float v[8];
#pragma unroll
                for (int n = 0; n < 2; ++n)
#pragma unroll
                    for (int i = 0; i < 4; ++i) { const float g = acc[ai][0][m][n][i] * rs, up = acc[ai][1][m][n][i] * rs; v[4 * n + i] = g * __builtin_amdgcn_rcpf(1.0f + __expf(-g)) * up; }
                u32x4 w; w.x = cvt_pk_bf16(v[0], v[1]); w.y = cvt_pk_bf16(v[2], v[3]); w.z = cvt_pk_bf16(v[4], v[5]); w.w = cvt_pk_bf16(v[6], v[7]);
                *(u32x4*)(O + (size_t)row * 2816 + u.pn * HALF + wc * 32 + 8 * fq) = w;
            }
    }
};
struct EpiDown {
    static constexpr bool PERM = true, AFTER_DRAIN = false;
    float* out; const bf16_t* hb;
    __device__ __forceinline__ void operator()(const f32x4 (&acc)[2][2][4][2], const Unit& u, int wr, int wc, int fr, int fq) const {
        const int row0 = u.pm * BM + wr * 64 + fr;
#pragma unroll
        for (int ai = 0; ai < 2; ++ai)
#pragma unroll
            for (int m = 0; m < 4; ++m) {
                const int row = row0 + ai * HALF + m * 16;
#pragma unroll
                for (int bj = 0; bj < 2; ++bj) {
                    const size_t off = (size_t)row * 1024 + u.pn * BM + bj * HALF + wc * 32 + 8 * fq;
                    const u32x4 hw = *(const u32x4*)(hb + off);
                    f32x4 h0, h1;
                    h0[0] = __builtin_bit_cast(float, hw.x << 16); h0[1] = __builtin_bit_cast(float, hw.x & 0xffff0000u); h0[2] = __builtin_bit_cast(float, hw.y << 16); h0[3] = __builtin_bit_cast(float, hw.y & 0xffff0000u);
                    h1[0] = __builtin_bit_cast(float, hw.z << 16); h1[1] = __builtin_bit_cast(float, hw.z & 0xffff0000u); h1[2] = __builtin_bit_cast(float, hw.w << 16); h1[3] = __builtin_bit_cast(float, hw.w & 0xffff0000u);
                    __builtin_nontemporal_store(h0 + acc[ai][bj][m][0], (f32x4*)(out + off));
                    __builtin_nontemporal_store(h1 + acc[ai][bj][m][1], (f32x4*)(out + off + 4));
                }
            }
    }
};
}

__device__ __forceinline__ void p0_transpose_item(const float* W, int K, int N, bf16* WT, const float* gain, int mode, LAS float* scr, int item, int lane) {
    const int nblk = N / 32, kb = item / nblk, nb = item % nblk, k0 = 64 * kb, n0 = 32 * nb;
#pragma unroll 8
    for (int i = 0; i < 32; ++i) { const int kk = 2 * i + (lane >> 5); scr[kk * 33 + (lane & 31)] = __builtin_nontemporal_load(W + (size_t)(k0 + kk) * N + n0 + (lane & 31)); }
    LDS_WAIT(); asm volatile("" ::: "memory");
    const int c = lane & 7;
    float g[8];
#pragma unroll
    for (int i = 0; i < 8; ++i) g[i] = gain ? gain[k0 + 8 * c + i] : 1.0f;
    const int rbase = (mode == 0) ? n0 : (256 * (n0 >> 7) + (n0 & 127) + (mode == 2 ? 128 : 0));
#pragma unroll
    for (int j = 0; j < 4; ++j) { const int n = (lane >> 3) + 8 * j; const LAS float* s = scr + (8 * c) * 33 + n;
        v4u o; o.x = pk2(s[0 * 33] * g[0], s[1 * 33] * g[1]); o.y = pk2(s[2 * 33] * g[2], s[3 * 33] * g[3]); o.z = pk2(s[4 * 33] * g[4], s[5 * 33] * g[5]); o.w = pk2(s[6 * 33] * g[6], s[7 * 33] * g[7]);
        *(GAS v4u*)(WT + (size_t)(rbase + n) * K + k0 + 8 * c) = o; }
    LDS_WAIT(); asm volatile("" ::: "memory");
}
__device__ __forceinline__ void p0_weights_late(Frame& F, int first_block, int which) {
    int wv = threadIdx.x >> 6, ln = threadIdx.x & 63;
    asm volatile("" : "+v"(wv), "+v"(ln));
    wv = __builtin_amdgcn_readfirstlane(wv);
    LAS float* scr = (LAS float*)(F.lds + wv * 16384);
    const int gw = (blockIdx.x - first_block) * NWAVES + wv, NGW = (F.G - first_block) * NWAVES;
    constexpr int I_OUT = (D / 64) * (D / 32), I_G = (D / 64) * (FF / 32), I_DN = (FF / 64) * (D / 32);
    if (which == 0) {
        for (int it = gw; it < I_OUT + 2 * I_G; it += NGW) {
            int r = it;
            if (r < I_OUT) { p0_transpose_item(F.w_out, D, D, F.WOUT, nullptr, 0, scr, r, ln); continue; } r -= I_OUT;
            if (r < I_G) { p0_transpose_item(F.w_gate, D, FF, F.WGU, F.g2, 1, scr, r, ln); continue; } r -= I_G;
            p0_transpose_item(F.w_up, D, FF, F.WGU, F.g2, 2, scr, r, ln);
        }
    } else {
        for (int it = gw; it < I_DN; it += NGW) p0_transpose_item(F.w_down, FF, D, F.WDN, nullptr, 0, scr, it, ln);
    }
}
__device__ __forceinline__ void p0_prologue(Frame& F) {
    LAS float* scr = (LAS float*)(F.lds + F.wave * 16384);
    const int gw = blockIdx.x * NWAVES + F.wave, NGW = F.G * NWAVES;
    constexpr int I_IN = (D / 64) * (PW / 32);
    for (int it = gw; it < I_IN; it += NGW) p0_transpose_item(F.w_in, D, PW, F.WIN, F.g1, 0, scr, it, F.lane);
    for (int m = gw; m < M; m += NGW) {
        const GAS f32x4* xr = (const GAS f32x4*)(F.x + (size_t)m * D) + F.lane;
        f32x4 v[4]; float s = 0.f;
#pragma unroll
        for (int j = 0; j < 4; ++j) { v[j] = __builtin_nontemporal_load(xr + 64 * j); s += (v[j].x * v[j].x + v[j].y * v[j].y) + (v[j].z * v[j].z + v[j].w * v[j].w); }
        s = wave_sum(s);
        if (F.lane == 0) F.RSTD1[m] = 1.0f / sqrtf(s * (1.0f / D) + EPS);
        GAS unsigned long long* o8 = (GAS unsigned long long*)(F.XB + (size_t)m * D) + F.lane;
#pragma unroll
        for (int j = 0; j < 4; ++j) o8[64 * j] = (unsigned long long)pk2(v[j].x, v[j].y) | ((unsigned long long)pk2(v[j].z, v[j].w) << 32);
    }
}

#define XB_TMO      128
#define XB_XCNT(j)  (256  + 64 * (j))
#define XB_XSUB(j)  (1280 + 64 * (j))
#define XB_XGEN(j)  (2304 + 64 * (j))
#define XB_TOP      3328
#define XB_TOPGEN   3392
#define XCD_BAR_WORDS 3456
#define XB_SPIN_CAP (1u << 18)

__device__ __forceinline__ unsigned xb_ld(unsigned* p)              { return __hip_atomic_load(p, __ATOMIC_RELAXED, __HIP_MEMORY_SCOPE_AGENT); }
__device__ __forceinline__ unsigned xb_add(unsigned* p, unsigned v) { return __hip_atomic_fetch_add(p, v, __ATOMIC_RELAXED, __HIP_MEMORY_SCOPE_AGENT); }
__device__ __forceinline__ unsigned xb_xcc_id() { return (unsigned)__builtin_amdgcn_s_getreg((3 << 11) | 20) & 0xFu; }
#define XB_SPIN(cond, bar) do { unsigned _sp = 0; while (cond) { __builtin_amdgcn_s_sleep(1); \
    if ((++_sp & 255u) == 0u) { if (xb_ld(&(bar)[XB_TMO])) break; if (_sp > XB_SPIN_CAP) { atomicAdd(&(bar)[XB_TMO], 1u); break; } } } } while (0)

struct XcdBarrier {
    unsigned* bar; unsigned x;
    volatile LAS unsigned* st;
};

__device__ __forceinline__ XcdBarrier xcd_barrier_post(unsigned* bar, volatile LAS unsigned* st) {
    XcdBarrier b; b.bar = bar; b.x = xb_xcc_id(); b.st = st;
    if (threadIdx.x == 0) (void)xb_add(&bar[XB_XCNT(b.x)], 1u);
    return b;
}
__device__ __forceinline__ void xcd_barrier_complete(unsigned* bar, unsigned x, unsigned& nloc, unsigned& nx) {
    const unsigned G = gridDim.x * gridDim.y * gridDim.z;
    unsigned sum, cnt, mine, sp = 0u;
    for (;;) {
        sum = 0u; cnt = 0u; mine = 0u;
#pragma unroll
        for (unsigned j = 0; j < 16; ++j) { const unsigned c = xb_ld(&bar[XB_XCNT(j)]); sum += c; cnt += (c > 0u) ? 1u : 0u; mine = (j == x) ? c : mine; }
        if (sum == G) break;
        __builtin_amdgcn_s_sleep(1);
        if ((++sp & 255u) == 0u) { if (xb_ld(&bar[XB_TMO])) break; if (sp > XB_SPIN_CAP) { atomicAdd(&bar[XB_TMO], 1u); break; } }
    }
    nloc = mine > 0u ? mine : 1u; nx = cnt > 0u ? cnt : 1u;
}

__device__ __forceinline__ void xcd_barrier(const XcdBarrier& b) {
    asm volatile("s_waitcnt vmcnt(0)" ::: "memory");
    __syncthreads();
    if (threadIdx.x == 0) {
        unsigned* bar = b.bar;
        __builtin_amdgcn_s_waitcnt(0);
        unsigned nloc = b.st[0], nx = b.st[1];
        if (nloc == 0u) { xcd_barrier_complete(bar, b.x, nloc, nx); b.st[0] = nloc; b.st[1] = nx; }
        const unsigned old = xb_add(&bar[XB_XSUB(b.x)], 1u);
        const unsigned gen = old / nloc;
        if (old + 1u == (gen + 1u) * nloc) {
            __builtin_amdgcn_fence(__ATOMIC_RELEASE, "agent");
            asm volatile("s_waitcnt vmcnt(0)" ::: "memory");
            const unsigned og = xb_add(&bar[XB_TOP], 1u);
            const unsigned tg = og / nx;
            if (og + 1u == (tg + 1u) * nx) xb_add(&bar[XB_TOPGEN], 1u);
            else XB_SPIN(xb_ld(&bar[XB_TOPGEN]) == tg, bar);
            __builtin_amdgcn_fence(__ATOMIC_ACQUIRE, "agent");
            xb_add(&bar[XB_XGEN(b.x)], 1u);
            asm volatile("s_waitcnt vmcnt(0)" ::: "memory");
        } else {
            XB_SPIN(xb_ld(&bar[XB_XGEN(b.x)]) == gen, bar);
            __builtin_amdgcn_fence(__ATOMIC_ACQUIRE, "agent");
            asm volatile("s_waitcnt vmcnt(0)" ::: "memory");
        }
    }
    __syncthreads();
}
#define NAIVE_ATTN 0
#define NAIVE_HGRN 0

__device__ __forceinline__ void hgrn_naive(Frame& F) {
    if (blockIdx.x >= 64 || F.wave != 0) return;
    const int item = blockIdx.x; const int b = item >> 3, h = (item >> 1) & 3, v = (item & 1) * 64 + F.lane;
    float S[128];
#pragma unroll
    for (int c = 0; c < 128; ++c) S[c] = 0.f;
    for (int t = 0; t < SEQ; ++t) {
        const size_t row = (size_t)b * SEQ + t; const bf16* pr = F.PROJ + row * PW;
        const float vv = bf2f(pr[C_I + h * 128 + v]);
        float o = 0.f;
#pragma unroll
        for (int c8 = 0; c8 < 16; ++c8) {
            const v4u qw = *(const v4u*)(pr + C_Q + h * 128 + c8 * 8); const v4u fw = *(const v4u*)(pr + C_F + h * 128 + c8 * 8);
#pragma unroll
            for (int i = 0; i < 4; ++i) {
                const float q0 = bflo(qw[i]), q1 = bfhi(qw[i]); const float f0 = __expf(bflo(fw[i])), f1 = __expf(bfhi(fw[i]));
                S[c8 * 8 + 2 * i] = f0 * S[c8 * 8 + 2 * i] + (1.0f - f0) * vv; o += q0 * S[c8 * 8 + 2 * i];
                S[c8 * 8 + 2 * i + 1] = f1 * S[c8 * 8 + 2 * i + 1] + (1.0f - f1) * vv; o += q1 * S[c8 * 8 + 2 * i + 1];
            }
        }
        F.OLOC[row * 512 + h * 128 + v] = o;
    }
}
__device__ __forceinline__ void attn_naive(Frame& F) {
    for (int id = blockIdx.x * 512 + F.tid; id < NB * AH * SEQ; id += F.G * 512) {
        const int t = id & 2047, qh = (id >> 11) & 7, b = id >> 14, kvh = qh >> 2;
        const size_t row = (size_t)b * SEQ + t;
        float q[64]; float ss = 0.f;
        { const bf16* qr = F.PROJ + row * PW + C_AQ + qh * 64;
#pragma unroll
          for (int d8 = 0; d8 < 8; ++d8) { const v4u w = *(const v4u*)(qr + d8 * 8);
#pragma unroll
              for (int i = 0; i < 4; ++i) { q[d8 * 8 + 2 * i] = bflo(w[i]); q[d8 * 8 + 2 * i + 1] = bfhi(w[i]); } }
#pragma unroll
          for (int d = 0; d < 64; ++d) ss += q[d] * q[d];
          const float rs = 1.0f / sqrtf(ss * (1.0f / 64.0f) + EPS);
#pragma unroll
          for (int d = 0; d < 64; ++d) q[d] = q[d] * rs * F.qg[d] * 0.125f * F.kg[d]; }
        float m = F.sinks[qh], l = 1.0f; float acc[64];
#pragma unroll
        for (int d = 0; d < 64; ++d) acc[d] = 0.f;
        const int k0 = t - 127 < 0 ? 0 : t - 127;
        for (int kp = k0; kp <= t; ++kp) {
            const bf16* kr = F.PROJ + ((size_t)b * SEQ + kp) * PW + C_AK + kvh * 64;
            float kss = 0.f, dot = 0.f;
#pragma unroll
            for (int d8 = 0; d8 < 8; ++d8) { const v4u w = *(const v4u*)(kr + d8 * 8);
#pragma unroll
                for (int i = 0; i < 4; ++i) { const float a = bflo(w[i]), c = bfhi(w[i]); kss += a * a + c * c; dot += q[d8 * 8 + 2 * i] * a + q[d8 * 8 + 2 * i + 1] * c; } }
            const float s = dot / sqrtf(kss * (1.0f / 64.0f) + EPS);
            const float mn = fmaxf(m, s), sc = __expf(m - mn), p = __expf(s - mn);
            l = l * sc + p; m = mn;
            const bf16* vr = F.PROJ + ((size_t)b * SEQ + kp) * PW + C_AV + kvh * 64;
#pragma unroll
            for (int d8 = 0; d8 < 8; ++d8) { const v4u w = *(const v4u*)(vr + d8 * 8);
#pragma unroll
                for (int i = 0; i < 4; ++i) { acc[d8 * 8 + 2 * i] = acc[d8 * 8 + 2 * i] * sc + p * bflo(w[i]); acc[d8 * 8 + 2 * i + 1] = acc[d8 * 8 + 2 * i + 1] * sc + p * bfhi(w[i]); } }
        }
        const float il = 1.0f / l;
        bf16* orow = F.MIXED + row * D + 512 + qh * 64;
#pragma unroll
        for (int d8 = 0; d8 < 8; ++d8) { v4u w;
#pragma unroll
            for (int i = 0; i < 4; ++i) w[i] = pk2(acc[d8 * 8 + 2 * i] * il, acc[d8 * 8 + 2 * i + 1] * il);
            *(v4u*)(orow + d8 * 8) = w; }
    }
}
__device__ __forceinline__ void hgrn_norm_naive(Frame& F) {
    const int gw = blockIdx.x * NWAVES + F.wave, NGW = F.G * NWAVES;
    for (int it = gw; it < M * 4; it += NGW) {
        const int row = it >> 2, h = it & 3;
        const float* o = F.OLOC + (size_t)row * 512 + h * 128;
        const float a = o[F.lane], c = o[64 + F.lane];
        const float ss = wave_sum(a * a + c * c); const float rs = 1.0f / sqrtf(ss * (1.0f / 128.0f) + EPS);
        const bf16* gr = F.PROJ + (size_t)row * PW + C_G + h * 128;
        bf16* mr = F.MIXED + (size_t)row * D + h * 128;
        mr[F.lane] = (bf16)f2bf(a * rs * F.ogain[F.lane] * bf2f(gr[F.lane]));
        mr[64 + F.lane] = (bf16)f2bf(c * rs * F.ogain[64 + F.lane] * bf2f(gr[64 + F.lane]));
    }
}

#ifndef PROBE_DUP
#define PROBE_DUP 0
#endif
#ifndef HGRN_WS
#define HGRN_WS 1
#endif
__device__ __forceinline__ bf16x8 pack8(const f32x4 a, const f32x4 b) {
    v4u w; w.x = pg8::cvt_pk_native(a[0], a[1]); w.y = pg8::cvt_pk_native(a[2], a[3]); w.z = pg8::cvt_pk_native(b[0], b[1]); w.w = pg8::cvt_pk_native(b[2], b[3]);
    return __builtin_bit_cast(bf16x8, w);
}
__device__ __forceinline__ bf16x8 join8(const v2u lo, const v2u hi) { v4u w; w.x = lo.x; w.y = lo.y; w.z = hi.x; w.w = hi.y; return __builtin_bit_cast(bf16x8, w); }
#define MFMA16(a, b, c) __builtin_amdgcn_mfma_f32_16x16x32_bf16((a), (b), (c), 0, 0, 0)
#define LDS_BARRIER() do { asm volatile("s_waitcnt lgkmcnt(0)" ::: "memory"); __builtin_amdgcn_s_barrier(); asm volatile("" ::: "memory"); } while (0)

constexpr int KS_STRIDE = 72, VT2_STRIDE = 264;
constexpr int AT_KS = 0, AT_VT = 256 * KS_STRIDE * 2;
__device__ __forceinline__ void attn_item(Frame& F, int item) {
    const int b = item >> 5, kvh = (item >> 4) & 1, qb = item & 15, p0 = qb * 128;
    const int tid = F.tid, lane = F.lane, w = F.wave, quad = lane >> 4, l15 = lane & 15;
    LAS bf16* Ks = (LAS bf16*)(F.lds + AT_KS); LAS bf16* Vt = (LAS bf16*)(F.lds + AT_VT);
    const size_t row = (size_t)b * SEQ + p0 + 16 * w + l15;
    {
        const int key = tid >> 1, half = tid & 1, pos = p0 - 128 + key;
        v4u kw[4], vw[4];
        if (pos >= 0) {
            const v4u* kr = (const v4u*)(F.PROJ + ((size_t)b * SEQ + pos) * PW + C_AK + kvh * 64 + half * 32);
            const v4u* vr = (const v4u*)(F.PROJ + ((size_t)b * SEQ + pos) * PW + C_AV + kvh * 64 + half * 32);
#pragma unroll
            for (int i = 0; i < 4; ++i) { kw[i] = kr[i]; vw[i] = vr[i]; }
        } else {
#pragma unroll
            for (int i = 0; i < 4; ++i) { kw[i] = (v4u){0u, 0u, 0u, 0u}; vw[i] = (v4u){0u, 0u, 0u, 0u}; }
        }
        float ss = 0.f;
#pragma unroll
        for (int i = 0; i < 4; ++i)
#pragma unroll
            for (int j = 0; j < 4; ++j) { const float a = bflo(kw[i][j]), c = bfhi(kw[i][j]); ss += a * a + c * c; }
        ss += __shfl_xor(ss, 1);
        const float rs = 1.0f / sqrtf(ss * (1.0f / 64.0f) + EPS);
#pragma unroll
        for (int i = 0; i < 4; ++i) {
            const f32x4 g0 = *(const f32x4*)(F.kg + half * 32 + 8 * i), g1 = *(const f32x4*)(F.kg + half * 32 + 8 * i + 4);
            v4u o;
            o.x = pk2(bflo(kw[i][0]) * rs * g0[0], bfhi(kw[i][0]) * rs * g0[1]); o.y = pk2(bflo(kw[i][1]) * rs * g0[2], bfhi(kw[i][1]) * rs * g0[3]);
            o.z = pk2(bflo(kw[i][2]) * rs * g1[0], bfhi(kw[i][2]) * rs * g1[1]); o.w = pk2(bflo(kw[i][3]) * rs * g1[2], bfhi(kw[i][3]) * rs * g1[3]);
            *(LAS v4u*)(Ks + key * KS_STRIDE + half * 32 + 8 * i) = o;
#pragma unroll
            for (int j = 0; j < 4; ++j) {
                Vt[(half * 32 + 8 * i + 2 * j) * VT2_STRIDE + key] = (bf16)(vw[i][j] & 0xffffu);
                Vt[(half * 32 + 8 * i + 2 * j + 1) * VT2_STRIDE + key] = (bf16)(vw[i][j] >> 16);
            }
        }
    }
    __syncthreads();
    bf16x8 kf[9][2];
#pragma unroll
    for (int kt = 0; kt < 9; ++kt)
#pragma unroll
        for (int ks = 0; ks < 2; ++ks) kf[kt][ks] = *(const LAS bf16x8*)(Ks + (16 * w + 16 * kt + l15) * KS_STRIDE + 32 * ks + 8 * quad);
    const float NEG = -1e30f;
    for (int g = 0; g < AG; ++g) {
        const int qh = kvh * AG + g;
        bf16x8 bq[2];
        {
            v4u qw[2]; float ss = 0.f;
#pragma unroll
            for (int ks = 0; ks < 2; ++ks) { qw[ks] = *(const v4u*)(F.PROJ + row * PW + C_AQ + qh * 64 + 32 * ks + 8 * quad);
#pragma unroll
                for (int j = 0; j < 4; ++j) { const float a = bflo(qw[ks][j]), c = bfhi(qw[ks][j]); ss += a * a + c * c; } }
            ss += __shfl_xor(ss, 16); ss += __shfl_xor(ss, 32);
            const float rs = 0.125f / sqrtf(ss * (1.0f / 64.0f) + EPS);
#pragma unroll
            for (int ks = 0; ks < 2; ++ks) {
                const f32x4 g0 = *(const f32x4*)(F.qg + 32 * ks + 8 * quad), g1 = *(const f32x4*)(F.qg + 32 * ks + 8 * quad + 4);
                v4u o;
                o.x = pk2(bflo(qw[ks][0]) * rs * g0[0], bfhi(qw[ks][0]) * rs * g0[1]); o.y = pk2(bflo(qw[ks][1]) * rs * g0[2], bfhi(qw[ks][1]) * rs * g0[3]);
                o.z = pk2(bflo(qw[ks][2]) * rs * g1[0], bfhi(qw[ks][2]) * rs * g1[1]); o.w = pk2(bflo(qw[ks][3]) * rs * g1[2], bfhi(qw[ks][3]) * rs * g1[3]);
                bq[ks] = __builtin_bit_cast(bf16x8, o);
            }
        }
        f32x4 sc[9];
#pragma unroll
        for (int kt = 0; kt < 9; ++kt) { sc[kt] = (f32x4){0.f, 0.f, 0.f, 0.f};
#pragma unroll
            for (int ks = 0; ks < 2; ++ks) sc[kt] = MFMA16(kf[kt][ks], bq[ks], sc[kt]); }
#pragma unroll
        for (int r = 0; r < 4; ++r) { if (!(l15 < 4 * quad + r)) sc[0][r] = NEG; if (!(l15 >= 4 * quad + r)) sc[8][r] = NEG; }
        if (qb == 0) {
#pragma unroll
            for (int kt = 0; kt < 9; ++kt)
#pragma unroll
                for (int r = 0; r < 4; ++r) if (16 * w + 16 * kt + 4 * quad + r < 128) sc[kt][r] = NEG;
        }
        const float sink = F.sinks[qh];
        float m = sink;
#pragma unroll
        for (int kt = 0; kt < 9; ++kt)
#pragma unroll
            for (int r = 0; r < 4; ++r) m = fmaxf(m, sc[kt][r]);
        m = fmaxf(m, __shfl_xor(m, 16)); m = fmaxf(m, __shfl_xor(m, 32));
        float l = 0.f;
#pragma unroll
        for (int kt = 0; kt < 9; ++kt)
#pragma unroll
            for (int r = 0; r < 4; ++r) { const float p = __expf(sc[kt][r] - m); sc[kt][r] = p; l += p; }
        l += __shfl_xor(l, 16); l += __shfl_xor(l, 32);
        l += __expf(sink - m);
        const float il = 1.0f / l;
        bf16x8 pf[5];
#pragma unroll
        for (int kk = 0; kk < 4; ++kk) pf[kk] = pack8(sc[2 * kk], sc[2 * kk + 1]);
        pf[4] = pack8(sc[8], (f32x4){0.f, 0.f, 0.f, 0.f});
#pragma unroll
        for (int dt = 0; dt < 4; ++dt) {
            f32x4 o = (f32x4){0.f, 0.f, 0.f, 0.f};
            const LAS bf16* vrow = Vt + (16 * dt + l15) * VT2_STRIDE + 16 * w + 4 * quad;
#pragma unroll
            for (int kk = 0; kk < 5; ++kk) {
                const v2u lo = *(const LAS v2u*)(vrow + 32 * kk);
                v2u hi = (v2u){0u, 0u}; if (kk < 4) hi = *(const LAS v2u*)(vrow + 32 * kk + 16);
                o = MFMA16(join8(lo, hi), pf[kk], o);
            }
            v2u ow; ow.x = pk2(o[0] * il, o[1] * il); ow.y = pk2(o[2] * il, o[3] * il);
            *(v2u*)(F.MIXED + row * D + 512 + qh * 64 + 16 * dt + 4 * quad) = ow;
        }
    }
    __syncthreads();
}

constexpr int QD_STRIDE = 136, KT_STRIDE = 40;
#define QDOFF(t) ((t) * QD_STRIDE + ((t) >> 3) * 16)
#define VTOFF(v) ((v) * KT_STRIDE + ((v) >> 3) * 32)
constexpr int HB_QD = 0, HB_KH = 8832, HB_KDT = 17664, HB_VT = 27904, HB_DEC = 39104, HB_BYTES = 39616;
static_assert(31 * QD_STRIDE + 3 * 16 + 128 <= (HB_KH - HB_QD) / 2 && 127 * KT_STRIDE + 15 * 32 + 32 <= (HB_DEC - HB_VT) / 2 && 128 * KT_STRIDE * 2 <= HB_VT - HB_KDT && 2 * HB_BYTES <= 131072, "HGRN LDS map");
__device__ __forceinline__ void hgrn_local(Frame& F, int item) {
    const int b = item >> 5, h = (item >> 3) & 3, seg = item & 7;
    const int tid = F.tid, lane = F.lane, w = F.wave, quad = lane >> 4, l15 = lane & 15;
    const int c = tid >> 2, part = tid & 3;
    const int vt_t = tid & 31, vt_v8 = tid >> 5;
    const size_t row0 = (size_t)b * SEQ + seg * 256;
    const bf16* pq = F.PROJ + row0 * PW + C_Q + h * 128 + c;
    const bf16* pf = F.PROJ + row0 * PW + C_F + h * 128 + c;
    const bf16* pv = F.PROJ + row0 * PW + C_I + h * 128 + vt_v8 * 8;
    f32x4 S[8];
#pragma unroll
    for (int i = 0; i < 8; ++i) S[i] = (f32x4){0.f, 0.f, 0.f, 0.f};
    float Bprev = 0.f;
    bf16 rq[8], rf[8]; v4u rv;
#define HG_LOAD_RAW(ch) do { _Pragma("unroll") for (int j = 0; j < 8; ++j) { const size_t t_ = (size_t)((ch) * 32 + 8 * part + j); rq[j] = pq[t_ * PW]; rf[j] = pf[t_ * PW]; } \
        rv = *(const v4u*)(pv + (size_t)((ch) * 32 + vt_t) * PW); } while (0)
#define HG_ELEM(ch) do { \
        LAS unsigned char* bb_ = F.lds + ((ch) & 1) * HB_BYTES; \
        LAS bf16* QD_ = (LAS bf16*)(bb_ + HB_QD); LAS bf16* KH_ = (LAS bf16*)(bb_ + HB_KH); LAS bf16* KDT_ = (LAS bf16*)(bb_ + HB_KDT); LAS bf16* VT_ = (LAS bf16*)(bb_ + HB_VT); LAS float* DEC_ = (LAS float*)(bb_ + HB_DEC); \
        float lf_[8], bl_[8]; float run_ = 0.f; \
        _Pragma("unroll") for (int j = 0; j < 8; ++j) { lf_[j] = bf2f(rf[j]); run_ += lf_[j]; bl_[j] = run_; } \
        const int b4_ = lane & ~3; \
        const float t0_ = __shfl(run_, b4_), t1_ = __shfl(run_, b4_ + 1), t2_ = __shfl(run_, b4_ + 2), t3_ = __shfl(run_, b4_ + 3); \
        const float pre_ = (part > 0 ? t0_ : 0.f) + (part > 1 ? t1_ : 0.f) + (part > 2 ? t2_ : 0.f); \
        const float btot_ = (t0_ + t1_) + (t2_ + t3_); \
        const float eprev_ = __expf(Bprev); \
        float kd_[8]; const float ebtot_ = __expf(btot_); float eip_ = __builtin_amdgcn_rcpf(__expf(pre_)); \
        _Pragma("unroll") for (int j = 0; j < 8; ++j) { const int t_ = 8 * part + j; const float bt_ = pre_ + bl_[j]; \
            const float e_ = __expf(bt_), ei_ = __builtin_amdgcn_rcpf(e_); \
            const float k_ = 1.0f - e_ * eip_; eip_ = ei_; const float qd_ = bf2f(rq[j]) * e_; const float kh_ = k_ * ei_; \
            const unsigned pw_ = pg8::cvt_pk_native(qd_, kh_); \
            QD_[QDOFF(t_) + c] = (bf16)(pw_ & 0xffffu); KH_[QDOFF(t_) + c] = (bf16)(pw_ >> 16); kd_[j] = kh_ * ebtot_; \
            F.QDS[(row0 + (size_t)((ch) * 32 + t_)) * 512 + h * 128 + c] = (bf16)f2bf(qd_ * eprev_); } \
        { v4u o_; o_.x = pk2(kd_[0], kd_[1]); o_.y = pk2(kd_[2], kd_[3]); o_.z = pk2(kd_[4], kd_[5]); o_.w = pk2(kd_[6], kd_[7]); *(LAS v4u*)(KDT_ + c * KT_STRIDE + 8 * part) = o_; } \
        if (part == 0) DEC_[c] = ebtot_; \
        Bprev += btot_; \
        _Pragma("unroll") for (int i = 0; i < 4; ++i) { VT_[VTOFF(8 * vt_v8 + 2 * i) + vt_t] = (bf16)(rv[i] & 0xffffu); VT_[VTOFF(8 * vt_v8 + 2 * i + 1) + vt_t] = (bf16)(rv[i] >> 16); } \
    } while (0)

    HG_LOAD_RAW(0);
    HG_ELEM(0);
    HG_LOAD_RAW(1);
    LDS_BARRIER();
    for (int ch = 0; ch < 8; ++ch) {
        if (ch + 1 < 8) { HG_ELEM(ch + 1); if (ch + 2 < 8) HG_LOAD_RAW(ch + 2); }
        const LAS unsigned char* bb = F.lds + (ch & 1) * HB_BYTES;
        const LAS bf16* QD = (const LAS bf16*)(bb + HB_QD); const LAS bf16* KH = (const LAS bf16*)(bb + HB_KH); const LAS bf16* KDT = (const LAS bf16*)(bb + HB_KDT);
        const LAS bf16* VT = (const LAS bf16*)(bb + HB_VT); const LAS float* DEC = (const LAS float*)(bb + HB_DEC);
        f32x4 T00 = (f32x4){0.f, 0.f, 0.f, 0.f}, T01 = T00, T11 = T00;
#pragma unroll
        for (int kk = 0; kk < 4; ++kk) {
            const bf16x8 kh0 = *(const LAS bf16x8*)(KH + QDOFF(l15) + 32 * kk + 8 * quad), kh1 = *(const LAS bf16x8*)(KH + QDOFF(16 + l15) + 32 * kk + 8 * quad);
            const bf16x8 q0 = *(const LAS bf16x8*)(QD + QDOFF(l15) + 32 * kk + 8 * quad), q1 = *(const LAS bf16x8*)(QD + QDOFF(16 + l15) + 32 * kk + 8 * quad);
            T00 = MFMA16(kh0, q0, T00); T01 = MFMA16(kh0, q1, T01); T11 = MFMA16(kh1, q1, T11);
        }
#pragma unroll
        for (int r = 0; r < 4; ++r) { if (4 * quad + r > l15) { T00[r] = 0.f; T11[r] = 0.f; } }
        const bf16x8 a0 = pack8(T00, (f32x4){0.f, 0.f, 0.f, 0.f}), a1 = pack8(T01, T11);
        const LAS bf16* vrow = VT + VTOFF(16 * w + l15);
        const bf16x8 bv = join8(*(const LAS v2u*)(vrow + 4 * quad), *(const LAS v2u*)(vrow + 16 + 4 * quad));
        f32x4 O0 = (f32x4){0.f, 0.f, 0.f, 0.f}, O1 = O0;
#pragma unroll
        for (int kk = 0; kk < 4; ++kk) {
            const bf16x8 aq0 = join8(*(const LAS v2u*)(QD + QDOFF(l15) + 32 * kk + 4 * quad), *(const LAS v2u*)(QD + QDOFF(l15) + 32 * kk + 16 + 4 * quad));
            const bf16x8 aq1 = join8(*(const LAS v2u*)(QD + QDOFF(16 + l15) + 32 * kk + 4 * quad), *(const LAS v2u*)(QD + QDOFF(16 + l15) + 32 * kk + 16 + 4 * quad));
            const bf16x8 bs = pack8(S[2 * kk], S[2 * kk + 1]);
            O0 = MFMA16(aq0, bs, O0); O1 = MFMA16(aq1, bs, O1);
        }
        O0 = MFMA16(a0, bv, O0); O1 = MFMA16(a1, bv, O1);
        {
            float* op = F.OLOC + (row0 + (size_t)(ch * 32 + 4 * quad)) * 512 + h * 128 + 16 * w + l15;
#pragma unroll
            for (int r = 0; r < 4; ++r) { op[(size_t)r * 512] = O0[r]; op[(size_t)(16 + r) * 512] = O1[r]; }
        }
        const bf16x8 bvn = *(const LAS bf16x8*)(vrow + 8 * quad);
#pragma unroll
        for (int tc = 0; tc < 8; ++tc) {
            const f32x4 dec = *(const LAS f32x4*)(DEC + 16 * tc + 4 * quad);
            S[tc] = S[tc] * dec;
            const bf16x8 ak = *(const LAS bf16x8*)(KDT + (16 * tc + l15) * KT_STRIDE + 8 * quad);
            S[tc] = MFMA16(ak, bvn, S[tc]);
        }
        LDS_BARRIER();
    }
#undef HG_LOAD_RAW
#undef HG_ELEM
    {
        f32x4* Lp = (f32x4*)F.LBUF + (size_t)(item * 8 + w) * 8 * 64 + lane;
#pragma unroll
        for (int tc = 0; tc < 8; ++tc) {
            const f32x4 val = S[tc] + 0.0f;
            asm volatile("global_store_dwordx4 %0, %1, off sc0 sc1\n\ts_nop 1" :: "v"(Lp + tc * 64), "v"(val) : "memory");
        }
        if (part == 0) { const float val = __expf(Bprev); asm volatile("global_store_dword %0, %1, off sc0 sc1" :: "v"(F.DTOT + item * 128 + c), "v"(val) : "memory"); }
    }
}
__device__ __forceinline__ void hgrn_local_ws2(Frame& F, int item) {
    const int b = item >> 5, h = (item >> 3) & 3, seg = item & 7;
    const int tid = F.tid, lane = F.lane, w = F.wave, quad = lane >> 4, l15 = lane & 15;
    const int c = tid >> 2, part = tid & 3;
    const int vt_t = tid & 31, vt_v8 = tid >> 5;
    const size_t row0 = (size_t)b * SEQ + seg * 256;
    const bf16* pq = F.PROJ + row0 * PW + C_Q + h * 128 + c;
    const bf16* pf = F.PROJ + row0 * PW + C_F + h * 128 + c;
    const bf16* pv = F.PROJ + row0 * PW + C_I + h * 128 + vt_v8 * 8;
    f32x4 S[2][8];
#pragma unroll
    for (int g = 0; g < 2; ++g)
#pragma unroll
        for (int i = 0; i < 8; ++i) S[g][i] = (f32x4){0.f, 0.f, 0.f, 0.f};
    float Bprev = 0.f;
    bf16 rq[8], rf[8]; v4u rv;
#define HG_LOAD_RAW(ch) do { _Pragma("unroll") for (int j = 0; j < 8; ++j) { const size_t t_ = (size_t)((ch) * 32 + 8 * part + j); rq[j] = pq[t_ * PW]; rf[j] = pf[t_ * PW]; } \
        rv = *(const v4u*)(pv + (size_t)((ch) * 32 + vt_t) * PW); } while (0)
#define HG_ELEM(ch) do { \
        LAS unsigned char* bb_ = F.lds + ((ch) & 1) * HB_BYTES; \
        LAS bf16* QD_ = (LAS bf16*)(bb_ + HB_QD); LAS bf16* KH_ = (LAS bf16*)(bb_ + HB_KH); LAS bf16* KDT_ = (LAS bf16*)(bb_ + HB_KDT); LAS bf16* VT_ = (LAS bf16*)(bb_ + HB_VT); LAS float* DEC_ = (LAS float*)(bb_ + HB_DEC); \
        float lf_[8], bl_[8]; float run_ = 0.f; \
        _Pragma("unroll") for (int j = 0; j < 8; ++j) { lf_[j] = bf2f(rf[j]); run_ += lf_[j]; bl_[j] = run_; } \
        const int b4_ = lane & ~3; \
        const float t0_ = __shfl(run_, b4_), t1_ = __shfl(run_, b4_ + 1), t2_ = __shfl(run_, b4_ + 2), t3_ = __shfl(run_, b4_ + 3); \
        const float pre_ = (part > 0 ? t0_ : 0.f) + (part > 1 ? t1_ : 0.f) + (part > 2 ? t2_ : 0.f); \
        const float btot_ = (t0_ + t1_) + (t2_ + t3_); \
        const float eprev_ = __expf(Bprev); \
        float kd_[8]; const float ebtot_ = __expf(btot_); float eip_ = __builtin_amdgcn_rcpf(__expf(pre_)); \
        _Pragma("unroll") for (int j = 0; j < 8; ++j) { const int t_ = 8 * part + j; const float bt_ = pre_ + bl_[j]; \
            const float e_ = __expf(bt_), ei_ = __builtin_amdgcn_rcpf(e_); \
            const float k_ = 1.0f - e_ * eip_; eip_ = ei_; const float qd_ = bf2f(rq[j]) * e_; const float kh_ = k_ * ei_; \
            const unsigned pw_ = pg8::cvt_pk_native(qd_, kh_); \
            QD_[QDOFF(t_) + c] = (bf16)(pw_ & 0xffffu); KH_[QDOFF(t_) + c] = (bf16)(pw_ >> 16); kd_[j] = kh_ * ebtot_; \
            F.QDS[(row0 + (size_t)((ch) * 32 + t_)) * 512 + h * 128 + c] = (bf16)f2bf(qd_ * eprev_); } \
        { v4u o_; o_.x = pk2(kd_[0], kd_[1]); o_.y = pk2(kd_[2], kd_[3]); o_.z = pk2(kd_[4], kd_[5]); o_.w = pk2(kd_[6], kd_[7]); *(LAS v4u*)(KDT_ + c * KT_STRIDE + 8 * part) = o_; } \
        if (part == 0) DEC_[c] = ebtot_; \
        Bprev += btot_; \
        _Pragma("unroll") for (int i = 0; i < 4; ++i) { VT_[VTOFF(8 * vt_v8 + 2 * i) + vt_t] = (bf16)(rv[i] & 0xffffu); VT_[VTOFF(8 * vt_v8 + 2 * i + 1) + vt_t] = (bf16)(rv[i] >> 16); } \
    } while (0)

    HG_LOAD_RAW(0);
    HG_ELEM(0);
    HG_LOAD_RAW(1);
    LDS_BARRIER();
    for (int ch = 0; ch < 8; ++ch) {
        if (w >= 4) { if (ch + 1 < 8) { HG_ELEM(ch + 1); if (ch + 2 < 8) HG_LOAD_RAW(ch + 2); } }
        if (w < 4) {
            const LAS unsigned char* bb = F.lds + (ch & 1) * HB_BYTES;
            const LAS bf16* QD = (const LAS bf16*)(bb + HB_QD); const LAS bf16* KH = (const LAS bf16*)(bb + HB_KH); const LAS bf16* KDT = (const LAS bf16*)(bb + HB_KDT);
            const LAS bf16* VT = (const LAS bf16*)(bb + HB_VT); const LAS float* DEC = (const LAS float*)(bb + HB_DEC);
            f32x4 T00 = (f32x4){0.f, 0.f, 0.f, 0.f}, T01 = T00, T11 = T00;
#pragma unroll
            for (int kk = 0; kk < 4; ++kk) {
                const bf16x8 kh0 = *(const LAS bf16x8*)(KH + QDOFF(l15) + 32 * kk + 8 * quad), kh1 = *(const LAS bf16x8*)(KH + QDOFF(16 + l15) + 32 * kk + 8 * quad);
                const bf16x8 q0 = *(const LAS bf16x8*)(QD + QDOFF(l15) + 32 * kk + 8 * quad), q1 = *(const LAS bf16x8*)(QD + QDOFF(16 + l15) + 32 * kk + 8 * quad);
                T00 = MFMA16(kh0, q0, T00); T01 = MFMA16(kh0, q1, T01); T11 = MFMA16(kh1, q1, T11);
            }
#pragma unroll
            for (int r = 0; r < 4; ++r) { if (4 * quad + r > l15) { T00[r] = 0.f; T11[r] = 0.f; } }
            const bf16x8 a0 = pack8(T00, (f32x4){0.f, 0.f, 0.f, 0.f}), a1 = pack8(T01, T11);
            f32x4 O[2][2];
#pragma unroll
            for (int g = 0; g < 2; ++g) { O[g][0] = (f32x4){0.f, 0.f, 0.f, 0.f}; O[g][1] = O[g][0]; }
#pragma unroll
            for (int kk = 0; kk < 4; ++kk) {
                const bf16x8 aq0 = join8(*(const LAS v2u*)(QD + QDOFF(l15) + 32 * kk + 4 * quad), *(const LAS v2u*)(QD + QDOFF(l15) + 32 * kk + 16 + 4 * quad));
                const bf16x8 aq1 = join8(*(const LAS v2u*)(QD + QDOFF(16 + l15) + 32 * kk + 4 * quad), *(const LAS v2u*)(QD + QDOFF(16 + l15) + 32 * kk + 16 + 4 * quad));
#pragma unroll
                for (int g = 0; g < 2; ++g) { const bf16x8 bs = pack8(S[g][2 * kk], S[g][2 * kk + 1]); O[g][0] = MFMA16(aq0, bs, O[g][0]); O[g][1] = MFMA16(aq1, bs, O[g][1]); }
            }
#pragma unroll
            for (int g = 0; g < 2; ++g) {
                const LAS bf16* vrow = VT + VTOFF(32 * w + 16 * g + l15);
                const bf16x8 bv = join8(*(const LAS v2u*)(vrow + 4 * quad), *(const LAS v2u*)(vrow + 16 + 4 * quad));
                O[g][0] = MFMA16(a0, bv, O[g][0]); O[g][1] = MFMA16(a1, bv, O[g][1]);
                float* op = F.OLOC + (row0 + (size_t)(ch * 32 + 4 * quad)) * 512 + h * 128 + 32 * w + 16 * g + l15;
#pragma unroll
                for (int r = 0; r < 4; ++r) { op[(size_t)r * 512] = O[g][0][r]; op[(size_t)(16 + r) * 512] = O[g][1][r]; }
            }
            const bf16x8 bvn0 = *(const LAS bf16x8*)(VT + VTOFF(32 * w + l15) + 8 * quad), bvn1 = *(const LAS bf16x8*)(VT + VTOFF(32 * w + 16 + l15) + 8 * quad);
#pragma unroll
            for (int tc = 0; tc < 8; ++tc) {
                const f32x4 dec = *(const LAS f32x4*)(DEC + 16 * tc + 4 * quad);
                const bf16x8 ak = *(const LAS bf16x8*)(KDT + (16 * tc + l15) * KT_STRIDE + 8 * quad);
                S[0][tc] = S[0][tc] * dec; S[1][tc] = S[1][tc] * dec;
                S[0][tc] = MFMA16(ak, bvn0, S[0][tc]); S[1][tc] = MFMA16(ak, bvn1, S[1][tc]);
            }
            if (ch + 1 < 8) { HG_ELEM(ch + 1); if (ch + 2 < 8) HG_LOAD_RAW(ch + 2); }
        }
        LDS_BARRIER();
    }
#undef HG_LOAD_RAW
#undef HG_ELEM
    if (w < 4) {
#pragma unroll
        for (int g = 0; g < 2; ++g) {
            f32x4* Lp = (f32x4*)F.LBUF + (size_t)(item * 8 + 2 * w + g) * 8 * 64 + lane;
#pragma unroll
            for (int tc = 0; tc < 8; ++tc) {
                const f32x4 val = S[g][tc] + 0.0f;
                asm volatile("global_store_dwordx4 %0, %1, off sc0 sc1\n\ts_nop 1" :: "v"(Lp + tc * 64), "v"(val) : "memory");
            }
        }
    }
    if (part == 0) { const float val = __expf(Bprev); asm volatile("global_store_dword %0, %1, off sc0 sc1" :: "v"(F.DTOT + item * 128 + c), "v"(val) : "memory"); }
}
__device__ __forceinline__ void hgrn_publish(Frame& F, unsigned* cnt, int item) {
    asm volatile("s_waitcnt vmcnt(0)" ::: "memory");
    __syncthreads();
    if (F.tid == 0) __hip_atomic_fetch_add(cnt + 64 * (item >> 3), 1u, __ATOMIC_RELAXED, __HIP_MEMORY_SCOPE_AGENT);
}
__device__ __forceinline__ void hgrn_wait(Frame& F, unsigned* cnt, int item) {
    if (F.tid == 0) {
        unsigned sp = 0;
        while (__hip_atomic_load(cnt + 64 * (item >> 3), __ATOMIC_RELAXED, __HIP_MEMORY_SCOPE_AGENT) < 8u) { __builtin_amdgcn_s_sleep(2); if (++sp > (1u << 22)) break; }
        __builtin_amdgcn_fence(__ATOMIC_ACQUIRE, "agent");
        asm volatile("s_waitcnt vmcnt(0)" ::: "memory");
    }
    __syncthreads();
}

constexpr int ST_STRIDE = 136;
__device__ __forceinline__ void hgrn_correct(Frame& F, int item) {
    const int b = item >> 5, h = (item >> 3) & 3, seg = item & 7;
    const int lane = F.lane, w = F.wave, quad = lane >> 4, l15 = lane & 15;
    const size_t row0 = (size_t)b * SEQ + seg * 256;
    LAS bf16* ST = (LAS bf16*)F.lds;
    v4u qf[2][4];
    if (seg > 0) {
#pragma unroll
        for (int tt = 0; tt < 2; ++tt)
#pragma unroll
            for (int kk = 0; kk < 4; ++kk) qf[tt][kk] = *(const v4u*)(F.QDS + (row0 + 32 * w + 16 * tt + l15) * 512 + h * 128 + 32 * kk + 8 * quad);
    }
    if (seg > 0) {
        f32x4 S[8];
#pragma unroll
        for (int i = 0; i < 8; ++i) S[i] = (f32x4){0.f, 0.f, 0.f, 0.f};
        f32x4 Lc[8], Dc[8];
        {
            const int im = item - seg;
            const f32x4* Lp = (const f32x4*)F.LBUF + (size_t)(im * 8 + w) * 8 * 64 + lane; const float* Dp = F.DTOT + im * 128;
#pragma unroll
            for (int tc = 0; tc < 8; ++tc) { Dc[tc] = *(const f32x4*)(Dp + 16 * tc + 4 * quad); Lc[tc] = Lp[tc * 64]; }
        }
        for (int m = 0; m < seg; ++m) {
            f32x4 Ln[8], Dn[8];
            const int im = item - seg + (m + 1 < seg ? m + 1 : m);
            const f32x4* Lp = (const f32x4*)F.LBUF + (size_t)(im * 8 + w) * 8 * 64 + lane; const float* Dp = F.DTOT + im * 128;
#pragma unroll
            for (int tc = 0; tc < 8; ++tc) { Dn[tc] = *(const f32x4*)(Dp + 16 * tc + 4 * quad); Ln[tc] = Lp[tc * 64]; }
#pragma unroll
            for (int tc = 0; tc < 8; ++tc) { S[tc] = Dc[tc] * S[tc] + Lc[tc]; Lc[tc] = Ln[tc]; Dc[tc] = Dn[tc]; }
        }
#pragma unroll
        for (int tc = 0; tc < 8; ++tc) { v2u o; o.x = pg8::cvt_pk_native(S[tc][0], S[tc][1]); o.y = pg8::cvt_pk_native(S[tc][2], S[tc][3]);
            *(LAS v2u*)(ST + (16 * w + l15) * ST_STRIDE + 16 * tc + 4 * quad) = o; }
    }
    f32x4 OL[2][8]; v2u GW[2][8];
#pragma unroll
    for (int tt = 0; tt < 2; ++tt) {
        const size_t row = row0 + 32 * w + 16 * tt + l15;
#pragma unroll
        for (int vt = 0; vt < 8; ++vt) { OL[tt][vt] = *(const f32x4*)(F.OLOC + row * 512 + h * 128 + 4 * quad + 16 * vt); GW[tt][vt] = *(const v2u*)(F.PROJ + row * PW + C_G + h * 128 + 4 * quad + 16 * vt); }
    }
    __syncthreads();
    f32x4 O[8][2];
#pragma unroll
    for (int vt = 0; vt < 8; ++vt) { O[vt][0] = (f32x4){0.f, 0.f, 0.f, 0.f}; O[vt][1] = O[vt][0]; }
    if (seg > 0) {
#pragma unroll
        for (int vt = 0; vt < 8; ++vt)
#pragma unroll
            for (int kk = 0; kk < 4; ++kk) {
                const bf16x8 a = *(const LAS bf16x8*)(ST + (16 * vt + l15) * ST_STRIDE + 32 * kk + 8 * quad);
                O[vt][0] = MFMA16(a, __builtin_bit_cast(bf16x8, qf[0][kk]), O[vt][0]);
                O[vt][1] = MFMA16(a, __builtin_bit_cast(bf16x8, qf[1][kk]), O[vt][1]);
            }
    }
#pragma unroll
    for (int tt = 0; tt < 2; ++tt) {
        const size_t row = row0 + 32 * w + 16 * tt + l15;
        float ss = 0.f;
#pragma unroll
        for (int vt = 0; vt < 8; ++vt) { const f32x4 o = O[vt][tt] + OL[tt][vt]; O[vt][tt] = o; ss += (o[0] * o[0] + o[1] * o[1]) + (o[2] * o[2] + o[3] * o[3]); }
        ss += __shfl_xor(ss, 16); ss += __shfl_xor(ss, 32);
        const float rs = 1.0f / sqrtf(ss * (1.0f / 128.0f) + EPS);
        bf16* mp = F.MIXED + row * D + h * 128 + 4 * quad;
#pragma unroll
        for (int vt = 0; vt < 8; ++vt) {
            const v2u gw = GW[tt][vt];
            const f32x4 og = *(const f32x4*)(F.ogain + 16 * vt + 4 * quad);
            const f32x4 o = O[vt][tt];
            v2u ow; ow.x = pk2(o[0] * rs * og[0] * bflo(gw.x), o[1] * rs * og[1] * bfhi(gw.x)); ow.y = pk2(o[2] * rs * og[2] * bflo(gw.y), o[3] * rs * og[3] * bfhi(gw.y));
            *(v2u*)(mp + 16 * vt) = ow;
        }
    }
    __syncthreads();
}
__device__ __forceinline__ int mix_first_item(const Frame& F) { const int bx = blockIdx.x; return (F.G == 256) ? (bx & 7) * 32 + (bx >> 3) : bx; }
__device__ __forceinline__ void mix_phase_a(Frame& F, bool handoff, unsigned* cnt) {
#if !NAIVE_HGRN
    for (int it = mix_first_item(F); it < NB * HH * 8; it += F.G) {
#if HGRN_WS
        hgrn_local_ws2(F, it);
#else
        hgrn_local(F, it);
#endif
        if (handoff) hgrn_publish(F, cnt, it); }
    __syncthreads();
#else
    hgrn_naive(F); __syncthreads();
#endif
#if !NAIVE_ATTN
    for (int it = mix_first_item(F); it < NB * KVH * 16; it += F.G) attn_item(F, it);
#else
    attn_naive(F); __syncthreads();
#endif
}
__device__ __forceinline__ void mix_phase_b(Frame& F, bool handoff, unsigned* cnt) {
#if !NAIVE_HGRN
    for (int it = mix_first_item(F); it < NB * HH * 8; it += F.G) { if (handoff) hgrn_wait(F, cnt, it); hgrn_correct(F, it); }
#else
    hgrn_norm_naive(F);
#endif
}
#define MK_N_LAUNCHES 1
#define NAIVE_MIX 0

#ifndef MK_N_LAUNCHES
#define MK_N_LAUNCHES 1
#endif
#ifndef NAIVE_MIX
#define NAIVE_MIX 0
#endif
constexpr int N_PHASES = 7;
struct Args { const float* in[13]; float* out; unsigned char* ws; int ph_lo, ph_hi; };
template <bool COOP>
__global__ void __launch_bounds__(NWAVES * 64, 2) fwd(Args args) {
    extern __shared__ __attribute__((aligned(16))) unsigned char lds[];
    Frame F;
    F.lds = (LAS unsigned char*)lds;
    F.tid = threadIdx.x; F.lane = F.tid & 63; F.wave = __builtin_amdgcn_readfirstlane(F.tid >> 6); F.G = gridDim.x;
    unsigned char* ws = args.ws;
    F.x = args.in[0]; F.g1 = args.in[1]; F.w_in = args.in[2]; F.lbl = args.in[3]; F.ogain = args.in[4]; F.qg = args.in[5]; F.kg = args.in[6];
    F.sinks = args.in[7]; F.w_out = args.in[8]; F.g2 = args.in[9]; F.w_gate = args.in[10]; F.w_up = args.in[11]; F.w_down = args.in[12]; F.out = args.out;
    F.WIN = (bf16*)(ws + WS_WIN); F.WOUT = (bf16*)(ws + WS_WOUT); F.WGU = (bf16*)(ws + WS_WGU); F.WDN = (bf16*)(ws + WS_WDN);
    F.XB = (bf16*)(ws + WS_XB); F.PROJ = (bf16*)(ws + WS_PROJ); F.ACT = (bf16*)(ws + WS_ACT); F.MIXED = (bf16*)(ws + WS_MIXED); F.HB = (bf16*)(ws + WS_HB); F.QDS = (bf16*)(ws + WS_QDS);
    F.RSTD1 = (float*)(ws + WS_RSTD1); F.PART = (float*)(ws + WS_PART); F.DTOT = (float*)(ws + WS_DTOT); F.OLOC = (float*)(ws + WS_OLOC); F.LBUF = (float*)(ws + WS_LBUF);
    const int lo = args.ph_lo, hi = args.ph_hi;
#define IN(k) (lo <= (k) && (k) < hi)
#ifndef USE_CG_SYNC
#define USE_CG_SYNC 0
#endif
    XcdBarrier bar; bar.bar = (unsigned*)(ws + WS_CTL) + 4096; bar.x = 0; bar.st = nullptr;
    if constexpr (COOP) {
        for (int u = F.tid; u < (LDS_BYTES - 131072) / 4; u += NWAVES * 64) ((LAS unsigned*)(F.lds + 131072))[u] = 0u;
        __syncthreads();
        bar = xcd_barrier_post((unsigned*)(ws + WS_CTL) + 4096, (volatile LAS unsigned*)(F.lds + 131072 + 352));
    }
#define SEAM(k) do { if constexpr (COOP) { if (IN(k) && IN((k) + 1)) { if (USE_CG_SYNC) cg::this_grid().sync(); else xcd_barrier(bar); } } } while (0)

#ifndef PROBE_DUP
#define PROBE_DUP 0
#endif
#ifndef PROBE_SYNC
#define PROBE_SYNC 0
#endif
    const bool handoff23 = COOP && !NAIVE_MIX && !NAIVE_HGRN && (F.G == NB * HH * 8) && IN(2) && IN(3);
    unsigned* cnt23 = (unsigned*)(ws + WS_CTL) + 8192;
    if (IN(0)) { p0_prologue(F); if (PROBE_DUP & 1) { __syncthreads(); p0_prologue(F); } SEAM(0); if constexpr (COOP) { for (int i_ = 0; i_ < PROBE_SYNC; ++i_) xcd_barrier(bar); } }
    if (IN(1)) {
        pg8::Gemm g{F.XB, F.WIN, M, PW, D}; pg8::StaticOrder S; S.init(M, PW, F.G, (int)blockIdx.x);
        pg8::EpiProj E{F.PROJ, F.RSTD1, F.lbl};
        pg8::gemm_phase<pg8::EpiProj, pg8::StaticOrder, true, true>(F.lds, g, S, E);
        if (PROBE_DUP & 2) { __syncthreads(); pg8::gemm_phase<pg8::EpiProj, pg8::StaticOrder, true, true>(F.lds, g, S, E); }
        {
            const int nwg = (M / 256) * (PW / 256), rem = nwg % F.G;
            const int first_late = (rem == 0) ? 0 : rem;
            if ((int)blockIdx.x >= first_late) { __syncthreads(); p0_weights_late(F, first_late, 0); }
        }
        SEAM(1);
    }
    if (IN(2)) {
#if NAIVE_MIX
        attn_naive(F); hgrn_naive(F);
#else
        mix_phase_a(F, handoff23, cnt23);
#endif
        if (!handoff23) SEAM(2);
    }
    if (IN(3)) {
#if NAIVE_MIX
        hgrn_norm_naive(F);
#else
        mix_phase_b(F, handoff23, cnt23);
#endif

        SEAM(3);
    }
    if (IN(4)) {
        pg8::Gemm g{F.MIXED, F.WOUT, M, D, D}; pg8::StaticOrder S; S.init(M, D, F.G, (int)blockIdx.x);
        pg8::EpiOut E{F.XB, F.out, F.HB, F.PART};
        pg8::gemm_phase<pg8::EpiOut, pg8::StaticOrder, true, true>(F.lds, g, S, E);
        if (PROBE_DUP & 16) { __syncthreads(); pg8::gemm_phase<pg8::EpiOut, pg8::StaticOrder, true, true>(F.lds, g, S, E); }
        SEAM(4);
    }
    if (IN(5)) {
        pg8::Gemm g{F.HB, F.WGU, M, NGU, D}; pg8::StaticOrder S; S.init(M, NGU, F.G, (int)blockIdx.x);
        pg8::EpiGU E{F.ACT, F.PART};
        pg8::gemm_phase<pg8::EpiGU, pg8::StaticOrder, true, true>(F.lds, g, S, E);
        if (PROBE_DUP & 32) { __syncthreads(); pg8::gemm_phase<pg8::EpiGU, pg8::StaticOrder, true, true>(F.lds, g, S, E); }
        {
            const int nwg = (M / 256) * (NGU / 256), rem = nwg % F.G;
            const int first_late = (rem == 0) ? 0 : rem;
            if ((int)blockIdx.x >= first_late) { __syncthreads(); p0_weights_late(F, first_late, 1); }
        }
        SEAM(5);
    }
    if (IN(6)) {
        pg8::Gemm g{F.ACT, F.WDN, M, D, FF}; pg8::StaticOrder S; S.init(M, D, F.G, (int)blockIdx.x);
        pg8::EpiDown E{F.out, F.HB};
        pg8::gemm_phase<pg8::EpiDown, pg8::StaticOrder, true, true>(F.lds, g, S, E);
        if (PROBE_DUP & 256) { __syncthreads(); pg8::gemm_phase<pg8::EpiDown, pg8::StaticOrder, true, true>(F.lds, g, S, E); }
    }
#undef IN
#undef SEAM
}

extern "C" void kernel_launch(void* const* d_in, const int* in_sizes, int n_in, void* d_out, int out_size, void* d_ws, size_t ws_size, hipStream_t stream) {
    static int grid = 0;
    if (grid == 0) {
        if (n_in != 13 || in_sizes[0] != M * D || out_size != M * D || ws_size < WS_END) { fprintf(stderr, "kernel_launch: unexpected shapes (n_in %d, in0 %d, out %d, ws %zu)\n", n_in, n_in > 0 ? in_sizes[0] : -1, out_size, ws_size); grid = -1; return; }
        int dev = 0, cus = 0, per_cu = 0;
        if (hipGetDevice(&dev) != hipSuccess || hipDeviceGetAttribute(&cus, hipDeviceAttributeMultiprocessorCount, dev) != hipSuccess) { grid = -1; return; }
        (void)hipFuncSetAttribute((const void*)fwd<true>, hipFuncAttributeMaxDynamicSharedMemorySize, LDS_BYTES);
        (void)hipFuncSetAttribute((const void*)fwd<false>, hipFuncAttributeMaxDynamicSharedMemorySize, LDS_BYTES);
        if (hipOccupancyMaxActiveBlocksPerMultiprocessor(&per_cu, (const void*)fwd<true>, NWAVES * 64, LDS_BYTES) != hipSuccess || per_cu < 1) {
            fprintf(stderr, "kernel_launch: occupancy query reports %d blocks per CU\n", per_cu); per_cu = 1; }
        (void)hipGetLastError();
        grid = cus;
    }
    if (grid < 0) return;
    if (hipMemsetAsync((char*)d_ws + WS_CTL, 0, 65536, stream) != hipSuccess) { fprintf(stderr, "kernel_launch: memset of the barrier words failed\n"); return; }
    Args a{};
    for (int i = 0; i < 13; ++i) a.in[i] = (const float*)d_in[i];
    a.out = (float*)d_out; a.ws = (unsigned char*)d_ws;
#if MK_N_LAUNCHES == 1
    a.ph_lo = 0; a.ph_hi = N_PHASES;
    void* params[] = {&a};
    hipError_t e = hipLaunchCooperativeKernel((const void*)fwd<true>, dim3(grid), dim3(NWAVES * 64), params, LDS_BYTES, stream);
    if (e != hipSuccess) fprintf(stderr, "cooperative launch failed: %s (grid %d)\n", hipGetErrorString(e), grid);
#else
    for (int ph = 0; ph < N_PHASES; ++ph) {
        a.ph_lo = ph; a.ph_hi = ph + 1;
        hipLaunchKernelGGL(fwd<false>, dim3(grid), dim3(NWAVES * 64), LDS_BYTES, stream, a);
    }
#endif
}
```

```cpp
#include <hip/hip_runtime.h>
#include <hip/hip_cooperative_groups.h>
#include <cstdio>
#include <cstdint>
namespace cg = cooperative_groups;
namespace pg8 {
#define PG8_LAS __attribute__((address_space(3)))
typedef unsigned short bf16_t;
typedef short bf16x8 __attribute__((ext_vector_type(8)));
typedef float f32x4 __attribute__((ext_vector_type(4)));
typedef unsigned u32x4 __attribute__((ext_vector_type(4)));
constexpr int BM = 256, BK = 64, HALF = 128, HTB = HALF * BK * 2  , STAGE_BYTES = 8 * HTB, NXCD = 8, WGM = 8;

__host__ __device__ __forceinline__ int lds_byte(int r, int c) { const int st = (r >> 4) * 2 + (c >> 5), rr = r & 15, cc = c & 31, ob = rr * 64 + cc * 2; return st * 1024 + (ob ^ (((ob >> 9) & 1) << 5)); }
__host__ __device__ __forceinline__ void stage_rc(int b, int& R, int& C) { const int st = b / 1024, sb = b % 1024, swz = sb ^ (((sb >> 9) & 1) << 5); R = (st >> 1) * 16 + swz / 64; C = (st & 1) * 32 + (swz % 64) / 2; }
__host__ __device__ __forceinline__ int perm32(int rho) { const int n = rho >> 4, i = rho & 15; return 8 * (i >> 2) + 4 * n + (i & 3); }

struct Unit { int pm, pn; };
struct Gemm { const bf16_t* A; const bf16_t* Bt; int M, N, K; };

struct StaticOrder {
    int nM, nN, nwg, G, c;
    __host__ __device__ void init(int M, int N, int G_, int c_) { nM = M / BM; nN = N / BM; nwg = nM * nN; G = G_; c = c_; }
    __host__ __device__ bool next(int i, Unit& u) const {
        const long L = (long)i * G + c; if (L >= nwg) return false;
        int wgid = (int)L; { const int q = nwg / NXCD, r = nwg % NXCD, xcd = wgid % NXCD, off = wgid / NXCD; wgid = (xcd < r ? xcd * (q + 1) : r * (q + 1) + (xcd - r) * q) + off; }
        const int nig = WGM * nN, gid = wgid / nig, fm = gid * WGM, gsz = (nM - fm) < WGM ? (nM - fm) : WGM;
        u.pm = fm + ((wgid % nig) % gsz); u.pn = (wgid % nig) / gsz; return true;
    }
    __device__ __forceinline__ void a_ready(const Unit&) const {}
    __device__ __forceinline__ void done(const Unit&) const {}
};

typedef float f32x2 __attribute__((ext_vector_type(2)));
__device__ __forceinline__ unsigned cvt_pk_bf16(float lo, float hi) { unsigned r; asm volatile("v_cvt_pk_bf16_f32 %0, %1, %2" : "=v"(r) : "v"(lo), "v"(hi)); return r; }
typedef __bf16 nbf16x2 __attribute__((ext_vector_type(2)));
__device__ __forceinline__ unsigned cvt_pk_native(float lo, float hi) { f32x2 v = {lo, hi}; return __builtin_bit_cast(unsigned, __builtin_convertvector(v, nbf16x2)); }
typedef float f32x2 __attribute__((ext_vector_type(2)));
template <class Epi, class Sched, bool ALIGN_EPI = false, bool SP2 = false>
__device__ __forceinline__ void gemm_phase(PG8_LAS unsigned char* lds, const Gemm g, const Sched& S, const Epi& E) {
    const int tid = threadIdx.x, wid = __builtin_amdgcn_readfirstlane(tid >> 6), lane = tid & 63, wr = wid >> 2, wc = wid & 3, fr = lane & 15, fq = lane >> 4;
    const int K = g.K, nt = K / BK;
    unsigned voffA[2], voffB[2];
#pragma unroll
    for (int i = 0; i < 2; ++i) { int R, C; stage_rc(tid * 16 + i * 8192, R, C); const int Rb = Epi::PERM ? ((R & ~31) + perm32(R & 31)) : R;
        voffA[i] = (unsigned)(R * K + C) * 2u; voffB[i] = (unsigned)(Rb * K + C) * 2u; }
    const size_t kstep = (size_t)(BK * 2);
    const size_t hstep = (size_t)HALF * K * 2;
    const size_t tstep = 2 * hstep;
    const unsigned ldsw = (unsigned)wid * 1024u;
    const int aoff = lds_byte(wr * 64 + fr, fq * 8), boff = lds_byte(wc * 32 + fr, fq * 8);
#define PG8_SA(b, h) (((b) * 2 + (h)) * HTB)
#define PG8_SB(b, h) ((4 + (b) * 2 + (h)) * HTB)
#define PG8_STAGE(bufoff, gbase, voff) do { _Pragma("unroll") for (int _i = 0; _i < 2; ++_i) \
        __builtin_amdgcn_global_load_lds((const unsigned*)((const char*)(gbase) + (voff)[_i]), (PG8_LAS unsigned*)(lds + (bufoff) + ldsw + _i * 8192), 16, 0, 0); } while (0)
#define PG8_LDA(dst, b, h) do { _Pragma("unroll") for (int m = 0; m < 4; ++m) _Pragma("unroll") for (int k = 0; k < 2; ++k) dst[m][k] = *(const PG8_LAS bf16x8*)(lds + PG8_SA(b, h) + aoff + m * 2048 + k * 1024); } while (0)
#define PG8_LDB(dst, b, h) do { _Pragma("unroll") for (int n = 0; n < 2; ++n) _Pragma("unroll") for (int k = 0; k < 2; ++k) dst[n][k] = *(const PG8_LAS bf16x8*)(lds + PG8_SB(b, h) + boff + n * 2048 + k * 1024); } while (0)
#define PG8_MMA(ai, bj, At, Bt) do { __builtin_amdgcn_s_setprio(1); _Pragma("unroll") for (int m = 0; m < 4; ++m) _Pragma("unroll") for (int n = 0; n < 2; ++n) _Pragma("unroll") for (int k = 0; k < 2; ++k) \
        acc[ai][bj][m][n] = __builtin_amdgcn_mfma_f32_16x16x32_bf16(Bt[n][k], At[m][k], acc[ai][bj][m][n], 0, 0, 0); __builtin_amdgcn_s_setprio(0); } while (0)
#define PG8_WAIT_V(n) asm volatile("s_waitcnt vmcnt(" #n ")" ::: "memory")
#define PG8_WAIT_L(n) asm volatile("s_waitcnt lgkmcnt(" #n ")" ::: "memory")
#define PG8_BAR __builtin_amdgcn_s_barrier()
#define PG8_SCHED __builtin_amdgcn_sched_barrier(0)
    Unit cur, nxt; int ui = 0;
    if (!S.next(0, cur)) return;
    f32x4 acc[2][2][4][2];
#pragma unroll
    for (int a = 0; a < 2; ++a)
#pragma unroll
        for (int b = 0; b < 2; ++b)
#pragma unroll
            for (int m = 0; m < 4; ++m)
#pragma unroll
                for (int n = 0; n < 2; ++n) acc[a][b][m][n] = (f32x4){0.f, 0.f, 0.f, 0.f};
    bf16x8 At[4][2], B0[2][2], B1[2][2];
    const char* cA = (const char*)g.A + (size_t)cur.pm * tstep; const char* cB = (const char*)g.Bt + (size_t)cur.pn * tstep;
    S.a_ready(cur);
    if constexpr (SP2) {
        PG8_STAGE(PG8_SB(0, 0), cB, voffB); PG8_STAGE(PG8_SB(0, 1), cB + hstep, voffB); PG8_STAGE(PG8_SA(0, 0), cA, voffA); PG8_STAGE(PG8_SA(0, 1), cA + hstep, voffA);
        if (wr == 1) PG8_BAR;
        PG8_WAIT_V(2); PG8_BAR;
        PG8_STAGE(PG8_SB(1, 0), cB + kstep, voffB); PG8_STAGE(PG8_SA(1, 0), cA + kstep, voffA); PG8_STAGE(PG8_SB(1, 1), cB + hstep + kstep, voffB);
        PG8_WAIT_V(6); PG8_BAR;
    } else {
        PG8_STAGE(PG8_SB(0, 0), cB, voffB); PG8_STAGE(PG8_SA(0, 0), cA, voffA); PG8_STAGE(PG8_SB(0, 1), cB + hstep, voffB); PG8_STAGE(PG8_SA(0, 1), cA + hstep, voffA);
        if (wr == 1) PG8_BAR;
        PG8_WAIT_V(4); PG8_BAR;
        PG8_STAGE(PG8_SB(1, 0), cB + kstep, voffB); PG8_STAGE(PG8_SA(1, 0), cA + kstep, voffA); PG8_STAGE(PG8_SB(1, 1), cB + hstep + kstep, voffB);
        PG8_WAIT_V(6); PG8_BAR;
    }
    for (;;) {
        const bool has_next = S.next(ui + 1, nxt);
        const char* nA = has_next ? (const char*)g.A + (size_t)nxt.pm * tstep : cA; const char* nB = has_next ? (const char*)g.Bt + (size_t)nxt.pn * tstep : cB;
        for (int t = 0; t < nt; t += 2) {
            const bool last = (t == nt - 2);
            const char* a1 = cA + (size_t)(t + 1) * kstep;
            const char* a2 = last ? nA : cA + (size_t)(t + 2) * kstep; const char* b2 = last ? nB : cB + (size_t)(t + 2) * kstep;
            const char* a3 = a2 + kstep; const char* b3 = b2 + kstep;
            if (last && has_next) S.a_ready(nxt);
            if constexpr (SP2) {
            PG8_LDB(B0, 0, 0); PG8_LDB(B1, 0, 1); PG8_SCHED; PG8_LDA(At, 0, 0); PG8_STAGE(PG8_SA(1, 1), a1 + hstep, voffA);
            PG8_WAIT_V(8); PG8_WAIT_L(0); PG8_BAR; PG8_MMA(0, 0, At, B0); PG8_MMA(0, 1, At, B1); PG8_BAR; PG8_SCHED;
            PG8_LDA(At, 0, 1); PG8_STAGE(PG8_SB(0, 0), b2, voffB); PG8_STAGE(PG8_SB(0, 1), b2 + hstep, voffB); PG8_STAGE(PG8_SA(0, 0), a2, voffA);
            PG8_WAIT_V(8); PG8_WAIT_L(0); PG8_BAR; PG8_MMA(1, 0, At, B0); PG8_MMA(1, 1, At, B1); PG8_BAR; PG8_SCHED;
            PG8_LDB(B0, 1, 0); PG8_LDB(B1, 1, 1); PG8_SCHED; PG8_LDA(At, 1, 0); PG8_STAGE(PG8_SA(0, 1), a2 + hstep, voffA);
            PG8_WAIT_V(8); PG8_WAIT_L(0); PG8_BAR; PG8_MMA(0, 0, At, B0); PG8_MMA(0, 1, At, B1); PG8_BAR; PG8_SCHED;
            PG8_LDA(At, 1, 1); PG8_STAGE(PG8_SB(1, 0), b3, voffB); PG8_STAGE(PG8_SB(1, 1), b3 + hstep, voffB); PG8_STAGE(PG8_SA(1, 0), a3, voffA);
            PG8_WAIT_V(8); PG8_WAIT_L(0); PG8_BAR; PG8_MMA(1, 0, At, B0); PG8_MMA(1, 1, At, B1); PG8_BAR; PG8_SCHED;
            } else {
            PG8_LDB(B0, 0, 0); PG8_SCHED; PG8_LDA(At, 0, 0); PG8_STAGE(PG8_SA(1, 1), a1 + hstep, voffA);
            PG8_WAIT_L(8); PG8_BAR; PG8_WAIT_L(0); PG8_MMA(0, 0, At, B0); PG8_BAR; PG8_SCHED;
            PG8_LDB(B1, 0, 1); PG8_STAGE(PG8_SB(0, 0), b2, voffB);
            PG8_BAR; PG8_WAIT_L(0); PG8_MMA(0, 1, At, B1); PG8_BAR;
            PG8_LDA(At, 0, 1); PG8_STAGE(PG8_SA(0, 0), a2, voffA);
            PG8_BAR; PG8_WAIT_L(0); PG8_MMA(1, 0, At, B0); PG8_BAR; PG8_SCHED;
            PG8_STAGE(PG8_SB(0, 1), b2 + hstep, voffB);
            PG8_WAIT_V(6); PG8_BAR; PG8_MMA(1, 1, At, B1); PG8_BAR;
            PG8_LDB(B0, 1, 0); PG8_SCHED; PG8_LDA(At, 1, 0); PG8_STAGE(PG8_SA(0, 1), a2 + hstep, voffA);
            PG8_WAIT_L(8); PG8_BAR; PG8_WAIT_L(0); PG8_MMA(0, 0, At, B0); PG8_BAR; PG8_SCHED;
            PG8_LDB(B1, 1, 1); PG8_STAGE(PG8_SB(1, 0), b3, voffB);
            PG8_BAR; PG8_WAIT_L(0); PG8_MMA(0, 1, At, B1); PG8_BAR;
            PG8_LDA(At, 1, 1); PG8_STAGE(PG8_SA(1, 0), a3, voffA);
            PG8_BAR; PG8_WAIT_L(0); PG8_MMA(1, 0, At, B0); PG8_BAR; PG8_SCHED;
            PG8_STAGE(PG8_SB(1, 1), b3 + hstep, voffB);
            PG8_WAIT_V(6); PG8_BAR; PG8_MMA(1, 1, At, B1); PG8_BAR;
            }
        }
        if constexpr (ALIGN_EPI) { if (wr == 0) PG8_BAR; }
        if constexpr (!Epi::AFTER_DRAIN) { E(acc, cur, wr, wc, fr, fq); S.done(cur); }
        if (!has_next) break;
#pragma unroll
        for (int a = 0; a < 2; ++a)
#pragma unroll
            for (int b = 0; b < 2; ++b)
#pragma unroll
                for (int m = 0; m < 4; ++m)
#pragma unroll
                    for (int n = 0; n < 2; ++n) acc[a][b][m][n] = (f32x4){0.f, 0.f, 0.f, 0.f};
        cur = nxt; cA = nA; cB = nB; ++ui;
        if constexpr (ALIGN_EPI) { if (wr == 1) PG8_BAR; }
    }
    PG8_WAIT_V(0);
    if constexpr (!ALIGN_EPI) { if (wr == 0) PG8_BAR; }
    PG8_BAR;
    if constexpr (Epi::AFTER_DRAIN) { E.fused(acc, cur, wr, wc, fr, fq, lds, wid, lane); S.done(cur); }
#undef PG8_SA
#undef PG8_SB
#undef PG8_STAGE
#undef PG8_LDA
#undef PG8_LDB
#undef PG8_MMA
#undef PG8_WAIT_V
#undef PG8_WAIT_L
#undef PG8_BAR
#undef PG8_SCHED
}
}

#define GAS __attribute__((address_space(1)))
#define LAS __attribute__((address_space(3)))
typedef unsigned short bf16;
typedef unsigned v4u __attribute__((ext_vector_type(4)));
typedef unsigned v2u __attribute__((ext_vector_type(2)));
typedef float f32x4 __attribute__((ext_vector_type(4)));
typedef short bf16x8 __attribute__((ext_vector_type(8)));
typedef short bf16x4 __attribute__((ext_vector_type(4)));

constexpr int NWAVES = 8;
constexpr int NB = 8, SEQ = 2048, D = 1024, M = NB * SEQ;
constexpr int PW = 2816, FF = 2816, NGU = 2 * FF;
constexpr int HH = 4, DK = 128, DV = 128, HW = 512;
constexpr int AH = 8, KVH = 2, AG = 4, HD = 64;
constexpr int C_Q = 0, C_F = 512, C_I = 1024, C_G = 1536, C_AQ = 2048, C_AK = 2560, C_AV = 2688;
constexpr float EPS = 1e-6f;

constexpr size_t MiB = 1u << 20;
constexpr size_t WS_CTL = 0;
constexpr size_t WS_WIN = 2 * MiB, WS_WOUT = 8 * MiB, WS_WGU = 10 * MiB, WS_WDN = 21 * MiB;
constexpr size_t WS_RSTD1 = 27 * MiB, WS_PART = 28 * MiB, WS_DTOT = 29 * MiB;
constexpr size_t WS_XB = 32 * MiB;
constexpr size_t WS_OLOC = 184 * MiB;
constexpr size_t WS_PROJ = 64 * MiB;
constexpr size_t WS_ACT = 64 * MiB;
constexpr size_t WS_MIXED = 152 * MiB;
constexpr size_t WS_HB = 184 * MiB;
constexpr size_t WS_LBUF = 216 * MiB;
constexpr size_t WS_QDS = 232 * MiB;
constexpr size_t WS_END = 256 * MiB;

constexpr int LDS_BYTES = 147456;

#define LDS_WAIT() asm volatile("s_waitcnt lgkmcnt(0)" ::: "memory")
#define VM_WAIT() asm volatile("s_waitcnt vmcnt(0)" ::: "memory")
__device__ __forceinline__ unsigned f2bf(float f) { unsigned u = __builtin_bit_cast(unsigned, f); return (u + 0x7fffu + ((u >> 16) & 1u)) >> 16; }
__device__ __forceinline__ unsigned pk2(float lo, float hi) { return f2bf(lo) | (f2bf(hi) << 16); }
__device__ __forceinline__ float bf2f(unsigned short b) { return __builtin_bit_cast(float, (unsigned)b << 16); }
__device__ __forceinline__ float bflo(unsigned w) { return __builtin_bit_cast(float, w << 16); }
__device__ __forceinline__ float bfhi(unsigned w) { return __builtin_bit_cast(float, w & 0xffff0000u); }
__device__ __forceinline__ float wave_sum(float v) {
#pragma unroll
    for (int o = 1; o < 64; o <<= 1) v += __shfl_xor(v, o);
    return v;
}
__device__ __forceinline__ float silu_f(float v) { return v / (1.0f + __expf(-v)); }

struct Frame {
    LAS unsigned char* lds;
    int tid, lane, wave, G;
    const float *x, *g1, *w_in, *lbl, *ogain, *qg, *kg, *sinks, *w_out, *g2, *w_gate, *w_up, *w_down;
    float* out;
    bf16 *WIN, *WOUT, *WGU, *WDN, *XB, *PROJ, *ACT, *MIXED, *HB, *QDS;
    float *RSTD1, *PART, *DTOT, *OLOC, *LBUF;
};

namespace pg8 {
struct EpiProj {
    static constexpr bool PERM = true, AFTER_DRAIN = false;
    bf16_t* O; const float* rstd; const float* lbl;
    __device__ __forceinline__ void operator()(const f32x4 (&acc)[2][2][4][2], const Unit& u, int wr, int wc, int fr, int fq) const {
        const int row0 = u.pm * BM + wr * 64 + fr;
#pragma unroll
        for (int bj = 0; bj < 2; ++bj) {
            const int col0 = u.pn * BM + bj * HALF + wc * 32 + 8 * fq;
            const int seg = __builtin_amdgcn_readfirstlane(col0 >> 9);
            float lb[8];
#pragma unroll
            for (int i = 0; i < 8; ++i) lb[i] = 0.f;
            if (seg == 1) {
                const int ci = col0 & 511;
#pragma unroll
                for (int i = 0; i < 8; ++i) { const float l0 = lbl[ci + i], l1 = lbl[512 + ci + i]; lb[i] = __builtin_amdgcn_rcpf(1.0f + __expf(l1 - l0)); }
            }
#pragma unroll
            for (int ai = 0; ai < 2; ++ai)
#pragma unroll
                for (int m = 0; m < 4; ++m) {
                    const int row = row0 + ai * HALF + m * 16; const float rs = rstd[row];
                    float v[8];
#pragma unroll
                    for (int i = 0; i < 4; ++i) { v[i] = acc[ai][bj][m][0][i] * rs; v[4 + i] = acc[ai][bj][m][1][i] * rs; }
                    if (seg == 0) {
#pragma unroll
                        for (int i = 0; i < 8; ++i) v[i] = v[i] * __builtin_amdgcn_rcpf(1.0f + __expf(-v[i])) * 0.08838834764831845f;
                    } else if (seg == 1) {
#pragma unroll
                        for (int i = 0; i < 8; ++i) { const float s = __builtin_amdgcn_rcpf(1.0f + __expf(-v[i])); v[i] = __logf(lb[i] + (1.0f - lb[i]) * s); }
                    } else if (seg == 3) {
#pragma unroll
                        for (int i = 0; i < 8; ++i) v[i] = v[i] * __builtin_amdgcn_rcpf(1.0f + __expf(-v[i]));
                    }
                    u32x4 w; w.x = cvt_pk_bf16(v[0], v[1]); w.y = cvt_pk_bf16(v[2], v[3]); w.z = cvt_pk_bf16(v[4], v[5]); w.w = cvt_pk_bf16(v[6], v[7]);
                    *(u32x4*)(O + (size_t)row * 2816 + col0) = w;
                }
        }
    }
};
struct EpiOut {
    static constexpr bool PERM = true, AFTER_DRAIN = false;
    const bf16_t* x; float* out; bf16_t* hb; float* part;
    __device__ __forceinline__ void operator()(const f32x4 (&acc)[2][2][4][2], const Unit& u, int wr, int wc, int fr, int fq) const {
        const int row0 = u.pm * BM + wr * 64 + fr;
#pragma unroll
        for (int ai = 0; ai < 2; ++ai)
#pragma unroll
            for (int m = 0; m < 4; ++m) {
                const int row = row0 + ai * HALF + m * 16; float ss = 0.f;
#pragma unroll
                for (int bj = 0; bj < 2; ++bj) {
                    const size_t off = (size_t)row * 1024 + u.pn * BM + bj * HALF + wc * 32 + 8 * fq;
                    const u32x4 xw = *(const u32x4*)(x + off);
                    f32x4 x0, x1;
                    x0[0] = __builtin_bit_cast(float, xw.x << 16); x0[1] = __builtin_bit_cast(float, xw.x & 0xffff0000u); x0[2] = __builtin_bit_cast(float, xw.y << 16); x0[3] = __builtin_bit_cast(float, xw.y & 0xffff0000u);
                    x1[0] = __builtin_bit_cast(float, xw.z << 16); x1[1] = __builtin_bit_cast(float, xw.z & 0xffff0000u); x1[2] = __builtin_bit_cast(float, xw.w << 16); x1[3] = __builtin_bit_cast(float, xw.w & 0xffff0000u);
                    const f32x4 h0 = x0 + acc[ai][bj][m][0], h1 = x1 + acc[ai][bj][m][1];
                    u32x4 w; w.x = cvt_pk_bf16(h0[0], h0[1]); w.y = cvt_pk_bf16(h0[2], h0[3]); w.z = cvt_pk_bf16(h1[0], h1[1]); w.w = cvt_pk_bf16(h1[2], h1[3]);
                    *(u32x4*)(hb + off) = w;
                    ss += ((h0[0] * h0[0] + h0[1] * h0[1]) + (h0[2] * h0[2] + h0[3] * h0[3])) + ((h1[0] * h1[0] + h1[1] * h1[1]) + (h1[2] * h1[2] + h1[3] * h1[3]));
                }
                ss += __shfl_xor(ss, 16); ss += __shfl_xor(ss, 32);
                if (fq == 0) part[(size_t)row * 16 + u.pn * 4 + wc] = ss;
            }
    }
};
struct EpiGU {
    static constexpr bool PERM = true, AFTER_DRAIN = false;
    bf16_t* O; const float* part;
    __device__ __forceinline__ void operator()(const f32x4 (&acc)[2][2][4][2], const Unit& u, int wr, int wc, int fr, int fq) const {
        const int row0 = u.pm * BM + wr * 64 + fr;
#pragma unroll
        for (int ai = 0; ai < 2; ++ai)
#pragma unroll
            for (int m = 0; m < 4; ++m) {
                const int row = row0 + ai * HALF + m * 16;
                const f32x4* pp = (const f32x4*)(part + (size_t)row * 16);
                const f32x4 p0 = pp[0], p1 = pp[1], p2 = pp[2], p3 = pp[3];
                const float ssq = ((p0[0] + p0[1]) + (p0[2] + p0[3])) + ((p1[0] + p1[1]) + (p1[2] + p1[3])) + ((p2[0] + p2[1]) + (p2[2] + p2[3])) + ((p3[0] + p3[1]) + (p3[2] + p3[3]));
                const float rs = __builtin_amdgcn_rsqf(ssq * (1.0f / 1024.0f) + 1e-6f);
                float v[8];
#pragma unroll
                for (int n = 0; n < 2; ++n)
#pragma unroll
                    for (int i = 0; i < 4; ++i) { const float g = acc[ai][0][m][n][i] * rs, up = acc[ai][1][m][n][i] * rs; v[4 * n + i] = g * __builtin_amdgcn_rcpf(1.0f + __expf(-g)) * up; }
                u32x4 w; w.x = cvt_pk_bf16(v[0], v[1]); w.y = cvt_pk_bf16(v[2], v[3]); w.z = cvt_pk_bf16(v[4], v[5]); w.w = cvt_pk_bf16(v[6], v[7]);
                *(u32x4*)(O + (size_t)row * 2816 + u.pn * HALF + wc * 32 + 8 * fq) = w;
            }
    }
};
struct EpiDown {
    static constexpr bool PERM = true, AFTER_DRAIN = false;
    float* out; const bf16_t* hb;
    __device__ __forceinline__ void operator()(const f32x4 (&acc)[2][2][4][2], const Unit& u, int wr, int wc, int fr, int fq) const {
        const int row0 = u.pm * BM + wr * 64 + fr;
#pragma unroll
        for (int ai = 0; ai < 2; ++ai)
#pragma unroll
            for (int m = 0; m < 4; ++m) {
                const int row = row0 + ai * HALF + m * 16;
#pragma unroll
                for (int bj = 0; bj < 2; ++bj) {
                    const size_t off = (size_t)row * 1024 + u.pn * BM + bj * HALF + wc * 32 + 8 * fq;
                    const u32x4 hw = *(const u32x4*)(hb + off);
                    f32x4 h0, h1;
                    h0[0] = __builtin_bit_cast(float, hw.x << 16); h0[1] = __builtin_bit_cast(float, hw.x & 0xffff0000u); h0[2] = __builtin_bit_cast(float, hw.y << 16); h0[3] = __builtin_bit_cast(float, hw.y & 0xffff0000u);
                    h1[0] = __builtin_bit_cast(float, hw.z << 16); h1[1] = __builtin_bit_cast(float, hw.z & 0xffff0000u); h1[2] = __builtin_bit_cast(float, hw.w << 16); h1[3] = __builtin_bit_cast(float, hw.w & 0xffff0000u);
                    __builtin_nontemporal_store(h0 + acc[ai][bj][m][0], (f32x4*)(out + off));
                    __builtin_nontemporal_store(h1 + acc[ai][bj][m][1], (f32x4*)(out + off + 4));
                }
            }
    }
};
}

__device__ __forceinline__ void p0_transpose_item(const float* W, int K, int N, bf16* WT, const float* gain, int mode, LAS float* scr, int item, int lane) {
    const int nblk = N / 32, kb = item / nblk, nb = item % nblk, k0 = 64 * kb, n0 = 32 * nb;
#pragma unroll 8
    for (int i = 0; i < 32; ++i) { const int kk = 2 * i + (lane >> 5); scr[kk * 33 + (lane & 31)] = __builtin_nontemporal_load(W + (size_t)(k0 + kk) * N + n0 + (lane & 31)); }
    LDS_WAIT(); asm volatile("" ::: "memory");
    const int c = lane & 7;
    float g[8];
#pragma unroll
    for (int i = 0; i < 8; ++i) g[i] = gain ? gain[k0 + 8 * c + i] : 1.0f;
    const int rbase = (mode == 0) ? n0 : (256 * (n0 >> 7) + (n0 & 127) + (mode == 2 ? 128 : 0));
#pragma unroll
    for (int j = 0; j < 4; ++j) { const int n = (lane >> 3) + 8 * j; const LAS float* s = scr + (8 * c) * 33 + n;
        v4u o; o.x = pk2(s[0 * 33] * g[0], s[1 * 33] * g[1]); o.y = pk2(s[2 * 33] * g[2], s[3 * 33] * g[3]); o.z = pk2(s[4 * 33] * g[4], s[5 * 33] * g[5]); o.w = pk2(s[6 * 33] * g[6], s[7 * 33] * g[7]);
        *(GAS v4u*)(WT + (size_t)(rbase + n) * K + k0 + 8 * c) = o; }
    LDS_WAIT(); asm volatile("" ::: "memory");
}
__device__ __forceinline__ void p0_weights_late(Frame& F, int first_block, int which) {
    int wv = threadIdx.x >> 6, ln = threadIdx.x & 63;
    asm volatile("" : "+v"(wv), "+v"(ln));
    wv = __builtin_amdgcn_readfirstlane(wv);
    LAS float* scr = (LAS float*)(F.lds + wv * 16384);
    const int gw = (blockIdx.x - first_block) * NWAVES + wv, NGW = (F.G - first_block) * NWAVES;
    constexpr int I_OUT = (D / 64) * (D / 32), I_G = (D / 64) * (FF / 32), I_DN = (FF / 64) * (D / 32);
    if (which == 0) {
        for (int it = gw; it < I_OUT + 2 * I_G; it += NGW) {
            int r = it;
            if (r < I_OUT) { p0_transpose_item(F.w_out, D, D, F.WOUT, nullptr, 0, scr, r, ln); continue; } r -= I_OUT;
            if (r < I_G) { p0_transpose_item(F.w_gate, D, FF, F.WGU, F.g2, 1, scr, r, ln); continue; } r -= I_G;
            p0_transpose_item(F.w_up, D, FF, F.WGU, F.g2, 2, scr, r, ln);
        }
    } else {
        for (int it = gw; it < I_DN; it += NGW) p0_transpose_item(F.w_down, FF, D, F.WDN, nullptr, 0, scr, it, ln);
    }
}
__device__ __forceinline__ void p0_prologue(Frame& F) {
    LAS float* scr = (LAS float*)(F.lds + F.wave * 16384);
    const int gw = blockIdx.x * NWAVES + F.wave, NGW = F.G * NWAVES;
    constexpr int I_IN = (D / 64) * (PW / 32);
    for (int it = gw; it < I_IN; it += NGW) p0_transpose_item(F.w_in, D, PW, F.WIN, F.g1, 0, scr, it, F.lane);
    for (int m = gw; m < M; m += NGW) {
        const GAS f32x4* xr = (const GAS f32x4*)(F.x + (size_t)m * D) + F.lane;
        f32x4 v[4]; float s = 0.f;
#pragma unroll
        for (int j = 0; j < 4; ++j) { v[j] = __builtin_nontemporal_load(xr + 64 * j); s += (v[j].x * v[j].x + v[j].y * v[j].y) + (v[j].z * v[j].z + v[j].w * v[j].w); }
        s = wave_sum(s);
        if (F.lane == 0) F.RSTD1[m] = 1.0f / sqrtf(s * (1.0f / D) + EPS);
        GAS unsigned long long* o8 = (GAS unsigned long long*)(F.XB + (size_t)m * D) + F.lane;
#pragma unroll
        for (int j = 0; j < 4; ++j) o8[64 * j] = (unsigned long long)pk2(v[j].x, v[j].y) | ((unsigned long long)pk2(v[j].z, v[j].w) << 32);
    }
}

#define XB_TMO      128
#define XB_XCNT(j)  (256  + 64 * (j))
#define XB_XSUB(j)  (1280 + 64 * (j))
#define XB_XGEN(j)  (2304 + 64 * (j))
#define XB_TOP      3328
#define XB_TOPGEN   3392
#define XCD_BAR_WORDS 3456
#define XB_SPIN_CAP (1u << 18)

__device__ __forceinline__ unsigned xb_ld(unsigned* p)              { return __hip_atomic_load(p, __ATOMIC_RELAXED, __HIP_MEMORY_SCOPE_AGENT); }
__device__ __forceinline__ unsigned xb_add(unsigned* p, unsigned v) { return __hip_atomic_fetch_add(p, v, __ATOMIC_RELAXED, __HIP_MEMORY_SCOPE_AGENT); }
__device__ __forceinline__ unsigned xb_xcc_id() { return (unsigned)__builtin_amdgcn_s_getreg((3 << 11) | 20) & 0xFu; }
#define XB_SPIN(cond, bar) do { unsigned _sp = 0; while (cond) { __builtin_amdgcn_s_sleep(1); \
    if ((++_sp & 255u) == 0u) { if (xb_ld(&(bar)[XB_TMO])) break; if (_sp > XB_SPIN_CAP) { atomicAdd(&(bar)[XB_TMO], 1u); break; } } } } while (0)

struct XcdBarrier {
    unsigned* bar; unsigned x;
    volatile LAS unsigned* st;
};

__device__ __forceinline__ XcdBarrier xcd_barrier_post(unsigned* bar, volatile LAS unsigned* st) {
    XcdBarrier b; b.bar = bar; b.x = xb_xcc_id(); b.st = st;
    if (threadIdx.x == 0) (void)xb_add(&bar[XB_XCNT(b.x)], 1u);
    return b;
}
__device__ __forceinline__ void xcd_barrier_complete(unsigned* bar, unsigned x, unsigned& nloc, unsigned& nx) {
    const unsigned G = gridDim.x * gridDim.y * gridDim.z;
    unsigned sum, cnt, mine, sp = 0u;
    for (;;) {
        sum = 0u; cnt = 0u; mine = 0u;
#pragma unroll
        for (unsigned j = 0; j < 16; ++j) { const unsigned c = xb_ld(&bar[XB_XCNT(j)]); sum += c; cnt += (c > 0u) ? 1u : 0u; mine = (j == x) ? c : mine; }
        if (sum == G) break;
        __builtin_amdgcn_s_sleep(1);
        if ((++sp & 255u) == 0u) { if (xb_ld(&bar[XB_TMO])) break; if (sp > XB_SPIN_CAP) { atomicAdd(&bar[XB_TMO], 1u); break; } }
    }
    nloc = mine > 0u ? mine : 1u; nx = cnt > 0u ? cnt : 1u;
}

__device__ __forceinline__ void xcd_barrier(const XcdBarrier& b) {
    asm volatile("s_waitcnt vmcnt(0)" ::: "memory");
    __syncthreads();
    if (threadIdx.x == 0) {
        unsigned* bar = b.bar;
        __builtin_amdgcn_s_waitcnt(0);
        unsigned nloc = b.st[0], nx = b.st[1];
        if (nloc == 0u) { xcd_barrier_complete(bar, b.x, nloc, nx); b.st[0] = nloc; b.st[1] = nx; }
        const unsigned old = xb_add(&bar[XB_XSUB(b.x)], 1u);
        const unsigned gen = old / nloc;
        if (old + 1u == (gen + 1u) * nloc) {
            __builtin_amdgcn_fence(__ATOMIC_RELEASE, "agent");
            asm volatile("s_waitcnt vmcnt(0)" ::: "memory");
            const unsigned og = xb_add(&bar[XB_TOP], 1u);
            const unsigned tg = og / nx;
            if (og + 1u == (tg + 1u) * nx) xb_add(&bar[XB_TOPGEN], 1u);
            else XB_SPIN(xb_ld(&bar[XB_TOPGEN]) == tg, bar);
            __builtin_amdgcn_fence(__ATOMIC_ACQUIRE, "agent");
            xb_add(&bar[XB_XGEN(b.x)], 1u);
            asm volatile("s_waitcnt vmcnt(0)" ::: "memory");
        } else {
            XB_SPIN(xb_ld(&bar[XB_XGEN(b.x)]) == gen, bar);
            __builtin_amdgcn_fence(__ATOMIC_ACQUIRE, "agent");
            asm volatile("s_waitcnt vmcnt(0)" ::: "memory");
        }
    }
    __syncthreads();
}
#define NAIVE_ATTN 0
#define NAIVE_HGRN 0

__device__ __forceinline__ void hgrn_naive(Frame& F) {
    if (blockIdx.x >= 64 || F.wave != 0) return;
    const int item = blockIdx.x; const int b = item >> 3, h = (item >> 1) & 3, v = (item & 1) * 64 + F.lane;
    float S[128];
#pragma unroll
    for (int c = 0; c < 128; ++c) S[c] = 0.f;
    for (int t = 0; t < SEQ; ++t) {
        const size_t row = (size_t)b * SEQ + t; const bf16* pr = F.PROJ + row * PW;
        const float vv = bf2f(pr[C_I + h * 128 + v]);
        float o = 0.f;
#pragma unroll
        for (int c8 = 0; c8 < 16; ++c8) {
            const v4u qw = *(const v4u*)(pr + C_Q + h * 128 + c8 * 8); const v4u fw = *(const v4u*)(pr + C_F + h * 128 + c8 * 8);
#pragma unroll
            for (int i = 0; i < 4; ++i) {
                const float q0 = bflo(qw[i]), q1 = bfhi(qw[i]); const float f0 = __expf(bflo(fw[i])), f1 = __expf(bfhi(fw[i]));
                S[c8 * 8 + 2 * i] = f0 * S[c8 * 8 + 2 * i] + (1.0f - f0) * vv; o += q0 * S[c8 * 8 + 2 * i];
                S[c8 * 8 + 2 * i + 1] = f1 * S[c8 * 8 + 2 * i + 1] + (1.0f - f1) * vv; o += q1 * S[c8 * 8 + 2 * i + 1];
            }
        }
        F.OLOC[row * 512 + h * 128 + v] = o;
    }
}
__device__ __forceinline__ void attn_naive(Frame& F) {
    for (int id = blockIdx.x * 512 + F.tid; id < NB * AH * SEQ; id += F.G * 512) {
        const int t = id & 2047, qh = (id >> 11) & 7, b = id >> 14, kvh = qh >> 2;
        const size_t row = (size_t)b * SEQ + t;
        float q[64]; float ss = 0.f;
        { const bf16* qr = F.PROJ + row * PW + C_AQ + qh * 64;
#pragma unroll
          for (int d8 = 0; d8 < 8; ++d8) { const v4u w = *(const v4u*)(qr + d8 * 8);
#pragma unroll
              for (int i = 0; i < 4; ++i) { q[d8 * 8 + 2 * i] = bflo(w[i]); q[d8 * 8 + 2 * i + 1] = bfhi(w[i]); } }
#pragma unroll
          for (int d = 0; d < 64; ++d) ss += q[d] * q[d];
          const float rs = 1.0f / sqrtf(ss * (1.0f / 64.0f) + EPS);
#pragma unroll
          for (int d = 0; d < 64; ++d) q[d] = q[d] * rs * F.qg[d] * 0.125f * F.kg[d]; }
        float m = F.sinks[qh], l = 1.0f; float acc[64];
#pragma unroll
        for (int d = 0; d < 64; ++d) acc[d] = 0.f;
        const int k0 = t - 127 < 0 ? 0 : t - 127;
        for (int kp = k0; kp <= t; ++kp) {
            const bf16* kr = F.PROJ + ((size_t)b * SEQ + kp) * PW + C_AK + kvh * 64;
            float kss = 0.f, dot = 0.f;
#pragma unroll
            for (int d8 = 0; d8 < 8; ++d8) { const v4u w = *(const v4u*)(kr + d8 * 8);
#pragma unroll
                for (int i = 0; i < 4; ++i) { const float a = bflo(w[i]), c = bfhi(w[i]); kss += a * a + c * c; dot += q[d8 * 8 + 2 * i] * a + q[d8 * 8 + 2 * i + 1] * c; } }
            const float s = dot / sqrtf(kss * (1.0f / 64.0f) + EPS);
            const float mn = fmaxf(m, s), sc = __expf(m - mn), p = __expf(s - mn);
            l = l * sc + p; m = mn;
            const bf16* vr = F.PROJ + ((size_t)b * SEQ + kp) * PW + C_AV + kvh * 64;
#pragma unroll
            for (int d8 = 0; d8 < 8; ++d8) { const v4u w = *(const v4u*)(vr + d8 * 8);
#pragma unroll
                for (int i = 0; i < 4; ++i) { acc[d8 * 8 + 2 * i] = acc[d8 * 8 + 2 * i] * sc + p * bflo(w[i]); acc[d8 * 8 + 2 * i + 1] = acc[d8 * 8 + 2 * i + 1] * sc + p * bfhi(w[i]); } }
        }
        const float il = 1.0f / l;
        bf16* orow = F.MIXED + row * D + 512 + qh * 64;
#pragma unroll
        for (int d8 = 0; d8 < 8; ++d8) { v4u w;
#pragma unroll
            for (int i = 0; i < 4; ++i) w[i] = pk2(acc[d8 * 8 + 2 * i] * il, acc[d8 * 8 + 2 * i + 1] * il);
            *(v4u*)(orow + d8 * 8) = w; }
    }
}
__device__ __forceinline__ void hgrn_norm_naive(Frame& F) {
    const int gw = blockIdx.x * NWAVES + F.wave, NGW = F.G * NWAVES;
    for (int it = gw; it < M * 4; it += NGW) {
        const int row = it >> 2, h = it & 3;
        const float* o = F.OLOC + (size_t)row * 512 + h * 128;
        const float a = o[F.lane], c = o[64 + F.lane];
        const float ss = wave_sum(a * a + c * c); const float rs = 1.0f / sqrtf(ss * (1.0f / 128.0f) + EPS);
        const bf16* gr = F.PROJ + (size_t)row * PW + C_G + h * 128;
        bf16* mr = F.MIXED + (size_t)row * D + h * 128;
        mr[F.lane] = (bf16)f2bf(a * rs * F.ogain[F.lane] * bf2f(gr[F.lane]));
        mr[64 + F.lane] = (bf16)f2bf(c * rs * F.ogain[64 + F.lane] * bf2f(gr[64 + F.lane]));
    }
}

#ifndef PROBE_DUP
#define PROBE_DUP 0
#endif
#ifndef HGRN_WS
#define HGRN_WS 1
#endif
__device__ __forceinline__ bf16x8 pack8(const f32x4 a, const f32x4 b) {
    v4u w; w.x = pg8::cvt_pk_native(a[0], a[1]); w.y = pg8::cvt_pk_native(a[2], a[3]); w.z = pg8::cvt_pk_native(b[0], b[1]); w.w = pg8::cvt_pk_native(b[2], b[3]);
    return __builtin_bit_cast(bf16x8, w);
}
__device__ __forceinline__ bf16x8 join8(const v2u lo, const v2u hi) { v4u w; w.x = lo.x; w.y = lo.y; w.z = hi.x; w.w = hi.y; return __builtin_bit_cast(bf16x8, w); }
#define MFMA16(a, b, c) __builtin_amdgcn_mfma_f32_16x16x32_bf16((a), (b), (c), 0, 0, 0)
#define LDS_BARRIER() do { asm volatile("s_waitcnt lgkmcnt(0)" ::: "memory"); __builtin_amdgcn_s_barrier(); asm volatile("" ::: "memory"); } while (0)

constexpr int KS_STRIDE = 72, VT2_STRIDE = 264;
constexpr int AT_KS = 0, AT_VT = 256 * KS_STRIDE * 2;
__device__ __forceinline__ void attn_item(Frame& F, int item) {
    const int b = item >> 5, kvh = (item >> 4) & 1, qb = item & 15, p0 = qb * 128;
    const int tid = F.tid, lane = F.lane, w = F.wave, quad = lane >> 4, l15 = lane & 15;
    LAS bf16* Ks = (LAS bf16*)(F.lds + AT_KS); LAS bf16* Vt = (LAS bf16*)(F.lds + AT_VT);
    const size_t row = (size_t)b * SEQ + p0 + 16 * w + l15;
    {
        const int key = tid >> 1, half = tid & 1, pos = p0 - 128 + key;
        v4u kw[4], vw[4];
        if (pos >= 0) {
            const v4u* kr = (const v4u*)(F.PROJ + ((size_t)b * SEQ + pos) * PW + C_AK + kvh * 64 + half * 32);
            const v4u* vr = (const v4u*)(F.PROJ + ((size_t)b * SEQ + pos) * PW + C_AV + kvh * 64 + half * 32);
#pragma unroll
            for (int i = 0; i < 4; ++i) { kw[i] = kr[i]; vw[i] = vr[i]; }
        } else {
#pragma unroll
            for (int i = 0; i < 4; ++i) { kw[i] = (v4u){0u, 0u, 0u, 0u}; vw[i] = (v4u){0u, 0u, 0u, 0u}; }
        }
        float ss = 0.f;
#pragma unroll
        for (int i = 0; i < 4; ++i)
#pragma unroll
            for (int j = 0; j < 4; ++j) { const float a = bflo(kw[i][j]), c = bfhi(kw[i][j]); ss += a * a + c * c; }
        ss += __shfl_xor(ss, 1);
        const float rs = __builtin_amdgcn_rsqf(ss * (1.0f / 64.0f) + EPS);
#pragma unroll
        for (int i = 0; i < 4; ++i) {
            const f32x4 g0 = *(const f32x4*)(F.kg + half * 32 + 8 * i), g1 = *(const f32x4*)(F.kg + half * 32 + 8 * i + 4);
            v4u o;
            o.x = pk2(bflo(kw[i][0]) * rs * g0[0], bfhi(kw[i][0]) * rs * g0[1]); o.y = pk2(bflo(kw[i][1]) * rs * g0[2], bfhi(kw[i][1]) * rs * g0[3]);
            o.z = pk2(bflo(kw[i][2]) * rs * g1[0], bfhi(kw[i][2]) * rs * g1[1]); o.w = pk2(bflo(kw[i][3]) * rs * g1[2], bfhi(kw[i][3]) * rs * g1[3]);
            *(LAS v4u*)(Ks + key * KS_STRIDE + half * 32 + 8 * i) = o;
#pragma unroll
            for (int j = 0; j < 4; ++j) {
                Vt[(half * 32 + 8 * i + 2 * j) * VT2_STRIDE + key] = (bf16)(vw[i][j] & 0xffffu);
                Vt[(half * 32 + 8 * i + 2 * j + 1) * VT2_STRIDE + key] = (bf16)(vw[i][j] >> 16);
            }
        }
    }
    __syncthreads();
    bf16x8 kf[9][2];
#pragma unroll
    for (int kt = 0; kt < 9; ++kt)
#pragma unroll
        for (int ks = 0; ks < 2; ++ks) kf[kt][ks] = *(const LAS bf16x8*)(Ks + (16 * w + 16 * kt + l15) * KS_STRIDE + 32 * ks + 8 * quad);
    const float NEG = -1e30f;
    for (int g = 0; g < AG; ++g) {
        const int qh = kvh * AG + g;
        bf16x8 bq[2];
        {
            v4u qw[2]; float ss = 0.f;
#pragma unroll
            for (int ks = 0; ks < 2; ++ks) { qw[ks] = *(const v4u*)(F.PROJ + row * PW + C_AQ + qh * 64 + 32 * ks + 8 * quad);
#pragma unroll
                for (int j = 0; j < 4; ++j) { const float a = bflo(qw[ks][j]), c = bfhi(qw[ks][j]); ss += a * a + c * c; } }
            ss += __shfl_xor(ss, 16); ss += __shfl_xor(ss, 32);
            const float rs = 0.125f * __builtin_amdgcn_rsqf(ss * (1.0f / 64.0f) + EPS);
#pragma unroll
            for (int ks = 0; ks < 2; ++ks) {
                const f32x4 g0 = *(const f32x4*)(F.qg + 32 * ks + 8 * quad), g1 = *(const f32x4*)(F.qg + 32 * ks + 8 * quad + 4);
                v4u o;
                o.x = pk2(bflo(qw[ks][0]) * rs * g0[0], bfhi(qw[ks][0]) * rs * g0[1]); o.y = pk2(bflo(qw[ks][1]) * rs * g0[2], bfhi(qw[ks][1]) * rs * g0[3]);
                o.z = pk2(bflo(qw[ks][2]) * rs * g1[0], bfhi(qw[ks][2]) * rs * g1[1]); o.w = pk2(bflo(qw[ks][3]) * rs * g1[2], bfhi(qw[ks][3]) * rs * g1[3]);
                bq[ks] = __builtin_bit_cast(bf16x8, o);
            }
        }
        f32x4 sc[9];
#pragma unroll
        for (int kt = 0; kt < 9; ++kt) { sc[kt] = (f32x4){0.f, 0.f, 0.f, 0.f};
#pragma unroll
            for (int ks = 0; ks < 2; ++ks) sc[kt] = MFMA16(kf[kt][ks], bq[ks], sc[kt]); }
#pragma unroll
        for (int r = 0; r < 4; ++r) { if (!(l15 < 4 * quad + r)) sc[0][r] = NEG; if (!(l15 >= 4 * quad + r)) sc[8][r] = NEG; }
        if (qb == 0) {
#pragma unroll
            for (int kt = 0; kt < 9; ++kt)
#pragma unroll
                for (int r = 0; r < 4; ++r) if (16 * w + 16 * kt + 4 * quad + r < 128) sc[kt][r] = NEG;
        }
        const float sink = F.sinks[qh];
        float m = sink;
#pragma unroll
        for (int kt = 0; kt < 9; ++kt)
#pragma unroll
            for (int r = 0; r < 4; ++r) m = fmaxf(m, sc[kt][r]);
        m = fmaxf(m, __shfl_xor(m, 16)); m = fmaxf(m, __shfl_xor(m, 32));
        float l = 0.f;
#pragma unroll
        for (int kt = 0; kt < 9; ++kt)
#pragma unroll
            for (int r = 0; r < 4; ++r) { const float p = __expf(sc[kt][r] - m); sc[kt][r] = p; l += p; }
        l += __shfl_xor(l, 16); l += __shfl_xor(l, 32);
        l += __expf(sink - m);
        const float il = __builtin_amdgcn_rcpf(l);
        bf16x8 pf[5];
#pragma unroll
        for (int kk = 0; kk < 4; ++kk) pf[kk] = pack8(sc[2 * kk], sc[2 * kk + 1]);
        pf[4] = pack8(sc[8], (f32x4){0.f, 0.f, 0.f, 0.f});
#pragma unroll
        for (int dt = 0; dt < 4; ++dt) {
            f32x4 o = (f32x4){0.f, 0.f, 0.f, 0.f};
            const LAS bf16* vrow = Vt + (16 * dt + l15) * VT2_STRIDE + 16 * w + 4 * quad;
#pragma unroll
            for (int kk = 0; kk < 5; ++kk) {
                const v2u lo = *(const LAS v2u*)(vrow + 32 * kk);
                v2u hi = (v2u){0u, 0u}; if (kk < 4) hi = *(const LAS v2u*)(vrow + 32 * kk + 16);
                o = MFMA16(join8(lo, hi), pf[kk], o);
            }
            v2u ow; ow.x = pk2(o[0] * il, o[1] * il); ow.y = pk2(o[2] * il, o[3] * il);
            *(v2u*)(F.MIXED + row * D + 512 + qh * 64 + 16 * dt + 4 * quad) = ow;
        }
    }
    __syncthreads();
}

constexpr int QD_STRIDE = 136, KT_STRIDE = 40;
#define QDOFF(t) ((t) * QD_STRIDE + ((t) >> 3) * 16)
#define VTOFF(v) ((v) * KT_STRIDE + ((v) >> 3) * 32)
constexpr int HB_QD = 0, HB_KH = 8832, HB_KDT = 17664, HB_VT = 27904, HB_DEC = 39104, HB_BYTES = 39616;
static_assert(31 * QD_STRIDE + 3 * 16 + 128 <= (HB_KH - HB_QD) / 2 && 127 * KT_STRIDE + 15 * 32 + 32 <= (HB_DEC - HB_VT) / 2 && 128 * KT_STRIDE * 2 <= HB_VT - HB_KDT && 2 * HB_BYTES <= 131072, "HGRN LDS map");
__device__ __forceinline__ void hgrn_local(Frame& F, int item) {
    const int b = item >> 5, h = (item >> 3) & 3, seg = item & 7;
    const int tid = F.tid, lane = F.lane, w = F.wave, quad = lane >> 4, l15 = lane & 15;
    const int c = tid >> 2, part = tid & 3;
    const int vt_t = tid & 31, vt_v8 = tid >> 5;
    const size_t row0 = (size_t)b * SEQ + seg * 256;
    const bf16* pq = F.PROJ + row0 * PW + C_Q + h * 128 + c;
    const bf16* pf = F.PROJ + row0 * PW + C_F + h * 128 + c;
    const bf16* pv = F.PROJ + row0 * PW + C_I + h * 128 + vt_v8 * 8;
    f32x4 S[8];
#pragma unroll
    for (int i = 0; i < 8; ++i) S[i] = (f32x4){0.f, 0.f, 0.f, 0.f};
    float Bprev = 0.f;
    bf16 rq[8], rf[8]; v4u rv;
#define HG_LOAD_RAW(ch) do { _Pragma("unroll") for (int j = 0; j < 8; ++j) { const size_t t_ = (size_t)((ch) * 32 + 8 * part + j); rq[j] = pq[t_ * PW]; rf[j] = pf[t_ * PW]; } \
        rv = *(const v4u*)(pv + (size_t)((ch) * 32 + vt_t) * PW); } while (0)
#define HG_ELEM(ch) do { \
        LAS unsigned char* bb_ = F.lds + ((ch) & 1) * HB_BYTES; \
        LAS bf16* QD_ = (LAS bf16*)(bb_ + HB_QD); LAS bf16* KH_ = (LAS bf16*)(bb_ + HB_KH); LAS bf16* KDT_ = (LAS bf16*)(bb_ + HB_KDT); LAS bf16* VT_ = (LAS bf16*)(bb_ + HB_VT); LAS float* DEC_ = (LAS float*)(bb_ + HB_DEC); \
        float lf_[8], bl_[8]; float run_ = 0.f; \
        _Pragma("unroll") for (int j = 0; j < 8; ++j) { lf_[j] = bf2f(rf[j]); run_ += lf_[j]; bl_[j] = run_; } \
        const int b4_ = lane & ~3; \
        const float t0_ = __shfl(run_, b4_), t1_ = __shfl(run_, b4_ + 1), t2_ = __shfl(run_, b4_ + 2), t3_ = __shfl(run_, b4_ + 3); \
        const float pre_ = (part > 0 ? t0_ : 0.f) + (part > 1 ? t1_ : 0.f) + (part > 2 ? t2_ : 0.f); \
        const float btot_ = (t0_ + t1_) + (t2_ + t3_); \
        const float eprev_ = __expf(Bprev); \
        float kd_[8]; const float ebtot_ = __expf(btot_); float eip_ = __builtin_amdgcn_rcpf(__expf(pre_)); \
        _Pragma("unroll") for (int j = 0; j < 8; ++j) { const int t_ = 8 * part + j; const float bt_ = pre_ + bl_[j]; \
            const float e_ = __expf(bt_), ei_ = __builtin_amdgcn_rcpf(e_); \
            const float k_ = 1.0f - e_ * eip_; eip_ = ei_; const float qd_ = bf2f(rq[j]) * e_; const float kh_ = k_ * ei_; \
            const unsigned pw_ = pg8::cvt_pk_native(qd_, kh_); \
            QD_[QDOFF(t_) + c] = (bf16)(pw_ & 0xffffu); KH_[QDOFF(t_) + c] = (bf16)(pw_ >> 16); kd_[j] = kh_ * ebtot_; \
            F.QDS[(row0 + (size_t)((ch) * 32 + t_)) * 512 + h * 128 + c] = (bf16)f2bf(qd_ * eprev_); } \
        { v4u o_; o_.x = pk2(kd_[0], kd_[1]); o_.y = pk2(kd_[2], kd_[3]); o_.z = pk2(kd_[4], kd_[5]); o_.w = pk2(kd_[6], kd_[7]); *(LAS v4u*)(KDT_ + c * KT_STRIDE + 8 * part) = o_; } \
        if (part == 0) DEC_[c] = ebtot_; \
        Bprev += btot_; \
        _Pragma("unroll") for (int i = 0; i < 4; ++i) { VT_[VTOFF(8 * vt_v8 + 2 * i) + vt_t] = (bf16)(rv[i] & 0xffffu); VT_[VTOFF(8 * vt_v8 + 2 * i + 1) + vt_t] = (bf16)(rv[i] >> 16); } \
    } while (0)

    HG_LOAD_RAW(0);
    HG_ELEM(0);
    HG_LOAD_RAW(1);
    LDS_BARRIER();
    for (int ch = 0; ch < 8; ++ch) {
        if (ch + 1 < 8) { HG_ELEM(ch + 1); if (ch + 2 < 8) HG_LOAD_RAW(ch + 2); }
        const LAS unsigned char* bb = F.lds + (ch & 1) * HB_BYTES;
        const LAS bf16* QD = (const LAS bf16*)(bb + HB_QD); const LAS bf16* KH = (const LAS bf16*)(bb + HB_KH); const LAS bf16* KDT = (const LAS bf16*)(bb + HB_KDT);
        const LAS bf16* VT = (const LAS bf16*)(bb + HB_VT); const LAS float* DEC = (const LAS float*)(bb + HB_DEC);
        f32x4 T00 = (f32x4){0.f, 0.f, 0.f, 0.f}, T01 = T00, T11 = T00;
#pragma unroll
        for (int kk = 0; kk < 4; ++kk) {
            const bf16x8 kh0 = *(const LAS bf16x8*)(KH + QDOFF(l15) + 32 * kk + 8 * quad), kh1 = *(const LAS bf16x8*)(KH + QDOFF(16 + l15) + 32 * kk + 8 * quad);
            const bf16x8 q0 = *(const LAS bf16x8*)(QD + QDOFF(l15) + 32 * kk + 8 * quad), q1 = *(const LAS bf16x8*)(QD + QDOFF(16 + l15) + 32 * kk + 8 * quad);
            T00 = MFMA16(kh0, q0, T00); T01 = MFMA16(kh0, q1, T01); T11 = MFMA16(kh1, q1, T11);
        }
#pragma unroll
        for (int r = 0; r < 4; ++r) { if (4 * quad + r > l15) { T00[r] = 0.f; T11[r] = 0.f; } }
        const bf16x8 a0 = pack8(T00, (f32x4){0.f, 0.f, 0.f, 0.f}), a1 = pack8(T01, T11);
        const LAS bf16* vrow = VT + VTOFF(16 * w + l15);
        const bf16x8 bv = join8(*(const LAS v2u*)(vrow + 4 * quad), *(const LAS v2u*)(vrow + 16 + 4 * quad));
        f32x4 O0 = (f32x4){0.f, 0.f, 0.f, 0.f}, O1 = O0;
#pragma unroll
        for (int kk = 0; kk < 4; ++kk) {
            const bf16x8 aq0 = join8(*(const LAS v2u*)(QD + QDOFF(l15) + 32 * kk + 4 * quad), *(const LAS v2u*)(QD + QDOFF(l15) + 32 * kk + 16 + 4 * quad));
            const bf16x8 aq1 = join8(*(const LAS v2u*)(QD + QDOFF(16 + l15) + 32 * kk + 4 * quad), *(const LAS v2u*)(QD + QDOFF(16 + l15) + 32 * kk + 16 + 4 * quad));
            const bf16x8 bs = pack8(S[2 * kk], S[2 * kk + 1]);
            O0 = MFMA16(aq0, bs, O0); O1 = MFMA16(aq1, bs, O1);
        }
        O0 = MFMA16(a0, bv, O0); O1 = MFMA16(a1, bv, O1);
        {
            float* op = F.OLOC + (row0 + (size_t)(ch * 32 + 4 * quad)) * 512 + h * 128 + 16 * w + l15;
#pragma unroll
            for (int r = 0; r < 4; ++r) { op[(size_t)r * 512] = O0[r]; op[(size_t)(16 + r) * 512] = O1[r]; }
        }
        const bf16x8 bvn = *(const LAS bf16x8*)(vrow + 8 * quad);
#pragma unroll
        for (int tc = 0; tc < 8; ++tc) {
            const f32x4 dec = *(const LAS f32x4*)(DEC + 16 * tc + 4 * quad);
            S[tc] = S[tc] * dec;
            const bf16x8 ak = *(const LAS bf16x8*)(KDT + (16 * tc + l15) * KT_STRIDE + 8 * quad);
            S[tc] = MFMA16(ak, bvn, S[tc]);
        }
        LDS_BARRIER();
    }
#undef HG_LOAD_RAW
#undef HG_ELEM
    {
        f32x4* Lp = (f32x4*)F.LBUF + (size_t)(item * 8 + w) * 8 * 64 + lane;
#pragma unroll
        for (int tc = 0; tc < 8; ++tc) {
            const f32x4 val = S[tc] + 0.0f;
            asm volatile("global_store_dwordx4 %0, %1, off sc0 sc1\n\ts_nop 1" :: "v"(Lp + tc * 64), "v"(val) : "memory");
        }
        if (part == 0) { const float val = __expf(Bprev); asm volatile("global_store_dword %0, %1, off sc0 sc1" :: "v"(F.DTOT + item * 128 + c), "v"(val) : "memory"); }
    }
}
__device__ __forceinline__ void hgrn_local_ws2(Frame& F, int item) {
    const int b = item >> 5, h = (item >> 3) & 3, seg = item & 7;
    const int tid = F.tid, lane = F.lane, w = F.wave, quad = lane >> 4, l15 = lane & 15;
    const int c = tid >> 2, part = tid & 3;
    const int vt_t = tid & 31, vt_v8 = tid >> 5;
    const size_t row0 = (size_t)b * SEQ + seg * 256;
    const bf16* pq = F.PROJ + row0 * PW + C_Q + h * 128 + c;
    const bf16* pf = F.PROJ + row0 * PW + C_F + h * 128 + c;
    const bf16* pv = F.PROJ + row0 * PW + C_I + h * 128 + vt_v8 * 8;
    f32x4 S[2][8];
#pragma unroll
    for (int g = 0; g < 2; ++g)
#pragma unroll
        for (int i = 0; i < 8; ++i) S[g][i] = (f32x4){0.f, 0.f, 0.f, 0.f};
    float Bprev = 0.f;
    bf16 rq[8], rf[8]; v4u rv;
#define HG_LOAD_RAW(ch) do { _Pragma("unroll") for (int j = 0; j < 8; ++j) { const size_t t_ = (size_t)((ch) * 32 + 8 * part + j); rq[j] = pq[t_ * PW]; rf[j] = pf[t_ * PW]; } \
        rv = *(const v4u*)(pv + (size_t)((ch) * 32 + vt_t) * PW); } while (0)
#define HG_ELEM(ch) do { \
        LAS unsigned char* bb_ = F.lds + ((ch) & 1) * HB_BYTES; \
        LAS bf16* QD_ = (LAS bf16*)(bb_ + HB_QD); LAS bf16* KH_ = (LAS bf16*)(bb_ + HB_KH); LAS bf16* KDT_ = (LAS bf16*)(bb_ + HB_KDT); LAS bf16* VT_ = (LAS bf16*)(bb_ + HB_VT); LAS float* DEC_ = (LAS float*)(bb_ + HB_DEC); \
        float lf_[8], bl_[8]; float run_ = 0.f; \
        _Pragma("unroll") for (int j = 0; j < 8; ++j) { lf_[j] = bf2f(rf[j]); run_ += lf_[j]; bl_[j] = run_; } \
        const int b4_ = lane & ~3; \
        const float t0_ = __shfl(run_, b4_), t1_ = __shfl(run_, b4_ + 1), t2_ = __shfl(run_, b4_ + 2), t3_ = __shfl(run_, b4_ + 3); \
        const float pre_ = (part > 0 ? t0_ : 0.f) + (part > 1 ? t1_ : 0.f) + (part > 2 ? t2_ : 0.f); \
        const float btot_ = (t0_ + t1_) + (t2_ + t3_); \
        const float eprev_ = __expf(Bprev); \
        float kd_[8]; const float ebtot_ = __expf(btot_); float eip_ = __builtin_amdgcn_rcpf(__expf(pre_)); \
        _Pragma("unroll") for (int j = 0; j < 8; ++j) { const int t_ = 8 * part + j; const float bt_ = pre_ + bl_[j]; \
            const float e_ = __expf(bt_), ei_ = __builtin_amdgcn_rcpf(e_); \
            const float k_ = 1.0f - e_ * eip_; eip_ = ei_; const float qd_ = bf2f(rq[j]) * e_; const float kh_ = k_ * ei_; \
            const unsigned pw_ = pg8::cvt_pk_native(qd_, kh_); \
            QD_[QDOFF(t_) + c] = (bf16)(pw_ & 0xffffu); KH_[QDOFF(t_) + c] = (bf16)(pw_ >> 16); kd_[j] = kh_ * ebtot_; \
            F.QDS[(row0 + (size_t)((ch) * 32 + t_)) * 512 + h * 128 + c] = (bf16)f2bf(qd_ * eprev_); } \
        { v4u o_; o_.x = pk2(kd_[0], kd_[1]); o_.y = pk2(kd_[2], kd_[3]); o_.z = pk2(kd_[4], kd_[5]); o_.w = pk2(kd_[6], kd_[7]); *(LAS v4u*)(KDT_ + c * KT_STRIDE + 8 * part) = o_; } \
        if (part == 0) DEC_[c] = ebtot_; \
        Bprev += btot_; \
        _Pragma("unroll") for (int i = 0; i < 4; ++i) { VT_[VTOFF(8 * vt_v8 + 2 * i) + vt_t] = (bf16)(rv[i] & 0xffffu); VT_[VTOFF(8 * vt_v8 + 2 * i + 1) + vt_t] = (bf16)(rv[i] >> 16); } \
    } while (0)

    HG_LOAD_RAW(0);
    HG_ELEM(0);
    HG_LOAD_RAW(1);
    LDS_BARRIER();
    for (int ch = 0; ch < 8; ++ch) {
        if (w >= 4) { if (ch + 1 < 8) { HG_ELEM(ch + 1); if (ch + 2 < 8) HG_LOAD_RAW(ch + 2); } }
        if (w < 4) {
            const LAS unsigned char* bb = F.lds + (ch & 1) * HB_BYTES;
            const LAS bf16* QD = (const LAS bf16*)(bb + HB_QD); const LAS bf16* KH = (const LAS bf16*)(bb + HB_KH); const LAS bf16* KDT = (const LAS bf16*)(bb + HB_KDT);
            const LAS bf16* VT = (const LAS bf16*)(bb + HB_VT); const LAS float* DEC = (const LAS float*)(bb + HB_DEC);
            f32x4 T00 = (f32x4){0.f, 0.f, 0.f, 0.f}, T01 = T00, T11 = T00;
#pragma unroll
            for (int kk = 0; kk < 4; ++kk) {
                const bf16x8 kh0 = *(const LAS bf16x8*)(KH + QDOFF(l15) + 32 * kk + 8 * quad), kh1 = *(const LAS bf16x8*)(KH + QDOFF(16 + l15) + 32 * kk + 8 * quad);
                const bf16x8 q0 = *(const LAS bf16x8*)(QD + QDOFF(l15) + 32 * kk + 8 * quad), q1 = *(const LAS bf16x8*)(QD + QDOFF(16 + l15) + 32 * kk + 8 * quad);
                T00 = MFMA16(kh0, q0, T00); T01 = MFMA16(kh0, q1, T01); T11 = MFMA16(kh1, q1, T11);
            }
#pragma unroll
            for (int r = 0; r < 4; ++r) { if (4 * quad + r > l15) { T00[r] = 0.f; T11[r] = 0.f; } }
            const bf16x8 a0 = pack8(T00, (f32x4){0.f, 0.f, 0.f, 0.f}), a1 = pack8(T01, T11);
            f32x4 O[2][2];
#pragma unroll
            for (int g = 0; g < 2; ++g) { O[g][0] = (f32x4){0.f, 0.f, 0.f, 0.f}; O[g][1] = O[g][0]; }
#pragma unroll
            for (int kk = 0; kk < 4; ++kk) {
                const bf16x8 aq0 = join8(*(const LAS v2u*)(QD + QDOFF(l15) + 32 * kk + 4 * quad), *(const LAS v2u*)(QD + QDOFF(l15) + 32 * kk + 16 + 4 * quad));
                const bf16x8 aq1 = join8(*(const LAS v2u*)(QD + QDOFF(16 + l15) + 32 * kk + 4 * quad), *(const LAS v2u*)(QD + QDOFF(16 + l15) + 32 * kk + 16 + 4 * quad));
#pragma unroll
                for (int g = 0; g < 2; ++g) { const bf16x8 bs = pack8(S[g][2 * kk], S[g][2 * kk + 1]); O[g][0] = MFMA16(aq0, bs, O[g][0]); O[g][1] = MFMA16(aq1, bs, O[g][1]); }
            }
#pragma unroll
            for (int g = 0; g < 2; ++g) {
                const LAS bf16* vrow = VT + VTOFF(32 * w + 16 * g + l15);
                const bf16x8 bv = join8(*(const LAS v2u*)(vrow + 4 * quad), *(const LAS v2u*)(vrow + 16 + 4 * quad));
                O[g][0] = MFMA16(a0, bv, O[g][0]); O[g][1] = MFMA16(a1, bv, O[g][1]);
                float* op = F.OLOC + (row0 + (size_t)(ch * 32 + 4 * quad)) * 512 + h * 128 + 32 * w + 16 * g + l15;
#pragma unroll
                for (int r = 0; r < 4; ++r) { op[(size_t)r * 512] = O[g][0][r]; op[(size_t)(16 + r) * 512] = O[g][1][r]; }
            }
            const bf16x8 bvn0 = *(const LAS bf16x8*)(VT + VTOFF(32 * w + l15) + 8 * quad), bvn1 = *(const LAS bf16x8*)(VT + VTOFF(32 * w + 16 + l15) + 8 * quad);
#pragma unroll
            for (int tc = 0; tc < 8; ++tc) {
                const f32x4 dec = *(const LAS f32x4*)(DEC + 16 * tc + 4 * quad);
                const bf16x8 ak = *(const LAS bf16x8*)(KDT + (16 * tc + l15) * KT_STRIDE + 8 * quad);
                S[0][tc] = S[0][tc] * dec; S[1][tc] = S[1][tc] * dec;
                S[0][tc] = MFMA16(ak, bvn0, S[0][tc]); S[1][tc] = MFMA16(ak, bvn1, S[1][tc]);
            }
            if (ch + 1 < 8) { HG_ELEM(ch + 1); if (ch + 2 < 8) HG_LOAD_RAW(ch + 2); }
        }
        LDS_BARRIER();
    }
#undef HG_LOAD_RAW
#undef HG_ELEM
    if (w < 4) {
#pragma unroll
        for (int g = 0; g < 2; ++g) {
            f32x4* Lp = (f32x4*)F.LBUF + (size_t)(item * 8 + 2 * w + g) * 8 * 64 + lane;
#pragma unroll
            for (int tc = 0; tc < 8; ++tc) {
                const f32x4 val = S[g][tc] + 0.0f;
                asm volatile("global_store_dwordx4 %0, %1, off sc0 sc1\n\ts_nop 1" :: "v"(Lp + tc * 64), "v"(val) : "memory");
            }
        }
    }
    if (part == 0) { const float val = __expf(Bprev); asm volatile("global_store_dword %0, %1, off sc0 sc1" :: "v"(F.DTOT + item * 128 + c), "v"(val) : "memory"); }
}
__device__ __forceinline__ void hgrn_publish(Frame& F, unsigned* cnt, int item) {
    asm volatile("s_waitcnt vmcnt(0)" ::: "memory");
    __syncthreads();
    if (F.tid == 0) __hip_atomic_fetch_add(cnt + 64 * (item >> 3), 1u, __ATOMIC_RELAXED, __HIP_MEMORY_SCOPE_AGENT);
}
__device__ __forceinline__ void hgrn_wait(Frame& F, unsigned* cnt, int item) {
    if (F.tid == 0) {
        unsigned sp = 0;
        while (__hip_atomic_load(cnt + 64 * (item >> 3), __ATOMIC_RELAXED, __HIP_MEMORY_SCOPE_AGENT) < 8u) { __builtin_amdgcn_s_sleep(2); if (++sp > (1u << 22)) break; }
        __builtin_amdgcn_fence(__ATOMIC_ACQUIRE, "agent");
        asm volatile("s_waitcnt vmcnt(0)" ::: "memory");
    }
    __syncthreads();
}

constexpr int ST_STRIDE = 136;
__device__ __forceinline__ void hgrn_correct(Frame& F, int item) {
    const int b = item >> 5, h = (item >> 3) & 3, seg = item & 7;
    const int lane = F.lane, w = F.wave, quad = lane >> 4, l15 = lane & 15;
    const size_t row0 = (size_t)b * SEQ + seg * 256;
    LAS bf16* ST = (LAS bf16*)F.lds;
    v4u qf[2][4];
    if (seg > 0) {
#pragma unroll
        for (int tt = 0; tt < 2; ++tt)
#pragma unroll
            for (int kk = 0; kk < 4; ++kk) qf[tt][kk] = *(const v4u*)(F.QDS + (row0 + 32 * w + 16 * tt + l15) * 512 + h * 128 + 32 * kk + 8 * quad);
    }
    if (seg > 0) {
        f32x4 S[8];
#pragma unroll
        for (int i = 0; i < 8; ++i) S[i] = (f32x4){0.f, 0.f, 0.f, 0.f};
        f32x4 Lc[8], Dc[8];
        {
            const int im = item - seg;
            const f32x4* Lp = (const f32x4*)F.LBUF + (size_t)(im * 8 + w) * 8 * 64 + lane; const float* Dp = F.DTOT + im * 128;
#pragma unroll
            for (int tc = 0; tc < 8; ++tc) { Dc[tc] = *(const f32x4*)(Dp + 16 * tc + 4 * quad); Lc[tc] = Lp[tc * 64]; }
        }
        for (int m = 0; m < seg; ++m) {
            f32x4 Ln[8], Dn[8];
            const int im = item - seg + (m + 1 < seg ? m + 1 : m);
            const f32x4* Lp = (const f32x4*)F.LBUF + (size_t)(im * 8 + w) * 8 * 64 + lane; const float* Dp = F.DTOT + im * 128;
#pragma unroll
            for (int tc = 0; tc < 8; ++tc) { Dn[tc] = *(const f32x4*)(Dp + 16 * tc + 4 * quad); Ln[tc] = Lp[tc * 64]; }
#pragma unroll
            for (int tc = 0; tc < 8; ++tc) { S[tc] = Dc[tc] * S[tc] + Lc[tc]; Lc[tc] = Ln[tc]; Dc[tc] = Dn[tc]; }
        }
#pragma unroll
        for (int tc = 0; tc < 8; ++tc) { v2u o; o.x = pg8::cvt_pk_native(S[tc][0], S[tc][1]); o.y = pg8::cvt_pk_native(S[tc][2], S[tc][3]);
            *(LAS v2u*)(ST + (16 * w + l15) * ST_STRIDE + 16 * tc + 4 * quad) = o; }
    }
    f32x4 OL[2][8]; v2u GW[2][8];
#pragma unroll
    for (int tt = 0; tt < 2; ++tt) {
        const size_t row = row0 + 32 * w + 16 * tt + l15;
#pragma unroll
        for (int vt = 0; vt < 8; ++vt) { OL[tt][vt] = *(const f32x4*)(F.OLOC + row * 512 + h * 128 + 4 * quad + 16 * vt); GW[tt][vt] = *(const v2u*)(F.PROJ + row * PW + C_G + h * 128 + 4 * quad + 16 * vt); }
    }
    __syncthreads();
    f32x4 O[8][2];
#pragma unroll
    for (int vt = 0; vt < 8; ++vt) { O[vt][0] = (f32x4){0.f, 0.f, 0.f, 0.f}; O[vt][1] = O[vt][0]; }
    if (seg > 0) {
#pragma unroll
        for (int vt = 0; vt < 8; ++vt)
#pragma unroll
            for (int kk = 0; kk < 4; ++kk) {
                const bf16x8 a = *(const LAS bf16x8*)(ST + (16 * vt + l15) * ST_STRIDE + 32 * kk + 8 * quad);
                O[vt][0] = MFMA16(a, __builtin_bit_cast(bf16x8, qf[0][kk]), O[vt][0]);
                O[vt][1] = MFMA16(a, __builtin_bit_cast(bf16x8, qf[1][kk]), O[vt][1]);
            }
    }
#pragma unroll
    for (int tt = 0; tt < 2; ++tt) {
        const size_t row = row0 + 32 * w + 16 * tt + l15;
        float ss = 0.f;
#pragma unroll
        for (int vt = 0; vt < 8; ++vt) { const f32x4 o = O[vt][tt] + OL[tt][vt]; O[vt][tt] = o; ss += (o[0] * o[0] + o[1] * o[1]) + (o[2] * o[2] + o[3] * o[3]); }
        ss += __shfl_xor(ss, 16); ss += __shfl_xor(ss, 32);
        const float rs = __builtin_amdgcn_rsqf(ss * (1.0f / 128.0f) + EPS);
        bf16* mp = F.MIXED + row * D + h * 128 + 4 * quad;
#pragma unroll
        for (int vt = 0; vt < 8; ++vt) {
            const v2u gw = GW[tt][vt];
            const f32x4 og = *(const f32x4*)(F.ogain + 16 * vt + 4 * quad);
            const f32x4 o = O[vt][tt];
            v2u ow; ow.x = pk2(o[0] * rs * og[0] * bflo(gw.x), o[1] * rs * og[1] * bfhi(gw.x)); ow.y = pk2(o[2] * rs * og[2] * bflo(gw.y), o[3] * rs * og[3] * bfhi(gw.y));
            *(v2u*)(mp + 16 * vt) = ow;
        }
    }
    __syncthreads();
}
__device__ __forceinline__ int mix_first_item(const Frame& F) { const int bx = blockIdx.x; return (F.G == 256) ? (bx & 7) * 32 + (bx >> 3) : bx; }
__device__ __forceinline__ void mix_phase_a(Frame& F, bool handoff, unsigned* cnt) {
#if !NAIVE_HGRN
    for (int it = mix_first_item(F); it < NB * HH * 8; it += F.G) {
#if HGRN_WS
        hgrn_local_ws2(F, it);
#else
        hgrn_local(F, it);
#endif
        if (handoff) hgrn_publish(F, cnt, it); }
    __syncthreads();
#else
    hgrn_naive(F); __syncthreads();
#endif
#if !NAIVE_ATTN
    for (int it = mix_first_item(F); it < NB * KVH * 16; it += F.G) attn_item(F, it);
#else
    attn_naive(F); __syncthreads();
#endif
}
__device__ __forceinline__ void mix_phase_b(Frame& F, bool handoff, unsigned* cnt) {
#if !NAIVE_HGRN
    for (int it = mix_first_item(F); it < NB * HH * 8; it += F.G) { if (handoff) hgrn_wait(F, cnt, it); hgrn_correct(F, it); }
#else
    hgrn_norm_naive(F);
#endif
}
#define MK_N_LAUNCHES 1
#define NAIVE_MIX 0

#ifndef MK_N_LAUNCHES
#define MK_N_LAUNCHES 1
#endif
#ifndef NAIVE_MIX
#define NAIVE_MIX 0
#endif
constexpr int N_PHASES = 7;
struct Args { const float* in[13]; float* out; unsigned char* ws; int ph_lo, ph_hi; };
template <bool COOP>
__global__ void __launch_bounds__(NWAVES * 64, 2) fwd(Args args) {
    extern __shared__ __attribute__((aligned(16))) unsigned char lds[];
    Frame F;
    F.lds = (LAS unsigned char*)lds;
    F.tid = threadIdx.x; F.lane = F.tid & 63; F.wave = __builtin_amdgcn_readfirstlane(F.tid >> 6); F.G = gridDim.x;
    unsigned char* ws = args.ws;
    F.x = args.in[0]; F.g1 = args.in[1]; F.w_in = args.in[2]; F.lbl = args.in[3]; F.ogain = args.in[4]; F.qg = args.in[5]; F.kg = args.in[6];
    F.sinks = args.in[7]; F.w_out = args.in[8]; F.g2 = args.in[9]; F.w_gate = args.in[10]; F.w_up = args.in[11]; F.w_down = args.in[12]; F.out = args.out;
    F.WIN = (bf16*)(ws + WS_WIN); F.WOUT = (bf16*)(ws + WS_WOUT); F.WGU = (bf16*)(ws + WS_WGU); F.WDN = (bf16*)(ws + WS_WDN);
    F.XB = (bf16*)(ws + WS_XB); F.PROJ = (bf16*)(ws + WS_PROJ); F.ACT = (bf16*)(ws + WS_ACT); F.MIXED = (bf16*)(ws + WS_MIXED); F.HB = (bf16*)(ws + WS_HB); F.QDS = (bf16*)(ws + WS_QDS);
    F.RSTD1 = (float*)(ws + WS_RSTD1); F.PART = (float*)(ws + WS_PART); F.DTOT = (float*)(ws + WS_DTOT); F.OLOC = (float*)(ws + WS_OLOC); F.LBUF = (float*)(ws + WS_LBUF);
    const int lo = args.ph_lo, hi = args.ph_hi;
#define IN(k) (lo <= (k) && (k) < hi)
#ifndef USE_CG_SYNC
#define USE_CG_SYNC 0
#endif
    XcdBarrier bar; bar.bar = (unsigned*)(ws + WS_CTL) + 4096; bar.x = 0; bar.st = nullptr;
    if constexpr (COOP) {
        for (int u = F.tid; u < (LDS_BYTES - 131072) / 4; u += NWAVES * 64) ((LAS unsigned*)(F.lds + 131072))[u] = 0u;
        __syncthreads();
        bar = xcd_barrier_post((unsigned*)(ws + WS_CTL) + 4096, (volatile LAS unsigned*)(F.lds + 131072 + 352));
    }
#define SEAM(k) do { if constexpr (COOP) { if (IN(k) && IN((k) + 1)) { if (USE_CG_SYNC) cg::this_grid().sync(); else xcd_barrier(bar); } } } while (0)

#ifndef PROBE_DUP
#define PROBE_DUP 0
#endif
#ifndef PROBE_SYNC
#define PROBE_SYNC 0
#endif
    const bool handoff23 = COOP && !NAIVE_MIX && !NAIVE_HGRN && (F.G == NB * HH * 8) && IN(2) && IN(3);
    unsigned* cnt23 = (unsigned*)(ws + WS_CTL) + 8192;
    if (IN(0)) { p0_prologue(F); if (PROBE_DUP & 1) { __syncthreads(); p0_prologue(F); } SEAM(0); if constexpr (COOP) { for (int i_ = 0; i_ < PROBE_SYNC; ++i_) xcd_barrier(bar); } }
    if (IN(1)) {
        pg8::Gemm g{F.XB, F.WIN, M, PW, D}; pg8::StaticOrder S; S.init(M, PW, F.G, (int)blockIdx.x);
        pg8::EpiProj E{F.PROJ, F.RSTD1, F.lbl};
        pg8::gemm_phase<pg8::EpiProj, pg8::StaticOrder, true, true>(F.lds, g, S, E);
        if (PROBE_DUP & 2) { __syncthreads(); pg8::gemm_phase<pg8::EpiProj, pg8::StaticOrder, true, true>(F.lds, g, S, E); }
        {
            const int nwg = (M / 256) * (PW / 256), rem = nwg % F.G;
            const int first_late = (rem == 0) ? 0 : rem;
            if ((int)blockIdx.x >= first_late) { __syncthreads(); p0_weights_late(F, first_late, 0); }
        }
        SEAM(1);
    }
    if (IN(2)) {
#if NAIVE_MIX
        attn_naive(F); hgrn_naive(F);
#else
        mix_phase_a(F, handoff23, cnt23);
#endif
        if (!handoff23) SEAM(2);
    }
    if (IN(3)) {
#if NAIVE_MIX
        hgrn_norm_naive(F);
#else
        mix_phase_b(F, handoff23, cnt23);
#endif

        SEAM(3);
    }
    if (IN(4)) {
        pg8::Gemm g{F.MIXED, F.WOUT, M, D, D}; pg8::StaticOrder S; S.init(M, D, F.G, (int)blockIdx.x);
        pg8::EpiOut E{F.XB, F.out, F.HB, F.PART};
        pg8::gemm_phase<pg8::EpiOut, pg8::StaticOrder, true, true>(F.lds, g, S, E);
        if (PROBE_DUP & 16) { __syncthreads(); pg8::gemm_phase<pg8::EpiOut, pg8::StaticOrder, true, true>(F.lds, g, S, E); }
        SEAM(4);
    }
    if (IN(5)) {
        pg8::Gemm g{F.HB, F.WGU, M, NGU, D}; pg8::StaticOrder S; S.init(M, NGU, F.G, (int)blockIdx.x);
        pg8::EpiGU E{F.ACT, F.PART};
        pg8::gemm_phase<pg8::EpiGU, pg8::StaticOrder, true, true>(F.lds, g, S, E);
        if (PROBE_DUP & 32) { __syncthreads(); pg8::gemm_phase<pg8::EpiGU, pg8::StaticOrder, true, true>(F.lds, g, S, E); }
        {
            const int nwg = (M / 256) * (NGU / 256), rem = nwg % F.G;
            const int first_late = (rem == 0) ? 0 : rem;
            if ((int)blockIdx.x >= first_late) { __syncthreads(); p0_weights_late(F, first_late, 1); }
        }
        SEAM(5);
    }
    if (IN(6)) {
        pg8::Gemm g{F.ACT, F.WDN, M, D, FF}; pg8::StaticOrder S; S.init(M, D, F.G, (int)blockIdx.x);
        pg8::EpiDown E{F.out, F.HB};
        pg8::gemm_phase<pg8::EpiDown, pg8::StaticOrder, true, true>(F.lds, g, S, E);
        if (PROBE_DUP & 256) { __syncthreads(); pg8::gemm_phase<pg8::EpiDown, pg8::StaticOrder, true, true>(F.lds, g, S, E); }
    }
#undef IN
#undef SEAM
}

extern "C" void kernel_launch(void* const* d_in, const int* in_sizes, int n_in, void* d_out, int out_size, void* d_ws, size_t ws_size, hipStream_t stream) {
    static int grid = 0;
    if (grid == 0) {
        if (n_in != 13 || in_sizes[0] != M * D || out_size != M * D || ws_size < WS_END) { fprintf(stderr, "kernel_launch: unexpected shapes (n_in %d, in0 %d, out %d, ws %zu)\n", n_in, n_in > 0 ? in_sizes[0] : -1, out_size, ws_size); grid = -1; return; }
        int dev = 0, cus = 0, per_cu = 0;
        if (hipGetDevice(&dev) != hipSuccess || hipDeviceGetAttribute(&cus, hipDeviceAttributeMultiprocessorCount, dev) != hipSuccess) { grid = -1; return; }
        (void)hipFuncSetAttribute((const void*)fwd<true>, hipFuncAttributeMaxDynamicSharedMemorySize, LDS_BYTES);
        (void)hipFuncSetAttribute((const void*)fwd<false>, hipFuncAttributeMaxDynamicSharedMemorySize, LDS_BYTES);
        if (hipOccupancyMaxActiveBlocksPerMultiprocessor(&per_cu, (const void*)fwd<true>, NWAVES * 64, LDS_BYTES) != hipSuccess || per_cu < 1) {
            fprintf(stderr, "kernel_launch: occupancy query reports %d blocks per CU\n", per_cu); per_cu = 1; }
        (void)hipGetLastError();
        grid = cus;
    }
    if (grid < 0) return;
    if (hipMemsetAsync((char*)d_ws + WS_CTL, 0, 65536, stream) != hipSuccess) { fprintf(stderr, "kernel_launch: memset of the barrier words failed\n"); return; }
    Args a{};
    for (int i = 0; i < 13; ++i) a.in[i] = (const float*)d_in[i];
    a.out = (float*)d_out; a.ws = (unsigned char*)d_ws;
#if MK_N_LAUNCHES == 1
    a.ph_lo = 0; a.ph_hi = N_PHASES;
    void* params[] = {&a};
    hipError_t e = hipLaunchCooperativeKernel((const void*)fwd<true>, dim3(grid), dim3(NWAVES * 64), params, LDS_BYTES, stream);
    if (e != hipSuccess) fprintf(stderr, "cooperative launch failed: %s (grid %d)\n", hipGetErrorString(e), grid);
#else
    for (int ph = 0; ph < N_PHASES; ++ph) {
        a.ph_lo = ph; a.ph_hi = ph + 1;
        hipLaunchKernelGGL(fwd<false>, dim3(grid), dim3(NWAVES * 64), LDS_BYTES, stream, a);
    }
#endif
}
```

```cpp
#include <hip/hip_runtime.h>
#include <hip/hip_cooperative_groups.h>
#include <cstdio>
#include <cstdint>
namespace cg = cooperative_groups;
namespace pg8 {
#define PG8_LAS __attribute__((address_space(3)))
typedef unsigned short bf16_t;
typedef short bf16x8 __attribute__((ext_vector_type(8)));
typedef float f32x4 __attribute__((ext_vector_type(4)));
typedef unsigned u32x4 __attribute__((ext_vector_type(4)));
constexpr int BM = 256, BK = 64, HALF = 128, HTB = HALF * BK * 2  , STAGE_BYTES = 8 * HTB, NXCD = 8, WGM = 8;

__host__ __device__ __forceinline__ int lds_byte(int r, int c) { const int st = (r >> 4) * 2 + (c >> 5), rr = r & 15, cc = c & 31, ob = rr * 64 + cc * 2; return st * 1024 + (ob ^ (((ob >> 9) & 1) << 5)); }
__host__ __device__ __forceinline__ void stage_rc(int b, int& R, int& C) { const int st = b / 1024, sb = b % 1024, swz = sb ^ (((sb >> 9) & 1) << 5); R = (st >> 1) * 16 + swz / 64; C = (st & 1) * 32 + (swz % 64) / 2; }
__host__ __device__ __forceinline__ int perm32(int rho) { const int n = rho >> 4, i = rho & 15; return 8 * (i >> 2) + 4 * n + (i & 3); }

struct Unit { int pm, pn; };
struct Gemm { const bf16_t* A; const bf16_t* Bt; int M, N, K; };

struct StaticOrder {
    int nM, nN, nwg, G, c;
    __host__ __device__ void init(int M, int N, int G_, int c_) { nM = M / BM; nN = N / BM; nwg = nM * nN; G = G_; c = c_; }
    __host__ __device__ bool next(int i, Unit& u) const {
        const long L = (long)i * G + c; if (L >= nwg) return false;
        int wgid = (int)L; { const int q = nwg / NXCD, r = nwg % NXCD, xcd = wgid % NXCD, off = wgid / NXCD; wgid = (xcd < r ? xcd * (q + 1) : r * (q + 1) + (xcd - r) * q) + off; }
        const int nig = WGM * nN, gid = wgid / nig, fm = gid * WGM, gsz = (nM - fm) < WGM ? (nM - fm) : WGM;
        u.pm = fm + ((wgid % nig) % gsz); u.pn = (wgid % nig) / gsz; return true;
    }
    __device__ __forceinline__ void a_ready(const Unit&) const {}
    __device__ __forceinline__ void done(const Unit&) const {}
};

typedef float f32x2 __attribute__((ext_vector_type(2)));
__device__ __forceinline__ unsigned cvt_pk_bf16(float lo, float hi) { unsigned r; asm volatile("v_cvt_pk_bf16_f32 %0, %1, %2" : "=v"(r) : "v"(lo), "v"(hi)); return r; }
typedef __bf16 nbf16x2 __attribute__((ext_vector_type(2)));
__device__ __forceinline__ unsigned cvt_pk_native(float lo, float hi) { f32x2 v = {lo, hi}; return __builtin_bit_cast(unsigned, __builtin_convertvector(v, nbf16x2)); }
typedef float f32x2 __attribute__((ext_vector_type(2)));
template <class Epi, class Sched, bool ALIGN_EPI = false, bool SP2 = false>
__device__ __forceinline__ void gemm_phase(PG8_LAS unsigned char* lds, const Gemm g, const Sched& S, const Epi& E) {
    const int tid = threadIdx.x, wid = __builtin_amdgcn_readfirstlane(tid >> 6), lane = tid & 63, wr = wid >> 2, wc = wid & 3, fr = lane & 15, fq = lane >> 4;
    const int K = g.K, nt = K / BK;
    unsigned voffA[2], voffB[2];
#pragma unroll
    for (int i = 0; i < 2; ++i) { int R, C; stage_rc(tid * 16 + i * 8192, R, C); const int Rb = Epi::PERM ? ((R & ~31) + perm32(R & 31)) : R;
        voffA[i] = (unsigned)(R * K + C) * 2u; voffB[i] = (unsigned)(Rb * K + C) * 2u; }
    const size_t kstep = (size_t)(BK * 2);
    const size_t hstep = (size_t)HALF * K * 2;
    const size_t tstep = 2 * hstep;
    const unsigned ldsw = (unsigned)wid * 1024u;
    const int aoff = lds_byte(wr * 64 + fr, fq * 8), boff = lds_byte(wc * 32 + fr, fq * 8);
#define PG8_SA(b, h) (((b) * 2 + (h)) * HTB)
#define PG8_SB(b, h) ((4 + (b) * 2 + (h)) * HTB)
#define PG8_STAGE(bufoff, gbase, voff) do { _Pragma("unroll") for (int _i = 0; _i < 2; ++_i) \
        __builtin_amdgcn_global_load_lds((const unsigned*)((const char*)(gbase) + (voff)[_i]), (PG8_LAS unsigned*)(lds + (bufoff) + ldsw + _i * 8192), 16, 0, 0); } while (0)
#define PG8_LDA(dst, b, h) do { _Pragma("unroll") for (int m = 0; m < 4; ++m) _Pragma("unroll") for (int k = 0; k < 2; ++k) dst[m][k] = *(const PG8_LAS bf16x8*)(lds + PG8_SA(b, h) + aoff + m * 2048 + k * 1024); } while (0)
#define PG8_LDB(dst, b, h) do { _Pragma("unroll") for (int n = 0; n < 2; ++n) _Pragma("unroll") for (int k = 0; k < 2; ++k) dst[n][k] = *(const PG8_LAS bf16x8*)(lds + PG8_SB(b, h) + boff + n * 2048 + k * 1024); } while (0)
#define PG8_MMA(ai, bj, At, Bt) do { __builtin_amdgcn_s_setprio(1); _Pragma("unroll") for (int m = 0; m < 4; ++m) _Pragma("unroll") for (int n = 0; n < 2; ++n) _Pragma("unroll") for (int k = 0; k < 2; ++k) \
        acc[ai][bj][m][n] = __builtin_amdgcn_mfma_f32_16x16x32_bf16(Bt[n][k], At[m][k], acc[ai][bj][m][n], 0, 0, 0); __builtin_amdgcn_s_setprio(0); } while (0)
#define PG8_WAIT_V(n) asm volatile("s_waitcnt vmcnt(" #n ")" ::: "memory")
#define PG8_WAIT_L(n) asm volatile("s_waitcnt lgkmcnt(" #n ")" ::: "memory")
#define PG8_BAR __builtin_amdgcn_s_barrier()
#define PG8_SCHED __builtin_amdgcn_sched_barrier(0)
    Unit cur, nxt; int ui = 0;
    if (!S.next(0, cur)) return;
    f32x4 acc[2][2][4][2];
#pragma unroll
    for (int a = 0; a < 2; ++a)
#pragma unroll
        for (int b = 0; b < 2; ++b)
#pragma unroll
            for (int m = 0; m < 4; ++m)
#pragma unroll
                for (int n = 0; n < 2; ++n) acc[a][b][m][n] = (f32x4){0.f, 0.f, 0.f, 0.f};
    bf16x8 At[4][2], B0[2][2], B1[2][2];
    const char* cA = (const char*)g.A + (size_t)cur.pm * tstep; const char* cB = (const char*)g.Bt + (size_t)cur.pn * tstep;
    S.a_ready(cur);
    if constexpr (SP2) {
        PG8_STAGE(PG8_SB(0, 0), cB, voffB); PG8_STAGE(PG8_SB(0, 1), cB + hstep, voffB); PG8_STAGE(PG8_SA(0, 0), cA, voffA); PG8_STAGE(PG8_SA(0, 1), cA + hstep, voffA);
        if (wr == 1) PG8_BAR;
        PG8_WAIT_V(2); PG8_BAR;
        PG8_STAGE(PG8_SB(1, 0), cB + kstep, voffB); PG8_STAGE(PG8_SA(1, 0), cA + kstep, voffA); PG8_STAGE(PG8_SB(1, 1), cB + hstep + kstep, voffB);
        PG8_WAIT_V(6); PG8_BAR;
    } else {
        PG8_STAGE(PG8_SB(0, 0), cB, voffB); PG8_STAGE(PG8_SA(0, 0), cA, voffA); PG8_STAGE(PG8_SB(0, 1), cB + hstep, voffB); PG8_STAGE(PG8_SA(0, 1), cA + hstep, voffA);
        if (wr == 1) PG8_BAR;
        PG8_WAIT_V(4); PG8_BAR;
        PG8_STAGE(PG8_SB(1, 0), cB + kstep, voffB); PG8_STAGE(PG8_SA(1, 0), cA + kstep, voffA); PG8_STAGE(PG8_SB(1, 1), cB + hstep + kstep, voffB);
        PG8_WAIT_V(6); PG8_BAR;
    }
    for (;;) {
        const bool has_next = S.next(ui + 1, nxt);
        const char* nA = has_next ? (const char*)g.A + (size_t)nxt.pm * tstep : cA; const char* nB = has_next ? (const char*)g.Bt + (size_t)nxt.pn * tstep : cB;
        for (int t = 0; t < nt; t += 2) {
            const bool last = (t == nt - 2);
            const char* a1 = cA + (size_t)(t + 1) * kstep;
            const char* a2 = last ? nA : cA + (size_t)(t + 2) * kstep; const char* b2 = last ? nB : cB + (size_t)(t + 2) * kstep;
            const char* a3 = a2 + kstep; const char* b3 = b2 + kstep;
            if (last && has_next) S.a_ready(nxt);
            if constexpr (SP2) {
            PG8_LDB(B0, 0, 0); PG8_LDB(B1, 0, 1); PG8_SCHED; PG8_LDA(At, 0, 0); PG8_STAGE(PG8_SA(1, 1), a1 + hstep, voffA);
            PG8_WAIT_V(8); PG8_WAIT_L(0); PG8_BAR; PG8_MMA(0, 0, At, B0); PG8_MMA(0, 1, At, B1); PG8_BAR; PG8_SCHED;
            PG8_LDA(At, 0, 1); PG8_STAGE(PG8_SB(0, 0), b2, voffB); PG8_STAGE(PG8_SB(0, 1), b2 + hstep, voffB); PG8_STAGE(PG8_SA(0, 0), a2, voffA);
            PG8_WAIT_V(8); PG8_WAIT_L(0); PG8_BAR; PG8_MMA(1, 0, At, B0); PG8_MMA(1, 1, At, B1); PG8_BAR; PG8_SCHED;
            PG8_LDB(B0, 1, 0); PG8_LDB(B1, 1, 1); PG8_SCHED; PG8_LDA(At, 1, 0); PG8_STAGE(PG8_SA(0, 1), a2 + hstep, voffA);
            PG8_WAIT_V(8); PG8_WAIT_L(0); PG8_BAR; PG8_MMA(0, 0, At, B0); PG8_MMA(0, 1, At, B1); PG8_BAR; PG8_SCHED;
            PG8_LDA(At, 1, 1); PG8_STAGE(PG8_SB(1, 0), b3, voffB); PG8_STAGE(PG8_SB(1, 1), b3 + hstep, voffB); PG8_STAGE(PG8_SA(1, 0), a3, voffA);
            PG8_WAIT_V(8); PG8_WAIT_L(0); PG8_BAR; PG8_MMA(1, 0, At, B0); PG8_MMA(1, 1, At, B1); PG8_BAR; PG8_SCHED;
            } else {
            PG8_LDB(B0, 0, 0); PG8_SCHED; PG8_LDA(At, 0, 0); PG8_STAGE(PG8_SA(1, 1), a1 + hstep, voffA);
            PG8_WAIT_L(8); PG8_BAR; PG8_WAIT_L(0); PG8_MMA(0, 0, At, B0); PG8_BAR; PG8_SCHED;
            PG8_LDB(B1, 0, 1); PG8_STAGE(PG8_SB(0, 0), b2, voffB);
            PG8_BAR; PG8_WAIT_L(0); PG8_MMA(0, 1, At, B1); PG8_BAR;
            PG8_LDA(At, 0, 1); PG8_STAGE(PG8_SA(0, 0), a2, voffA);
            PG8_BAR; PG8_WAIT_L(0); PG8_MMA(1, 0, At, B0); PG8_BAR; PG8_SCHED;
            PG8_STAGE(PG8_SB(0, 1), b2 + hstep, voffB);
            PG8_WAIT_V(6); PG8_BAR; PG8_MMA(1, 1, At, B1); PG8_BAR;
            PG8_LDB(B0, 1, 0); PG8_SCHED; PG8_LDA(At, 1, 0); PG8_STAGE(PG8_SA(0, 1), a2 + hstep, voffA);
            PG8_WAIT_L(8); PG8_BAR; PG8_WAIT_L(0); PG8_MMA(0, 0, At, B0); PG8_BAR; PG8_SCHED;
            PG8_LDB(B1, 1, 1); PG8_STAGE(PG8_SB(1, 0), b3, voffB);
            PG8_BAR; PG8_WAIT_L(0); PG8_MMA(0, 1, At, B1); PG8_BAR;
            PG8_LDA(At, 1, 1); PG8_STAGE(PG8_SA(1, 0), a3, voffA);
            PG8_BAR; PG8_WAIT_L(0); PG8_MMA(1, 0, At, B0); PG8_BAR; PG8_SCHED;
            PG8_STAGE(PG8_SB(1, 1), b3 + hstep, voffB);
            PG8_WAIT_V(6); PG8_BAR; PG8_MMA(1, 1, At, B1); PG8_BAR;
            }
        }
        if constexpr (ALIGN_EPI) { if (wr == 0) PG8_BAR; }
        if constexpr (!Epi::AFTER_DRAIN) { E(acc, cur, wr, wc, fr, fq); S.done(cur); }
        if (!has_next) break;
#pragma unroll
        for (int a = 0; a < 2; ++a)
#pragma unroll
            for (int b = 0; b < 2; ++b)
#pragma unroll
                for (int m = 0; m < 4; ++m)
#pragma unroll
                    for (int n = 0; n < 2; ++n) acc[a][b][m][n] = (f32x4){0.f, 0.f, 0.f, 0.f};
        cur = nxt; cA = nA; cB = nB; ++ui;
        if constexpr (ALIGN_EPI) { if (wr == 1) PG8_BAR; }
    }
    PG8_WAIT_V(0);
    if constexpr (!ALIGN_EPI) { if (wr == 0) PG8_BAR; }
    PG8_BAR;
    if constexpr (Epi::AFTER_DRAIN) { E.fused(acc, cur, wr, wc, fr, fq, lds, wid, lane); S.done(cur); }
#undef PG8_SA
#undef PG8_SB
#undef PG8_STAGE
#undef PG8_LDA
#undef PG8_LDB
#undef PG8_MMA
#undef PG8_WAIT_V
#undef PG8_WAIT_L
#undef PG8_BAR
#undef PG8_SCHED
}
}

#define GAS __attribute__((address_space(1)))
#define LAS __attribute__((address_space(3)))
typedef unsigned short bf16;
typedef unsigned v4u __attribute__((ext_vector_type(4)));
typedef unsigned v2u __attribute__((ext_vector_type(2)));
typedef float f32x4 __attribute__((ext_vector_type(4)));
typedef short bf16x8 __attribute__((ext_vector_type(8)));
typedef short bf16x4 __attribute__((ext_vector_type(4)));

constexpr int NWAVES = 8;
constexpr int NB = 8, SEQ = 2048, D = 1024, M = NB * SEQ;
constexpr int PW = 2816, FF = 2816, NGU = 2 * FF;
constexpr int HH = 4, DK = 128, DV = 128, HW = 512;
constexpr int AH = 8, KVH = 2, AG = 4, HD = 64;
constexpr int C_Q = 0, C_F = 512, C_I = 1024, C_G = 1536, C_AQ = 2048, C_AK = 2560, C_AV = 2688;
constexpr float EPS = 1e-6f;

constexpr size_t MiB = 1u << 20;
constexpr size_t WS_CTL = 0;
constexpr size_t WS_WIN = 2 * MiB, WS_WOUT = 8 * MiB, WS_WGU = 10 * MiB, WS_WDN = 21 * MiB;
constexpr size_t WS_RSTD1 = 27 * MiB, WS_PART = 28 * MiB, WS_DTOT = 29 * MiB;
constexpr size_t WS_XB = 32 * MiB;
constexpr size_t WS_OLOC = 184 * MiB;
constexpr size_t WS_PROJ = 64 * MiB;
constexpr size_t WS_ACT = 64 * MiB;
constexpr size_t WS_MIXED = 152 * MiB;
constexpr size_t WS_HB = 184 * MiB;
constexpr size_t WS_LBUF = 216 * MiB;
constexpr size_t WS_QDS = 232 * MiB;
constexpr size_t WS_END = 256 * MiB;

constexpr int LDS_BYTES = 147456;

#define LDS_WAIT() asm volatile("s_waitcnt lgkmcnt(0)" ::: "memory")
#define VM_WAIT() asm volatile("s_waitcnt vmcnt(0)" ::: "memory")
__device__ __forceinline__ unsigned f2bf(float f) { unsigned u = __builtin_bit_cast(unsigned, f); return (u + 0x7fffu + ((u >> 16) & 1u)) >> 16; }
__device__ __forceinline__ unsigned pk2(float lo, float hi) { return f2bf(lo) | (f2bf(hi) << 16); }
__device__ __forceinline__ float bf2f(unsigned short b) { return __builtin_bit_cast(float, (unsigned)b << 16); }
__device__ __forceinline__ float bflo(unsigned w) { return __builtin_bit_cast(float, w << 16); }
__device__ __forceinline__ float bfhi(unsigned w) { return __builtin_bit_cast(float, w & 0xffff0000u); }
__device__ __forceinline__ float wave_sum(float v) {
#pragma unroll
    for (int o = 1; o < 64; o <<= 1) v += __shfl_xor(v, o);
    return v;
}
__device__ __forceinline__ float silu_f(float v) { return v / (1.0f + __expf(-v)); }

struct Frame {
    LAS unsigned char* lds;
    int tid, lane, wave, G;
    const float *x, *g1, *w_in, *lbl, *ogain, *qg, *kg, *sinks, *w_out, *g2, *w_gate, *w_up, *w_down;
    float* out;
    bf16 *WIN, *WOUT, *WGU, *WDN, *XB, *PROJ, *ACT, *MIXED, *HB, *QDS;
    float *RSTD1, *PART, *DTOT, *OLOC, *LBUF;
};

namespace pg8 {
struct EpiProj {
    static constexpr bool PERM = true, AFTER_DRAIN = false;
    bf16_t* O; const float* rstd; const float* lbl;
    __device__ __forceinline__ void operator()(const f32x4 (&acc)[2][2][4][2], const Unit& u, int wr, int wc, int fr, int fq) const {
        const int row0 = u.pm * BM + wr * 64 + fr;
#pragma unroll
        for (int bj = 0; bj < 2; ++bj) {
            const int col0 = u.pn * BM + bj * HALF + wc * 32 + 8 * fq;
            const int seg = __builtin_amdgcn_readfirstlane(col0 >> 9);
            float lb[8];
#pragma unroll
            for (int i = 0; i < 8; ++i) lb[i] = 0.f;
            if (seg == 1) {
                const int ci = col0 & 511;
#pragma unroll
                for (int i = 0; i < 8; ++i) { const float l0 = lbl[ci + i], l1 = lbl[512 + ci + i]; lb[i] = __builtin_amdgcn_rcpf(1.0f + __expf(l1 - l0)); }
            }
#pragma unroll
            for (int ai = 0; ai < 2; ++ai)
#pragma unroll
                for (int m = 0; m < 4; ++m) {
                    const int row = row0 + ai * HALF + m * 16; const float rs = rstd[row];
                    float v[8];
#pragma unroll
                    for (int i = 0; i < 4; ++i) { v[i] = acc[ai][bj][m][0][i] * rs; v[4 + i] = acc[ai][bj][m][1][i] * rs; }
                    if (seg == 0) {
#pragma unroll
                        for (int i = 0; i < 8; ++i) v[i] = v[i] * __builtin_amdgcn_rcpf(1.0f + __expf(-v[i])) * 0.08838834764831845f;
                    } else if (seg == 1) {
#pragma unroll
                        for (int i = 0; i < 8; ++i) { const float s = __builtin_amdgcn_rcpf(1.0f + __expf(-v[i])); v[i] = __logf(lb[i] + (1.0f - lb[i]) * s); }
                    } else if (seg == 3) {
#pragma unroll
                        for (int i = 0; i < 8; ++i) v[i] = v[i] * __builtin_amdgcn_rcpf(1.0f + __expf(-v[i]));
                    }
                    u32x4 w; w.x = cvt_pk_bf16(v[0], v[1]); w.y = cvt_pk_bf16(v[2], v[3]); w.z = cvt_pk_bf16(v[4], v[5]); w.w = cvt_pk_bf16(v[6], v[7]);
                    *(u32x4*)(O + (size_t)row * 2816 + col0) = w;
                }
        }
    }
};
struct EpiOut {
    static constexpr bool PERM = true, AFTER_DRAIN = false;
    const bf16_t* x; float* out; bf16_t* hb; float* part;
    __device__ __forceinline__ void operator()(const f32x4 (&acc)[2][2][4][2], const Unit& u, int wr, int wc, int fr, int fq) const {
        const int row0 = u.pm * BM + wr * 64 + fr;
#pragma unroll
        for (int ai = 0; ai < 2; ++ai)
#pragma unroll
            for (int m = 0; m < 4; ++m) {
                const int row = row0 + ai * HALF + m * 16; float ss = 0.f;
#pragma unroll
                for (int bj = 0; bj < 2; ++bj) {
                    const size_t off = (size_t)row * 1024 + u.pn * BM + bj * HALF + wc * 32 + 8 * fq;
                    const u32x4 xw = *(const u32x4*)(x + off);
                    f32x4 x0, x1;
                    x0[0] = __builtin_bit_cast(float, xw.x << 16); x0[1] = __builtin_bit_cast(float, xw.x & 0xffff0000u); x0[2] = __builtin_bit_cast(float, xw.y << 16); x0[3] = __builtin_bit_cast(float, xw.y & 0xffff0000u);
                    x1[0] = __builtin_bit_cast(float, xw.z << 16); x1[1] = __builtin_bit_cast(float, xw.z & 0xffff0000u); x1[2] = __builtin_bit_cast(float, xw.w << 16); x1[3] = __builtin_bit_cast(float, xw.w & 0xffff0000u);
                    const f32x4 h0 = x0 + acc[ai][bj][m][0], h1 = x1 + acc[ai][bj][m][1];
                    u32x4 w; w.x = cvt_pk_bf16(h0[0], h0[1]); w.y = cvt_pk_bf16(h0[2], h0[3]); w.z = cvt_pk_bf16(h1[0], h1[1]); w.w = cvt_pk_bf16(h1[2], h1[3]);
                    *(u32x4*)(hb + off) = w;
                    ss += ((h0[0] * h0[0] + h0[1] * h0[1]) + (h0[2] * h0[2] + h0[3] * h0[3])) + ((h1[0] * h1[0] + h1[1] * h1[1]) + (h1[2] * h1[2] + h1[3] * h1[3]));
                }
                ss += __shfl_xor(ss, 16); ss += __shfl_xor(ss, 32);
                if (fq == 0) part[(size_t)row * 16 + u.pn * 4 + wc] = ss;
            }
    }
};
struct EpiGU {
    static constexpr bool PERM = true, AFTER_DRAIN = false;
    bf16_t* O; const float* part; const LAS float* rsc; int rbase;
    __device__ __forceinline__ void operator()(const f32x4 (&acc)[2][2][4][2], const Unit& u, int wr, int wc, int fr, int fq) const {
        const int row0 = u.pm * BM + wr * 64 + fr;
#pragma unroll
        for (int ai = 0; ai < 2; ++ai)
#pragma unroll
            for (int m = 0; m < 4; ++m) {
                const int row = row0 + ai * HALF + m * 16;
                float rs;
                if (rsc) rs = rsc[row - rbase];
                else {
                    const f32x4* pp = (const f32x4*)(part + (size_t)row * 16);
                    const f32x4 p0 = pp[0], p1 = pp[1], p2 = pp[2], p3 = pp[3];
                    const float ssq = ((p0[0] + p0[1]) + (p0[2] + p0[3])) + ((p1[0] + p1[1]) + (p1[2] + p1[3])) + ((p2[0] + p2[1]) + (p2[2] + p2[3])) + ((p3[0] + p3[1]) + (p3[2] + p3[3]));
                    rs = __builtin_amdgcn_rsqf(ssq * (1.0f / 1024.0f) + 1e-6f);
                }
                float v[8];
#pragma unroll
                for (int n = 0; n < 2; ++n)
#pragma unroll
                    for (int i = 0; i < 4; ++i) { const float g = acc[ai][0][m][n][i] * rs, up = acc[ai][1][m][n][i] * rs; v[4 * n + i] = g * __builtin_amdgcn_rcpf(1.0f + __expf(-g)) * up; }
                u32x4 w; w.x = cvt_pk_bf16(v[0], v[1]); w.y = cvt_pk_bf16(v[2], v[3]); w.z = cvt_pk_bf16(v[4], v[5]); w.w = cvt_pk_bf16(v[6], v[7]);
                *(u32x4*)(O + (size_t)row * 2816 + u.pn * HALF + wc * 32 + 8 * fq) = w;
            }
    }
};
struct EpiDown {
    static constexpr bool PERM = true, AFTER_DRAIN = false;
    float* out; const bf16_t* hb;
    __device__ __forceinline__ void operator()(const f32x4 (&acc)[2][2][4][2], const Unit& u, int wr, int wc, int fr, int fq) const {
        const int row0 = u.pm * BM + wr * 64 + fr;
#pragma unroll
        for (int ai = 0; ai < 2; ++ai)
#pragma unroll
            for (int m = 0; m < 4; ++m) {
                const int row = row0 + ai * HALF + m * 16;
#pragma unroll
                for (int bj = 0; bj < 2; ++bj) {
                    const size_t off = (size_t)row * 1024 + u.pn * BM + bj * HALF + wc * 32 + 8 * fq;
                    const u32x4 hw = *(const u32x4*)(hb + off);
                    f32x4 h0, h1;
                    h0[0] = __builtin_bit_cast(float, hw.x << 16); h0[1] = __builtin_bit_cast(float, hw.x & 0xffff0000u); h0[2] = __builtin_bit_cast(float, hw.y << 16); h0[3] = __builtin_bit_cast(float, hw.y & 0xffff0000u);
                    h1[0] = __builtin_bit_cast(float, hw.z << 16); h1[1] = __builtin_bit_cast(float, hw.z & 0xffff0000u); h1[2] = __builtin_bit_cast(float, hw.w << 16); h1[3] = __builtin_bit_cast(float, hw.w & 0xffff0000u);
                    __builtin_nontemporal_store(h0 + acc[ai][bj][m][0], (f32x4*)(out + off));
                    __builtin_nontemporal_store(h1 + acc[ai][bj][m][1], (f32x4*)(out + off + 4));
                }
            }
    }
};
}

__device__ __forceinline__ void p0_transpose_item(const float* W, int K, int N, bf16* WT, const float* gain, int mode, LAS float* scr, int item, int lane) {
    const int nblk = N / 32, kb = item / nblk, nb = item % nblk, k0 = 64 * kb, n0 = 32 * nb;
#pragma unroll 8
    for (int i = 0; i < 32; ++i) { const int kk = 2 * i + (lane >> 5); scr[kk * 33 + (lane & 31)] = __builtin_nontemporal_load(W + (size_t)(k0 + kk) * N + n0 + (lane & 31)); }
    LDS_WAIT(); asm volatile("" ::: "memory");
    const int c = lane & 7;
    float g[8];
#pragma unroll
    for (int i = 0; i < 8; ++i) g[i] = gain ? gain[k0 + 8 * c + i] : 1.0f;
    const int rbase = (mode == 0) ? n0 : (256 * (n0 >> 7) + (n0 & 127) + (mode == 2 ? 128 : 0));
#pragma unroll
    for (int j = 0; j < 4; ++j) { const int n = (lane >> 3) + 8 * j; const LAS float* s = scr + (8 * c) * 33 + n;
        v4u o; o.x = pk2(s[0 * 33] * g[0], s[1 * 33] * g[1]); o.y = pk2(s[2 * 33] * g[2], s[3 * 33] * g[3]); o.z = pk2(s[4 * 33] * g[4], s[5 * 33] * g[5]); o.w = pk2(s[6 * 33] * g[6], s[7 * 33] * g[7]);
        *(GAS v4u*)(WT + (size_t)(rbase + n) * K + k0 + 8 * c) = o; }
    LDS_WAIT(); asm volatile("" ::: "memory");
}
__device__ __forceinline__ void p0_weights_late(Frame& F, int first_block, int which) {
    int wv = threadIdx.x >> 6, ln = threadIdx.x & 63;
    asm volatile("" : "+v"(wv), "+v"(ln));
    wv = __builtin_amdgcn_readfirstlane(wv);
    LAS float* scr = (LAS float*)(F.lds + wv * 16384);
    const int gw = (blockIdx.x - first_block) * NWAVES + wv, NGW = (F.G - first_block) * NWAVES;
    constexpr int I_OUT = (D / 64) * (D / 32), I_G = (D / 64) * (FF / 32), I_DN = (FF / 64) * (D / 32);
    if (which == 0) {
        for (int it = gw; it < I_OUT + 2 * I_G; it += NGW) {
            int r = it;
            if (r < I_OUT) { p0_transpose_item(F.w_out, D, D, F.WOUT, nullptr, 0, scr, r, ln); continue; } r -= I_OUT;
            if (r < I_G) { p0_transpose_item(F.w_gate, D, FF, F.WGU, F.g2, 1, scr, r, ln); continue; } r -= I_G;
            p0_transpose_item(F.w_up, D, FF, F.WGU, F.g2, 2, scr, r, ln);
        }
    } else {
        for (int it = gw; it < I_DN; it += NGW) p0_transpose_item(F.w_down, FF, D, F.WDN, nullptr, 0, scr, it, ln);
    }
}
__device__ __forceinline__ void p0_prologue(Frame& F) {
    LAS float* scr = (LAS float*)(F.lds + F.wave * 16384);
    const int gw = blockIdx.x * NWAVES + F.wave, NGW = F.G * NWAVES;
    constexpr int I_IN = (D / 64) * (PW / 32);
    for (int it = gw; it < I_IN; it += NGW) p0_transpose_item(F.w_in, D, PW, F.WIN, F.g1, 0, scr, it, F.lane);
    for (int m = gw; m < M; m += NGW) {
        const GAS f32x4* xr = (const GAS f32x4*)(F.x + (size_t)m * D) + F.lane;
        f32x4 v[4]; float s = 0.f;
#pragma unroll
        for (int j = 0; j < 4; ++j) { v[j] = __builtin_nontemporal_load(xr + 64 * j); s += (v[j].x * v[j].x + v[j].y * v[j].y) + (v[j].z * v[j].z + v[j].w * v[j].w); }
        s = wave_sum(s);
        if (F.lane == 0) F.RSTD1[m] = 1.0f / sqrtf(s * (1.0f / D) + EPS);
        GAS unsigned long long* o8 = (GAS unsigned long long*)(F.XB + (size_t)m * D) + F.lane;
#pragma unroll
        for (int j = 0; j < 4; ++j) o8[64 * j] = (unsigned long long)pk2(v[j].x, v[j].y) | ((unsigned long long)pk2(v[j].z, v[j].w) << 32);
    }
}

#define XB_TMO      128
#define XB_XCNT(j)  (256  + 64 * (j))
#define XB_XSUB(j)  (1280 + 64 * (j))
#define XB_XGEN(j)  (2304 + 64 * (j))
#define XB_TOP      3328
#define XB_TOPGEN   3392
#define XCD_BAR_WORDS 3456
#define XB_SPIN_CAP (1u << 18)

__device__ __forceinline__ unsigned xb_ld(unsigned* p)              { return __hip_atomic_load(p, __ATOMIC_RELAXED, __HIP_MEMORY_SCOPE_AGENT); }
__device__ __forceinline__ unsigned xb_add(unsigned* p, unsigned v) { return __hip_atomic_fetch_add(p, v, __ATOMIC_RELAXED, __HIP_MEMORY_SCOPE_AGENT); }
__device__ __forceinline__ unsigned xb_xcc_id() { return (unsigned)__builtin_amdgcn_s_getreg((3 << 11) | 20) & 0xFu; }
#define XB_SPIN(cond, bar) do { unsigned _sp = 0; while (cond) { __builtin_amdgcn_s_sleep(1); \
    if ((++_sp & 255u) == 0u) { if (xb_ld(&(bar)[XB_TMO])) break; if (_sp > XB_SPIN_CAP) { atomicAdd(&(bar)[XB_TMO], 1u); break; } } } } while (0)

struct XcdBarrier {
    unsigned* bar; unsigned x;
    volatile LAS unsigned* st;
};

__device__ __forceinline__ XcdBarrier xcd_barrier_post(unsigned* bar, volatile LAS unsigned* st) {
    XcdBarrier b; b.bar = bar; b.x = xb_xcc_id(); b.st = st;
    if (threadIdx.x == 0) (void)xb_add(&bar[XB_XCNT(b.x)], 1u);
    return b;
}
__device__ __forceinline__ void xcd_barrier_complete(unsigned* bar, unsigned x, unsigned& nloc, unsigned& nx) {
    const unsigned G = gridDim.x * gridDim.y * gridDim.z;
    unsigned sum, cnt, mine, sp = 0u;
    for (;;) {
        sum = 0u; cnt = 0u; mine = 0u;
#pragma unroll
        for (unsigned j = 0; j < 16; ++j) { const unsigned c = xb_ld(&bar[XB_XCNT(j)]); sum += c; cnt += (c > 0u) ? 1u : 0u; mine = (j == x) ? c : mine; }
        if (sum == G) break;
        __builtin_amdgcn_s_sleep(1);
        if ((++sp & 255u) == 0u) { if (xb_ld(&bar[XB_TMO])) break; if (sp > XB_SPIN_CAP) { atomicAdd(&bar[XB_TMO], 1u); break; } }
    }
    nloc = mine > 0u ? mine : 1u; nx = cnt > 0u ? cnt : 1u;
}

__device__ __forceinline__ void xcd_barrier(const XcdBarrier& b) {
    asm volatile("s_waitcnt vmcnt(0)" ::: "memory");
    __syncthreads();
    if (threadIdx.x == 0) {
        unsigned* bar = b.bar;
        __builtin_amdgcn_s_waitcnt(0);
        unsigned nloc = b.st[0], nx = b.st[1];
        if (nloc == 0u) { xcd_barrier_complete(bar, b.x, nloc, nx); b.st[0] = nloc; b.st[1] = nx; }
        const unsigned old = xb_add(&bar[XB_XSUB(b.x)], 1u);
        const unsigned gen = old / nloc;
        if (old + 1u == (gen + 1u) * nloc) {
            __builtin_amdgcn_fence(__ATOMIC_RELEASE, "agent");
            asm volatile("s_waitcnt vmcnt(0)" ::: "memory");
            const unsigned og = xb_add(&bar[XB_TOP], 1u);
            const unsigned tg = og / nx;
            if (og + 1u == (tg + 1u) * nx) xb_add(&bar[XB_TOPGEN], 1u);
            else XB_SPIN(xb_ld(&bar[XB_TOPGEN]) == tg, bar);
            __builtin_amdgcn_fence(__ATOMIC_ACQUIRE, "agent");
            xb_add(&bar[XB_XGEN(b.x)], 1u);
            asm volatile("s_waitcnt vmcnt(0)" ::: "memory");
        } else {
            XB_SPIN(xb_ld(&bar[XB_XGEN(b.x)]) == gen, bar);
            __builtin_amdgcn_fence(__ATOMIC_ACQUIRE, "agent");
            asm volatile("s_waitcnt vmcnt(0)" ::: "memory");
        }
    }
    __syncthreads();
}
#define NAIVE_ATTN 0
#define NAIVE_HGRN 0

__device__ __forceinline__ void hgrn_naive(Frame& F) {
    if (blockIdx.x >= 64 || F.wave != 0) return;
    const int item = blockIdx.x; const int b = item >> 3, h = (item >> 1) & 3, v = (item & 1) * 64 + F.lane;
    float S[128];
#pragma unroll
    for (int c = 0; c < 128; ++c) S[c] = 0.f;
    for (int t = 0; t < SEQ; ++t) {
        const size_t row = (size_t)b * SEQ + t; const bf16* pr = F.PROJ + row * PW;
        const float vv = bf2f(pr[C_I + h * 128 + v]);
        float o = 0.f;
#pragma unroll
        for (int c8 = 0; c8 < 16; ++c8) {
            const v4u qw = *(const v4u*)(pr + C_Q + h * 128 + c8 * 8); const v4u fw = *(const v4u*)(pr + C_F + h * 128 + c8 * 8);
#pragma unroll
            for (int i = 0; i < 4; ++i) {
                const float q0 = bflo(qw[i]), q1 = bfhi(qw[i]); const float f0 = __expf(bflo(fw[i])), f1 = __expf(bfhi(fw[i]));
                S[c8 * 8 + 2 * i] = f0 * S[c8 * 8 + 2 * i] + (1.0f - f0) * vv; o += q0 * S[c8 * 8 + 2 * i];
                S[c8 * 8 + 2 * i + 1] = f1 * S[c8 * 8 + 2 * i + 1] + (1.0f - f1) * vv; o += q1 * S[c8 * 8 + 2 * i + 1];
            }
        }
        F.OLOC[row * 512 + h * 128 + v] = o;
    }
}
__device__ __forceinline__ void attn_naive(Frame& F) {
    for (int id = blockIdx.x * 512 + F.tid; id < NB * AH * SEQ; id += F.G * 512) {
        const int t = id & 2047, qh = (id >> 11) & 7, b = id >> 14, kvh = qh >> 2;
        const size_t row = (size_t)b * SEQ + t;
        float q[64]; float ss = 0.f;
        { const bf16* qr = F.PROJ + row * PW + C_AQ + qh * 64;
#pragma unroll
          for (int d8 = 0; d8 < 8; ++d8) { const v4u w = *(const v4u*)(qr + d8 * 8);
#pragma unroll
              for (int i = 0; i < 4; ++i) { q[d8 * 8 + 2 * i] = bflo(w[i]); q[d8 * 8 + 2 * i + 1] = bfhi(w[i]); } }
#pragma unroll
          for (int d = 0; d < 64; ++d) ss += q[d] * q[d];
          const float rs = 1.0f / sqrtf(ss * (1.0f / 64.0f) + EPS);
#pragma unroll
          for (int d = 0; d < 64; ++d) q[d] = q[d] * rs * F.qg[d] * 0.125f * F.kg[d]; }
        float m = F.sinks[qh], l = 1.0f; float acc[64];
#pragma unroll
        for (int d = 0; d < 64; ++d) acc[d] = 0.f;
        const int k0 = t - 127 < 0 ? 0 : t - 127;
        for (int kp = k0; kp <= t; ++kp) {
            const bf16* kr = F.PROJ + ((size_t)b * SEQ + kp) * PW + C_AK + kvh * 64;
            float kss = 0.f, dot = 0.f;
#pragma unroll
            for (int d8 = 0; d8 < 8; ++d8) { const v4u w = *(const v4u*)(kr + d8 * 8);
#pragma unroll
                for (int i = 0; i < 4; ++i) { const float a = bflo(w[i]), c = bfhi(w[i]); kss += a * a + c * c; dot += q[d8 * 8 + 2 * i] * a + q[d8 * 8 + 2 * i + 1] * c; } }
            const float s = dot / sqrtf(kss * (1.0f / 64.0f) + EPS);
            const float mn = fmaxf(m, s), sc = __expf(m - mn), p = __expf(s - mn);
            l = l * sc + p; m = mn;
            const bf16* vr = F.PROJ + ((size_t)b * SEQ + kp) * PW + C_AV + kvh * 64;
#pragma unroll
            for (int d8 = 0; d8 < 8; ++d8) { const v4u w = *(const v4u*)(vr + d8 * 8);
#pragma unroll
                for (int i = 0; i < 4; ++i) { acc[d8 * 8 + 2 * i] = acc[d8 * 8 + 2 * i] * sc + p * bflo(w[i]); acc[d8 * 8 + 2 * i + 1] = acc[d8 * 8 + 2 * i + 1] * sc + p * bfhi(w[i]); } }
        }
        const float il = 1.0f / l;
        bf16* orow = F.MIXED + row * D + 512 + qh * 64;
#pragma unroll
        for (int d8 = 0; d8 < 8; ++d8) { v4u w;
#pragma unroll
            for (int i = 0; i < 4; ++i) w[i] = pk2(acc[d8 * 8 + 2 * i] * il, acc[d8 * 8 + 2 * i + 1] * il);
            *(v4u*)(orow + d8 * 8) = w; }
    }
}
__device__ __forceinline__ void hgrn_norm_naive(Frame& F) {
    const int gw = blockIdx.x * NWAVES + F.wave, NGW = F.G * NWAVES;
    for (int it = gw; it < M * 4; it += NGW) {
        const int row = it >> 2, h = it & 3;
        const float* o = F.OLOC + (size_t)row * 512 + h * 128;
        const float a = o[F.lane], c = o[64 + F.lane];
        const float ss = wave_sum(a * a + c * c); const float rs = 1.0f / sqrtf(ss * (1.0f / 128.0f) + EPS);
        const bf16* gr = F.PROJ + (size_t)row * PW + C_G + h * 128;
        bf16* mr = F.MIXED + (size_t)row * D + h * 128;
        mr[F.lane] = (bf16)f2bf(a * rs * F.ogain[F.lane] * bf2f(gr[F.lane]));
        mr[64 + F.lane] = (bf16)f2bf(c * rs * F.ogain[64 + F.lane] * bf2f(gr[64 + F.lane]));
    }
}

#ifndef PROBE_DUP
#define PROBE_DUP 0
#endif
#ifndef HGRN_WS
#define HGRN_WS 1
#endif
__device__ __forceinline__ bf16x8 pack8(const f32x4 a, const f32x4 b) {
    v4u w; w.x = pg8::cvt_pk_native(a[0], a[1]); w.y = pg8::cvt_pk_native(a[2], a[3]); w.z = pg8::cvt_pk_native(b[0], b[1]); w.w = pg8::cvt_pk_native(b[2], b[3]);
    return __builtin_bit_cast(bf16x8, w);
}
__device__ __forceinline__ bf16x8 join8(const v2u lo, const v2u hi) { v4u w; w.x = lo.x; w.y = lo.y; w.z = hi.x; w.w = hi.y; return __builtin_bit_cast(bf16x8, w); }
#define MFMA16(a, b, c) __builtin_amdgcn_mfma_f32_16x16x32_bf16((a), (b), (c), 0, 0, 0)
#define LDS_BARRIER() do { asm volatile("s_waitcnt lgkmcnt(0)" ::: "memory"); __builtin_amdgcn_s_barrier(); asm volatile("" ::: "memory"); } while (0)

constexpr int KS_STRIDE = 72, VT2_STRIDE = 264;
constexpr int AT_KS = 0, AT_VT = 256 * KS_STRIDE * 2;
__device__ __forceinline__ void attn_item(Frame& F, int item) {
    const int b = item >> 5, kvh = (item >> 4) & 1, qb = item & 15, p0 = qb * 128;
    const int tid = F.tid, lane = F.lane, w = F.wave, quad = lane >> 4, l15 = lane & 15;
    LAS bf16* Ks = (LAS bf16*)(F.lds + AT_KS); LAS bf16* Vt = (LAS bf16*)(F.lds + AT_VT);
    const size_t row = (size_t)b * SEQ + p0 + 16 * w + l15;
    {
        const int key = tid >> 1, half = tid & 1, pos = p0 - 128 + key;
        v4u kw[4], vw[4];
        if (pos >= 0) {
            const v4u* kr = (const v4u*)(F.PROJ + ((size_t)b * SEQ + pos) * PW + C_AK + kvh * 64 + half * 32);
            const v4u* vr = (const v4u*)(F.PROJ + ((size_t)b * SEQ + pos) * PW + C_AV + kvh * 64 + half * 32);
#pragma unroll
            for (int i = 0; i < 4; ++i) { kw[i] = kr[i]; vw[i] = vr[i]; }
        } else {
#pragma unroll
            for (int i = 0; i < 4; ++i) { kw[i] = (v4u){0u, 0u, 0u, 0u}; vw[i] = (v4u){0u, 0u, 0u, 0u}; }
        }
        float ss = 0.f;
#pragma unroll
        for (int i = 0; i < 4; ++i)
#pragma unroll
            for (int j = 0; j < 4; ++j) { const float a = bflo(kw[i][j]), c = bfhi(kw[i][j]); ss += a * a + c * c; }
        ss += __shfl_xor(ss, 1);
        const float rs = __builtin_amdgcn_rsqf(ss * (1.0f / 64.0f) + EPS);
#pragma unroll
        for (int i = 0; i < 4; ++i) {
            const f32x4 g0 = *(const f32x4*)(F.kg + half * 32 + 8 * i), g1 = *(const f32x4*)(F.kg + half * 32 + 8 * i + 4);
            v4u o;
            o.x = pk2(bflo(kw[i][0]) * rs * g0[0], bfhi(kw[i][0]) * rs * g0[1]); o.y = pk2(bflo(kw[i][1]) * rs * g0[2], bfhi(kw[i][1]) * rs * g0[3]);
            o.z = pk2(bflo(kw[i][2]) * rs * g1[0], bfhi(kw[i][2]) * rs * g1[1]); o.w = pk2(bflo(kw[i][3]) * rs * g1[2], bfhi(kw[i][3]) * rs * g1[3]);
            *(LAS v4u*)(Ks + key * KS_STRIDE + half * 32 + 8 * i) = o;
#pragma unroll
            for (int j = 0; j < 4; ++j) {
                Vt[(half * 32 + 8 * i + 2 * j) * VT2_STRIDE + key] = (bf16)(vw[i][j] & 0xffffu);
                Vt[(half * 32 + 8 * i + 2 * j + 1) * VT2_STRIDE + key] = (bf16)(vw[i][j] >> 16);
            }
        }
    }
    __syncthreads();
    bf16x8 kf[9][2];
#pragma unroll
    for (int kt = 0; kt < 9; ++kt)
#pragma unroll
        for (int ks = 0; ks < 2; ++ks) kf[kt][ks] = *(const LAS bf16x8*)(Ks + (16 * w + 16 * kt + l15) * KS_STRIDE + 32 * ks + 8 * quad);
    const float NEG = -1e30f;
    for (int g = 0; g < AG; ++g) {
        const int qh = kvh * AG + g;
        bf16x8 bq[2];
        {
            v4u qw[2]; float ss = 0.f;
#pragma unroll
            for (int ks = 0; ks < 2; ++ks) { qw[ks] = *(const v4u*)(F.PROJ + row * PW + C_AQ + qh * 64 + 32 * ks + 8 * quad);
#pragma unroll
                for (int j = 0; j < 4; ++j) { const float a = bflo(qw[ks][j]), c = bfhi(qw[ks][j]); ss += a * a + c * c; } }
            ss += __shfl_xor(ss, 16); ss += __shfl_xor(ss, 32);
            const float rs = 0.125f * __builtin_amdgcn_rsqf(ss * (1.0f / 64.0f) + EPS);
#pragma unroll
            for (int ks = 0; ks < 2; ++ks) {
                const f32x4 g0 = *(const f32x4*)(F.qg + 32 * ks + 8 * quad), g1 = *(const f32x4*)(F.qg + 32 * ks + 8 * quad + 4);
                v4u o;
                o.x = pk2(bflo(qw[ks][0]) * rs * g0[0], bfhi(qw[ks][0]) * rs * g0[1]); o.y = pk2(bflo(qw[ks][1]) * rs * g0[2], bfhi(qw[ks][1]) * rs * g0[3]);
                o.z = pk2(bflo(qw[ks][2]) * rs * g1[0], bfhi(qw[ks][2]) * rs * g1[1]); o.w = pk2(bflo(qw[ks][3]) * rs * g1[2], bfhi(qw[ks][3]) * rs * g1[3]);
                bq[ks] = __builtin_bit_cast(bf16x8, o);
            }
        }
        f32x4 sc[9];
#pragma unroll
        for (int kt = 0; kt < 9; ++kt) { sc[kt] = (f32x4){0.f, 0.f, 0.f, 0.f};
#pragma unroll
            for (int ks = 0; ks < 2; ++ks) sc[kt] = MFMA16(kf[kt][ks], bq[ks], sc[kt]); }
#pragma unroll
        for (int r = 0; r < 4; ++r) { if (!(l15 < 4 * quad + r)) sc[0][r] = NEG; if (!(l15 >= 4 * quad + r)) sc[8][r] = NEG; }
        if (qb == 0) {
#pragma unroll
            for (int kt = 0; kt < 9; ++kt)
#pragma unroll
                for (int r = 0; r < 4; ++r) if (16 * w + 16 * kt + 4 * quad + r < 128) sc[kt][r] = NEG;
        }
        const float sink = F.sinks[qh];
        float m = sink;
#pragma unroll
        for (int kt = 0; kt < 9; ++kt)
#pragma unroll
            for (int r = 0; r < 4; ++r) m = fmaxf(m, sc[kt][r]);
        m = fmaxf(m, __shfl_xor(m, 16)); m = fmaxf(m, __shfl_xor(m, 32));
        float l = 0.f;
#pragma unroll
        for (int kt = 0; kt < 9; ++kt)
#pragma unroll
            for (int r = 0; r < 4; ++r) { const float p = __expf(sc[kt][r] - m); sc[kt][r] = p; l += p; }
        l += __shfl_xor(l, 16); l += __shfl_xor(l, 32);
        l += __expf(sink - m);
        const float il = __builtin_amdgcn_rcpf(l);
        bf16x8 pf[5];
#pragma unroll
        for (int kk = 0; kk < 4; ++kk) pf[kk] = pack8(sc[2 * kk], sc[2 * kk + 1]);
        pf[4] = pack8(sc[8], (f32x4){0.f, 0.f, 0.f, 0.f});
#pragma unroll
        for (int dt = 0; dt < 4; ++dt) {
            f32x4 o = (f32x4){0.f, 0.f, 0.f, 0.f};
            const LAS bf16* vrow = Vt + (16 * dt + l15) * VT2_STRIDE + 16 * w + 4 * quad;
#pragma unroll
            for (int kk = 0; kk < 5; ++kk) {
                const v2u lo = *(const LAS v2u*)(vrow + 32 * kk);
                v2u hi = (v2u){0u, 0u}; if (kk < 4) hi = *(const LAS v2u*)(vrow + 32 * kk + 16);
                o = MFMA16(join8(lo, hi), pf[kk], o);
            }
            v2u ow; ow.x = pk2(o[0] * il, o[1] * il); ow.y = pk2(o[2] * il, o[3] * il);
            *(v2u*)(F.MIXED + row * D + 512 + qh * 64 + 16 * dt + 4 * quad) = ow;
        }
    }
    __syncthreads();
}

constexpr int QD_STRIDE = 136, KT_STRIDE = 40;
#define QDOFF(t) ((t) * QD_STRIDE + ((t) >> 3) * 16)
#define VTOFF(v) ((v) * KT_STRIDE + ((v) >> 3) * 32)
constexpr int HB_QD = 0, HB_KH = 8832, HB_KDT = 17664, HB_VT = 27904, HB_DEC = 39104, HB_BYTES = 39616;
static_assert(31 * QD_STRIDE + 3 * 16 + 128 <= (HB_KH - HB_QD) / 2 && 127 * KT_STRIDE + 15 * 32 + 32 <= (HB_DEC - HB_VT) / 2 && 128 * KT_STRIDE * 2 <= HB_VT - HB_KDT && 2 * HB_BYTES <= 131072, "HGRN LDS map");
__device__ __forceinline__ void hgrn_local(Frame& F, int item) {
    const int b = item >> 5, h = (item >> 3) & 3, seg = item & 7;
    const int tid = F.tid, lane = F.lane, w = F.wave, quad = lane >> 4, l15 = lane & 15;
    const int c = tid >> 2, part = tid & 3;
    const int vt_t = tid & 31, vt_v8 = tid >> 5;
    const size_t row0 = (size_t)b * SEQ + seg * 256;
    const bf16* pq = F.PROJ + row0 * PW + C_Q + h * 128 + c;
    const bf16* pf = F.PROJ + row0 * PW + C_F + h * 128 + c;
    const bf16* pv = F.PROJ + row0 * PW + C_I + h * 128 + vt_v8 * 8;
    f32x4 S[8];
#pragma unroll
    for (int i = 0; i < 8; ++i) S[i] = (f32x4){0.f, 0.f, 0.f, 0.f};
    float Bprev = 0.f;
    bf16 rq[8], rf[8]; v4u rv;
#define HG_LOAD_RAW(ch) do { _Pragma("unroll") for (int j = 0; j < 8; ++j) { const size_t t_ = (size_t)((ch) * 32 + 8 * part + j); rq[j] = pq[t_ * PW]; rf[j] = pf[t_ * PW]; } \
        rv = *(const v4u*)(pv + (size_t)((ch) * 32 + vt_t) * PW); } while (0)
#define HG_ELEM(ch) do { \
        LAS unsigned char* bb_ = F.lds + ((ch) & 1) * HB_BYTES; \
        LAS bf16* QD_ = (LAS bf16*)(bb_ + HB_QD); LAS bf16* KH_ = (LAS bf16*)(bb_ + HB_KH); LAS bf16* KDT_ = (LAS bf16*)(bb_ + HB_KDT); LAS bf16* VT_ = (LAS bf16*)(bb_ + HB_VT); LAS float* DEC_ = (LAS float*)(bb_ + HB_DEC); \
        float lf_[8], bl_[8]; float run_ = 0.f; \
        _Pragma("unroll") for (int j = 0; j < 8; ++j) { lf_[j] = bf2f(rf[j]); run_ += lf_[j]; bl_[j] = run_; } \
        const int b4_ = lane & ~3; \
        const float t0_ = __shfl(run_, b4_), t1_ = __shfl(run_, b4_ + 1), t2_ = __shfl(run_, b4_ + 2), t3_ = __shfl(run_, b4_ + 3); \
        const float pre_ = (part > 0 ? t0_ : 0.f) + (part > 1 ? t1_ : 0.f) + (part > 2 ? t2_ : 0.f); \
        const float btot_ = (t0_ + t1_) + (t2_ + t3_); \
        const float eprev_ = __expf(Bprev); \
        float kd_[8]; const float ebtot_ = __expf(btot_); float eip_ = __builtin_amdgcn_rcpf(__expf(pre_)); \
        _Pragma("unroll") for (int j = 0; j < 8; ++j) { const int t_ = 8 * part + j; const float bt_ = pre_ + bl_[j]; \
            const float e_ = __expf(bt_), ei_ = __builtin_amdgcn_rcpf(e_); \
            const float k_ = 1.0f - e_ * eip_; eip_ = ei_; const float qd_ = bf2f(rq[j]) * e_; const float kh_ = k_ * ei_; \
            const unsigned pw_ = pg8::cvt_pk_native(qd_, kh_); \
            QD_[QDOFF(t_) + c] = (bf16)(pw_ & 0xffffu); KH_[QDOFF(t_) + c] = (bf16)(pw_ >> 16); kd_[j] = kh_ * ebtot_; \
            F.QDS[(row0 + (size_t)((ch) * 32 + t_)) * 512 + h * 128 + c] = (bf16)f2bf(qd_ * eprev_); } \
        { v4u o_; o_.x = pk2(kd_[0], kd_[1]); o_.y = pk2(kd_[2], kd_[3]); o_.z = pk2(kd_[4], kd_[5]); o_.w = pk2(kd_[6], kd_[7]); *(LAS v4u*)(KDT_ + c * KT_STRIDE + 8 * part) = o_; } \
        if (part == 0) DEC_[c] = ebtot_; \
        Bprev += btot_; \
        _Pragma("unroll") for (int i = 0; i < 4; ++i) { VT_[VTOFF(8 * vt_v8 + 2 * i) + vt_t] = (bf16)(rv[i] & 0xffffu); VT_[VTOFF(8 * vt_v8 + 2 * i + 1) + vt_t] = (bf16)(rv[i] >> 16); } \
    } while (0)

    HG_LOAD_RAW(0);
    HG_ELEM(0);
    HG_LOAD_RAW(1);
    LDS_BARRIER();
    for (int ch = 0; ch < 8; ++ch) {
        if (ch + 1 < 8) { HG_ELEM(ch + 1); if (ch + 2 < 8) HG_LOAD_RAW(ch + 2); }
        const LAS unsigned char* bb = F.lds + (ch & 1) * HB_BYTES;
        const LAS bf16* QD = (const LAS bf16*)(bb + HB_QD); const LAS bf16* KH = (const LAS bf16*)(bb + HB_KH); const LAS bf16* KDT = (const LAS bf16*)(bb + HB_KDT);
        const LAS bf16* VT = (const LAS bf16*)(bb + HB_VT); const LAS float* DEC = (const LAS float*)(bb + HB_DEC);
        f32x4 T00 = (f32x4){0.f, 0.f, 0.f, 0.f}, T01 = T00, T11 = T00;
#pragma unroll
        for (int kk = 0; kk < 4; ++kk) {
            const bf16x8 kh0 = *(const LAS bf16x8*)(KH + QDOFF(l15) + 32 * kk + 8 * quad), kh1 = *(const LAS bf16x8*)(KH + QDOFF(16 + l15) + 32 * kk + 8 * quad);
            const bf16x8 q0 = *(const LAS bf16x8*)(QD + QDOFF(l15) + 32 * kk + 8 * quad), q1 = *(const LAS bf16x8*)(QD + QDOFF(16 + l15) + 32 * kk + 8 * quad);
            T00 = MFMA16(kh0, q0, T00); T01 = MFMA16(kh0, q1, T01); T11 = MFMA16(kh1, q1, T11);
        }
#pragma unroll
        for (int r = 0; r < 4; ++r) { if (4 * quad + r > l15) { T00[r] = 0.f; T11[r] = 0.f; } }
        const bf16x8 a0 = pack8(T00, (f32x4){0.f, 0.f, 0.f, 0.f}), a1 = pack8(T01, T11);
        const LAS bf16* vrow = VT + VTOFF(16 * w + l15);
        const bf16x8 bv = join8(*(const LAS v2u*)(vrow + 4 * quad), *(const LAS v2u*)(vrow + 16 + 4 * quad));
        f32x4 O0 = (f32x4){0.f, 0.f, 0.f, 0.f}, O1 = O0;
#pragma unroll
        for (int kk = 0; kk < 4; ++kk) {
            const bf16x8 aq0 = join8(*(const LAS v2u*)(QD + QDOFF(l15) + 32 * kk + 4 * quad), *(const LAS v2u*)(QD + QDOFF(l15) + 32 * kk + 16 + 4 * quad));
            const bf16x8 aq1 = join8(*(const LAS v2u*)(QD + QDOFF(16 + l15) + 32 * kk + 4 * quad), *(const LAS v2u*)(QD + QDOFF(16 + l15) + 32 * kk + 16 + 4 * quad));
            const bf16x8 bs = pack8(S[2 * kk], S[2 * kk + 1]);
            O0 = MFMA16(aq0, bs, O0); O1 = MFMA16(aq1, bs, O1);
        }
        O0 = MFMA16(a0, bv, O0); O1 = MFMA16(a1, bv, O1);
        {
            float* op = F.OLOC + (row0 + (size_t)(ch * 32 + 4 * quad)) * 512 + h * 128 + 16 * w + l15;
#pragma unroll
            for (int r = 0; r < 4; ++r) { op[(size_t)r * 512] = O0[r]; op[(size_t)(16 + r) * 512] = O1[r]; }
        }
        const bf16x8 bvn = *(const LAS bf16x8*)(vrow + 8 * quad);
#pragma unroll
        for (int tc = 0; tc < 8; ++tc) {
            const f32x4 dec = *(const LAS f32x4*)(DEC + 16 * tc + 4 * quad);
            S[tc] = S[tc] * dec;
            const bf16x8 ak = *(const LAS bf16x8*)(KDT + (16 * tc + l15) * KT_STRIDE + 8 * quad);
            S[tc] = MFMA16(ak, bvn, S[tc]);
        }
        LDS_BARRIER();
    }
#undef HG_LOAD_RAW
#undef HG_ELEM
    {
        f32x4* Lp = (f32x4*)F.LBUF + (size_t)(item * 8 + w) * 8 * 64 + lane;
#pragma unroll
        for (int tc = 0; tc < 8; ++tc) {
            const f32x4 val = S[tc] + 0.0f;
            asm volatile("global_store_dwordx4 %0, %1, off sc0 sc1\n\ts_nop 1" :: "v"(Lp + tc * 64), "v"(val) : "memory");
        }
        if (part == 0) { const float val = __expf(Bprev); asm volatile("global_store_dword %0, %1, off sc0 sc1" :: "v"(F.DTOT + item * 128 + c), "v"(val) : "memory"); }
    }
}
__device__ __forceinline__ void hgrn_local_ws2(Frame& F, int item) {
    const int b = item >> 5, h = (item >> 3) & 3, seg = item & 7;
    const int tid = F.tid, lane = F.lane, w = F.wave, quad = lane >> 4, l15 = lane & 15;
    const int c = tid >> 2, part = tid & 3;
    const int vt_t = tid & 31, vt_v8 = tid >> 5;
    const size_t row0 = (size_t)b * SEQ + seg * 256;
    const bf16* pq = F.PROJ + row0 * PW + C_Q + h * 128 + c;
    const bf16* pf = F.PROJ + row0 * PW + C_F + h * 128 + c;
    const bf16* pv = F.PROJ + row0 * PW + C_I + h * 128 + vt_v8 * 8;
    f32x4 S[2][8];
#pragma unroll
    for (int g = 0; g < 2; ++g)
#pragma unroll
        for (int i = 0; i < 8; ++i) S[g][i] = (f32x4){0.f, 0.f, 0.f, 0.f};
    float Bprev = 0.f;
    bf16 rq[8], rf[8]; v4u rv;
#define HG_LOAD_RAW(ch) do { _Pragma("unroll") for (int j = 0; j < 8; ++j) { const size_t t_ = (size_t)((ch) * 32 + 8 * part + j); rq[j] = pq[t_ * PW]; rf[j] = pf[t_ * PW]; } \
        rv = *(const v4u*)(pv + (size_t)((ch) * 32 + vt_t) * PW); } while (0)
#define HG_ELEM(ch) do { \
        LAS unsigned char* bb_ = F.lds + ((ch) & 1) * HB_BYTES; \
        LAS bf16* QD_ = (LAS bf16*)(bb_ + HB_QD); LAS bf16* KH_ = (LAS bf16*)(bb_ + HB_KH); LAS bf16* KDT_ = (LAS bf16*)(bb_ + HB_KDT); LAS bf16* VT_ = (LAS bf16*)(bb_ + HB_VT); LAS float* DEC_ = (LAS float*)(bb_ + HB_DEC); \
        float lf_[8], bl_[8]; float run_ = 0.f; \
        _Pragma("unroll") for (int j = 0; j < 8; ++j) { lf_[j] = bf2f(rf[j]); run_ += lf_[j]; bl_[j] = run_; } \
        const int b4_ = lane & ~3; \
        const float t0_ = __shfl(run_, b4_), t1_ = __shfl(run_, b4_ + 1), t2_ = __shfl(run_, b4_ + 2), t3_ = __shfl(run_, b4_ + 3); \
        const float pre_ = (part > 0 ? t0_ : 0.f) + (part > 1 ? t1_ : 0.f) + (part > 2 ? t2_ : 0.f); \
        const float btot_ = (t0_ + t1_) + (t2_ + t3_); \
        const float eprev_ = __expf(Bprev); \
        float kd_[8]; const float ebtot_ = __expf(btot_); float eip_ = __builtin_amdgcn_rcpf(__expf(pre_)); \
        _Pragma("unroll") for (int j = 0; j < 8; ++j) { const int t_ = 8 * part + j; const float bt_ = pre_ + bl_[j]; \
            const float e_ = __expf(bt_), ei_ = __builtin_amdgcn_rcpf(e_); \
            const float k_ = 1.0f - e_ * eip_; eip_ = ei_; const float qd_ = bf2f(rq[j]) * e_; const float kh_ = k_ * ei_; \
            const unsigned pw_ = pg8::cvt_pk_native(qd_, kh_); \
            QD_[QDOFF(t_) + c] = (bf16)(pw_ & 0xffffu); KH_[QDOFF(t_) + c] = (bf16)(pw_ >> 16); kd_[j] = kh_ * ebtot_; \
            F.QDS[(row0 + (size_t)((ch) * 32 + t_)) * 512 + h * 128 + c] = (bf16)f2bf(qd_ * eprev_); } \
        { v4u o_; o_.x = pk2(kd_[0], kd_[1]); o_.y = pk2(kd_[2], kd_[3]); o_.z = pk2(kd_[4], kd_[5]); o_.w = pk2(kd_[6], kd_[7]); *(LAS v4u*)(KDT_ + c * KT_STRIDE + 8 * part) = o_; } \
        if (part == 0) DEC_[c] = ebtot_; \
        Bprev += btot_; \
        _Pragma("unroll") for (int i = 0; i < 4; ++i) { VT_[VTOFF(8 * vt_v8 + 2 * i) + vt_t] = (bf16)(rv[i] & 0xffffu); VT_[VTOFF(8 * vt_v8 + 2 * i + 1) + vt_t] = (bf16)(rv[i] >> 16); } \
    } while (0)

    HG_LOAD_RAW(0);
    HG_ELEM(0);
    HG_LOAD_RAW(1);
    LDS_BARRIER();
    for (int ch = 0; ch < 8; ++ch) {
        if (w >= 4) { if (ch + 1 < 8) { HG_ELEM(ch + 1); if (ch + 2 < 8) HG_LOAD_RAW(ch + 2); } }
        if (w < 4) {
            const LAS unsigned char* bb = F.lds + (ch & 1) * HB_BYTES;
            const LAS bf16* QD = (const LAS bf16*)(bb + HB_QD); const LAS bf16* KH = (const LAS bf16*)(bb + HB_KH); const LAS bf16* KDT = (const LAS bf16*)(bb + HB_KDT);
            const LAS bf16* VT = (const LAS bf16*)(bb + HB_VT); const LAS float* DEC = (const LAS float*)(bb + HB_DEC);
            f32x4 T00 = (f32x4){0.f, 0.f, 0.f, 0.f}, T01 = T00, T11 = T00;
#pragma unroll
            for (int kk = 0; kk < 4; ++kk) {
                const bf16x8 kh0 = *(const LAS bf16x8*)(KH + QDOFF(l15) + 32 * kk + 8 * quad), kh1 = *(const LAS bf16x8*)(KH + QDOFF(16 + l15) + 32 * kk + 8 * quad);
                const bf16x8 q0 = *(const LAS bf16x8*)(QD + QDOFF(l15) + 32 * kk + 8 * quad), q1 = *(const LAS bf16x8*)(QD + QDOFF(16 + l15) + 32 * kk + 8 * quad);
                T00 = MFMA16(kh0, q0, T00); T01 = MFMA16(kh0, q1, T01); T11 = MFMA16(kh1, q1, T11);
            }
#pragma unroll
            for (int r = 0; r < 4; ++r) { if (4 * quad + r > l15) { T00[r] = 0.f; T11[r] = 0.f; } }
            const bf16x8 a0 = pack8(T00, (f32x4){0.f, 0.f, 0.f, 0.f}), a1 = pack8(T01, T11);
            f32x4 O[2][2];
#pragma unroll
            for (int g = 0; g < 2; ++g) { O[g][0] = (f32x4){0.f, 0.f, 0.f, 0.f}; O[g][1] = O[g][0]; }
#pragma unroll
            for (int kk = 0; kk < 4; ++kk) {
                const bf16x8 aq0 = join8(*(const LAS v2u*)(QD + QDOFF(l15) + 32 * kk + 4 * quad), *(const LAS v2u*)(QD + QDOFF(l15) + 32 * kk + 16 + 4 * quad));
                const bf16x8 aq1 = join8(*(const LAS v2u*)(QD + QDOFF(16 + l15) + 32 * kk + 4 * quad), *(const LAS v2u*)(QD + QDOFF(16 + l15) + 32 * kk + 16 + 4 * quad));
#pragma unroll
                for (int g = 0; g < 2; ++g) { const bf16x8 bs = pack8(S[g][2 * kk], S[g][2 * kk + 1]); O[g][0] = MFMA16(aq0, bs, O[g][0]); O[g][1] = MFMA16(aq1, bs, O[g][1]); }
            }
#pragma unroll
            for (int g = 0; g < 2; ++g) {
                const LAS bf16* vrow = VT + VTOFF(32 * w + 16 * g + l15);
                const bf16x8 bv = join8(*(const LAS v2u*)(vrow + 4 * quad), *(const LAS v2u*)(vrow + 16 + 4 * quad));
                O[g][0] = MFMA16(a0, bv, O[g][0]); O[g][1] = MFMA16(a1, bv, O[g][1]);
                float* op = F.OLOC + (row0 + (size_t)(ch * 32 + 4 * quad)) * 512 + h * 128 + 32 * w + 16 * g + l15;
#pragma unroll
                for (int r = 0; r < 4; ++r) { op[(size_t)r * 512] = O[g][0][r]; op[(size_t)(16 + r) * 512] = O[g][1][r]; }
            }
            const bf16x8 bvn0 = *(const LAS bf16x8*)(VT + VTOFF(32 * w + l15) + 8 * quad), bvn1 = *(const LAS bf16x8*)(VT + VTOFF(32 * w + 16 + l15) + 8 * quad);
#pragma unroll
            for (int tc = 0; tc < 8; ++tc) {
                const f32x4 dec = *(const LAS f32x4*)(DEC + 16 * tc + 4 * quad);
                const bf16x8 ak = *(const LAS bf16x8*)(KDT + (16 * tc + l15) * KT_STRIDE + 8 * quad);
                S[0][tc] = S[0][tc] * dec; S[1][tc] = S[1][tc] * dec;
                S[0][tc] = MFMA16(ak, bvn0, S[0][tc]); S[1][tc] = MFMA16(ak, bvn1, S[1][tc]);
            }
            if (ch + 1 < 8) { HG_ELEM(ch + 1); if (ch + 2 < 8) HG_LOAD_RAW(ch + 2); }
        }
        LDS_BARRIER();
    }
#undef HG_LOAD_RAW
#undef HG_ELEM
    if (w < 4) {
#pragma unroll
        for (int g = 0; g < 2; ++g) {
            f32x4* Lp = (f32x4*)F.LBUF + (size_t)(item * 8 + 2 * w + g) * 8 * 64 + lane;
#pragma unroll
            for (int tc = 0; tc < 8; ++tc) {
                const f32x4 val = S[g][tc] + 0.0f;
                asm volatile("global_store_dwordx4 %0, %1, off sc0 sc1\n\ts_nop 1" :: "v"(Lp + tc * 64), "v"(val) : "memory");
            }
        }
    }
    if (part == 0) { const float val = __expf(Bprev); asm volatile("global_store_dword %0, %1, off sc0 sc1" :: "v"(F.DTOT + item * 128 + c), "v"(val) : "memory"); }
}
__device__ __forceinline__ void hgrn_publish(Frame& F, unsigned* cnt, int item) {
    asm volatile("s_waitcnt vmcnt(0)" ::: "memory");
    __syncthreads();
    if (F.tid == 0) __hip_atomic_fetch_add(cnt + 64 * (item >> 3), 1u, __ATOMIC_RELAXED, __HIP_MEMORY_SCOPE_AGENT);
}
__device__ __forceinline__ void hgrn_wait(Frame& F, unsigned* cnt, int item) {
    if (F.tid == 0) {
        unsigned sp = 0;
        while (__hip_atomic_load(cnt + 64 * (item >> 3), __ATOMIC_RELAXED, __HIP_MEMORY_SCOPE_AGENT) < 8u) { __builtin_amdgcn_s_sleep(2); if (++sp > (1u << 22)) break; }
        __builtin_amdgcn_fence(__ATOMIC_ACQUIRE, "agent");
        asm volatile("s_waitcnt vmcnt(0)" ::: "memory");
    }
    __syncthreads();
}

constexpr int ST_STRIDE = 136;
__device__ __forceinline__ void hgrn_correct(Frame& F, int item) {
    const int b = item >> 5, h = (item >> 3) & 3, seg = item & 7;
    const int lane = F.lane, w = F.wave, quad = lane >> 4, l15 = lane & 15;
    const size_t row0 = (size_t)b * SEQ + seg * 256;
    LAS bf16* ST = (LAS bf16*)F.lds;
    v4u qf[2][4];
    if (seg > 0) {
#pragma unroll
        for (int tt = 0; tt < 2; ++tt)
#pragma unroll
            for (int kk = 0; kk < 4; ++kk) qf[tt][kk] = *(const v4u*)(F.QDS + (row0 + 32 * w + 16 * tt + l15) * 512 + h * 128 + 32 * kk + 8 * quad);
    }
    if (seg > 0) {
        f32x4 S[8];
#pragma unroll
        for (int i = 0; i < 8; ++i) S[i] = (f32x4){0.f, 0.f, 0.f, 0.f};
        f32x4 Lc[8], Dc[8];
        {
            const int im = item - seg;
            const f32x4* Lp = (const f32x4*)F.LBUF + (size_t)(im * 8 + w) * 8 * 64 + lane; const float* Dp = F.DTOT + im * 128;
#pragma unroll
            for (int tc = 0; tc < 8; ++tc) { Dc[tc] = *(const f32x4*)(Dp + 16 * tc + 4 * quad); Lc[tc] = Lp[tc * 64]; }
        }
        for (int m = 0; m < seg; ++m) {
            f32x4 Ln[8], Dn[8];
            const int im = item - seg + (m + 1 < seg ? m + 1 : m);
            const f32x4* Lp = (const f32x4*)F.LBUF + (size_t)(im * 8 + w) * 8 * 64 + lane; const float* Dp = F.DTOT + im * 128;
#pragma unroll
            for (int tc = 0; tc < 8; ++tc) { Dn[tc] = *(const f32x4*)(Dp + 16 * tc + 4 * quad); Ln[tc] = Lp[tc * 64]; }
#pragma unroll
            for (int tc = 0; tc < 8; ++tc) { S[tc] = Dc[tc] * S[tc] + Lc[tc]; Lc[tc] = Ln[tc]; Dc[tc] = Dn[tc]; }
        }
#pragma unroll
        for (int tc = 0; tc < 8; ++tc) { v2u o; o.x = pg8::cvt_pk_native(S[tc][0], S[tc][1]); o.y = pg8::cvt_pk_native(S[tc][2], S[tc][3]);
            *(LAS v2u*)(ST + (16 * w + l15) * ST_STRIDE + 16 * tc + 4 * quad) = o; }
    }
    f32x4 OL[2][8]; v2u GW[2][8];
#pragma unroll
    for (int tt = 0; tt < 2; ++tt) {
        const size_t row = row0 + 32 * w + 16 * tt + l15;
#pragma unroll
        for (int vt = 0; vt < 8; ++vt) { OL[tt][vt] = *(const f32x4*)(F.OLOC + row * 512 + h * 128 + 4 * quad + 16 * vt); GW[tt][vt] = *(const v2u*)(F.PROJ + row * PW + C_G + h * 128 + 4 * quad + 16 * vt); }
    }
    __syncthreads();
    f32x4 O[8][2];
#pragma unroll
    for (int vt = 0; vt < 8; ++vt) { O[vt][0] = (f32x4){0.f, 0.f, 0.f, 0.f}; O[vt][1] = O[vt][0]; }
    if (seg > 0) {
#pragma unroll
        for (int vt = 0; vt < 8; ++vt)
#pragma unroll
            for (int kk = 0; kk < 4; ++kk) {
                const bf16x8 a = *(const LAS bf16x8*)(ST + (16 * vt + l15) * ST_STRIDE + 32 * kk + 8 * quad);
                O[vt][0] = MFMA16(a, __builtin_bit_cast(bf16x8, qf[0][kk]), O[vt][0]);
                O[vt][1] = MFMA16(a, __builtin_bit_cast(bf16x8, qf[1][kk]), O[vt][1]);
            }
    }
#pragma unroll
    for (int tt = 0; tt < 2; ++tt) {
        const size_t row = row0 + 32 * w + 16 * tt + l15;
        float ss = 0.f;
#pragma unroll
        for (int vt = 0; vt < 8; ++vt) { const f32x4 o = O[vt][tt] + OL[tt][vt]; O[vt][tt] = o; ss += (o[0] * o[0] + o[1] * o[1]) + (o[2] * o[2] + o[3] * o[3]); }
        ss += __shfl_xor(ss, 16); ss += __shfl_xor(ss, 32);
        const float rs = __builtin_amdgcn_rsqf(ss * (1.0f / 128.0f) + EPS);
        bf16* mp = F.MIXED + row * D + h * 128 + 4 * quad;
#pragma unroll
        for (int vt = 0; vt < 8; ++vt) {
            const v2u gw = GW[tt][vt];
            const f32x4 og = *(const f32x4*)(F.ogain + 16 * vt + 4 * quad);
            const f32x4 o = O[vt][tt];
            v2u ow; ow.x = pk2(o[0] * rs * og[0] * bflo(gw.x), o[1] * rs * og[1] * bfhi(gw.x)); ow.y = pk2(o[2] * rs * og[2] * bflo(gw.y), o[3] * rs * og[3] * bfhi(gw.y));
            *(v2u*)(mp + 16 * vt) = ow;
        }
    }
    __syncthreads();
}
__device__ __forceinline__ int mix_first_item(const Frame& F) { const int bx = blockIdx.x; return (F.G == 256) ? (bx & 7) * 32 + (bx >> 3) : bx; }
__device__ __forceinline__ void mix_phase_a(Frame& F, bool handoff, unsigned* cnt) {
#if !NAIVE_HGRN
    for (int it = mix_first_item(F); it < NB * HH * 8; it += F.G) {
#if HGRN_WS
        hgrn_local_ws2(F, it);
#else
        hgrn_local(F, it);
#endif
        if (handoff) hgrn_publish(F, cnt, it); }
    __syncthreads();
#else
    hgrn_naive(F); __syncthreads();
#endif
#if !NAIVE_ATTN
    for (int it = mix_first_item(F); it < NB * KVH * 16; it += F.G) attn_item(F, it);
#else
    attn_naive(F); __syncthreads();
#endif
}
__device__ __forceinline__ void mix_phase_b(Frame& F, bool handoff, unsigned* cnt) {
#if !NAIVE_HGRN
    for (int it = mix_first_item(F); it < NB * HH * 8; it += F.G) { if (handoff) hgrn_wait(F, cnt, it); hgrn_correct(F, it); }
#else
    hgrn_norm_naive(F);
#endif
}
#define MK_N_LAUNCHES 1
#define NAIVE_MIX 0

#ifndef MK_N_LAUNCHES
#define MK_N_LAUNCHES 1
#endif
#ifndef NAIVE_MIX
#define NAIVE_MIX 0
#endif
constexpr int N_PHASES = 7;
struct Args { const float* in[13]; float* out; unsigned char* ws; int ph_lo, ph_hi; };
template <bool COOP>
__global__ void __launch_bounds__(NWAVES * 64, 2) fwd(Args args) {
    extern __shared__ __attribute__((aligned(16))) unsigned char lds[];
    Frame F;
    F.lds = (LAS unsigned char*)lds;
    F.tid = threadIdx.x; F.lane = F.tid & 63; F.wave = __builtin_amdgcn_readfirstlane(F.tid >> 6); F.G = gridDim.x;
    unsigned char* ws = args.ws;
    F.x = args.in[0]; F.g1 = args.in[1]; F.w_in = args.in[2]; F.lbl = args.in[3]; F.ogain = args.in[4]; F.qg = args.in[5]; F.kg = args.in[6];
    F.sinks = args.in[7]; F.w_out = args.in[8]; F.g2 = args.in[9]; F.w_gate = args.in[10]; F.w_up = args.in[11]; F.w_down = args.in[12]; F.out = args.out;
    F.WIN = (bf16*)(ws + WS_WIN); F.WOUT = (bf16*)(ws + WS_WOUT); F.WGU = (bf16*)(ws + WS_WGU); F.WDN = (bf16*)(ws + WS_WDN);
    F.XB = (bf16*)(ws + WS_XB); F.PROJ = (bf16*)(ws + WS_PROJ); F.ACT = (bf16*)(ws + WS_ACT); F.MIXED = (bf16*)(ws + WS_MIXED); F.HB = (bf16*)(ws + WS_HB); F.QDS = (bf16*)(ws + WS_QDS);
    F.RSTD1 = (float*)(ws + WS_RSTD1); F.PART = (float*)(ws + WS_PART); F.DTOT = (float*)(ws + WS_DTOT); F.OLOC = (float*)(ws + WS_OLOC); F.LBUF = (float*)(ws + WS_LBUF);
    const int lo = args.ph_lo, hi = args.ph_hi;
#define IN(k) (lo <= (k) && (k) < hi)
#ifndef USE_CG_SYNC
#define USE_CG_SYNC 0
#endif
    XcdBarrier bar; bar.bar = (unsigned*)(ws + WS_CTL) + 4096; bar.x = 0; bar.st = nullptr;
    if constexpr (COOP) {
        for (int u = F.tid; u < (LDS_BYTES - 131072) / 4; u += NWAVES * 64) ((LAS unsigned*)(F.lds + 131072))[u] = 0u;
        __syncthreads();
        bar = xcd_barrier_post((unsigned*)(ws + WS_CTL) + 4096, (volatile LAS unsigned*)(F.lds + 131072 + 352));
    }
#define SEAM(k) do { if constexpr (COOP) { if (IN(k) && IN((k) + 1)) { if (USE_CG_SYNC) cg::this_grid().sync(); else xcd_barrier(bar); } } } while (0)

#ifndef PROBE_DUP
#define PROBE_DUP 0
#endif
#ifndef PROBE_SYNC
#define PROBE_SYNC 0
#endif
    const bool handoff23 = COOP && !NAIVE_MIX && !NAIVE_HGRN && (F.G == NB * HH * 8) && IN(2) && IN(3);
    unsigned* cnt23 = (unsigned*)(ws + WS_CTL) + 8192;
    if (IN(0)) { p0_prologue(F); if (PROBE_DUP & 1) { __syncthreads(); p0_prologue(F); } SEAM(0); if constexpr (COOP) { for (int i_ = 0; i_ < PROBE_SYNC; ++i_) xcd_barrier(bar); } }
    if (IN(1)) {
        pg8::Gemm g{F.XB, F.WIN, M, PW, D}; pg8::StaticOrder S; S.init(M, PW, F.G, (int)blockIdx.x);
        pg8::EpiProj E{F.PROJ, F.RSTD1, F.lbl};
        pg8::gemm_phase<pg8::EpiProj, pg8::StaticOrder, true, true>(F.lds, g, S, E);
        if (PROBE_DUP & 2) { __syncthreads(); pg8::gemm_phase<pg8::EpiProj, pg8::StaticOrder, true, true>(F.lds, g, S, E); }
        {
            const int nwg = (M / 256) * (PW / 256), rem = nwg % F.G;
            const int first_late = (rem == 0) ? 0 : rem;
            if ((int)blockIdx.x >= first_late) { __syncthreads(); p0_weights_late(F, first_late, 0); }
        }
        SEAM(1);
    }
    if (IN(2)) {
#if NAIVE_MIX
        attn_naive(F); hgrn_naive(F);
#else
        mix_phase_a(F, handoff23, cnt23);
#endif
        if (!handoff23) SEAM(2);
    }
    if (IN(3)) {
#if NAIVE_MIX
        hgrn_norm_naive(F);
#else
        mix_phase_b(F, handoff23, cnt23);
#endif

        SEAM(3);
    }
    if (IN(4)) {
        pg8::Gemm g{F.MIXED, F.WOUT, M, D, D}; pg8::StaticOrder S; S.init(M, D, F.G, (int)blockIdx.x);
        pg8::EpiOut E{F.XB, F.out, F.HB, F.PART};
        pg8::gemm_phase<pg8::EpiOut, pg8::StaticOrder, true, true>(F.lds, g, S, E);
        if (PROBE_DUP & 16) { __syncthreads(); pg8::gemm_phase<pg8::EpiOut, pg8::StaticOrder, true, true>(F.lds, g, S, E); }
        SEAM(4);
    }
    if (IN(5)) {
        pg8::Gemm g{F.HB, F.WGU, M, NGU, D}; pg8::StaticOrder S; S.init(M, NGU, F.G, (int)blockIdx.x);
        LAS float* rsc = (LAS float*)(F.lds + 131072 + 1024); const int rbase = (int)(blockIdx.x & 7) * 2048; const bool rs_cached = (F.G == 256);
        if (rs_cached) {
            for (int r = F.tid; r < 2048; r += NWAVES * 64) {
                const f32x4* pp = (const f32x4*)(F.PART + (size_t)(rbase + r) * 16);
                const f32x4 p0 = pp[0], p1 = pp[1], p2 = pp[2], p3 = pp[3];
                const float ssq = ((p0[0] + p0[1]) + (p0[2] + p0[3])) + ((p1[0] + p1[1]) + (p1[2] + p1[3])) + ((p2[0] + p2[1]) + (p2[2] + p2[3])) + ((p3[0] + p3[1]) + (p3[2] + p3[3]));
                rsc[r] = __builtin_amdgcn_rsqf(ssq * (1.0f / 1024.0f) + 1e-6f);
            }
            __syncthreads();
        }
        pg8::EpiGU E{F.ACT, F.PART, rs_cached ? (const LAS float*)rsc : (const LAS float*)nullptr, rbase};
        pg8::gemm_phase<pg8::EpiGU, pg8::StaticOrder, true, true>(F.lds, g, S, E);
        if (PROBE_DUP & 32) { __syncthreads(); pg8::gemm_phase<pg8::EpiGU, pg8::StaticOrder, true, true>(F.lds, g, S, E); }
        {
            const int nwg = (M / 256) * (NGU / 256), rem = nwg % F.G;
            const int first_late = (rem == 0) ? 0 : rem;
            if ((int)blockIdx.x >= first_late) { __syncthreads(); p0_weights_late(F, first_late, 1); }
        }
        SEAM(5);
    }
    if (IN(6)) {
        pg8::Gemm g{F.ACT, F.WDN, M, D, FF}; pg8::StaticOrder S; S.init(M, D, F.G, (int)blockIdx.x);
        pg8::EpiDown E{F.out, F.HB};
        pg8::gemm_phase<pg8::EpiDown, pg8::StaticOrder, true, true>(F.lds, g, S, E);
        if (PROBE_DUP & 256) { __syncthreads(); pg8::gemm_phase<pg8::EpiDown, pg8::StaticOrder, true, true>(F.lds, g, S, E); }
    }
#undef IN
#undef SEAM
}

extern "C" void kernel_launch(void* const* d_in, const int* in_sizes, int n_in, void* d_out, int out_size, void* d_ws, size_t ws_size, hipStream_t stream) {
    static int grid = 0;
    if (grid == 0) {
        if (n_in != 13 || in_sizes[0] != M * D || out_size != M * D || ws_size < WS_END) { fprintf(stderr, "kernel_launch: unexpected shapes (n_in %d, in0 %d, out %d, ws %zu)\n", n_in, n_in > 0 ? in_sizes[0] : -1, out_size, ws_size); grid = -1; return; }
        int dev = 0, cus = 0, per_cu = 0;
        if (hipGetDevice(&dev) != hipSuccess || hipDeviceGetAttribute(&cus, hipDeviceAttributeMultiprocessorCount, dev) != hipSuccess) { grid = -1; return; }
        (void)hipFuncSetAttribute((const void*)fwd<true>, hipFuncAttributeMaxDynamicSharedMemorySize, LDS_BYTES);
        (void)hipFuncSetAttribute((const void*)fwd<false>, hipFuncAttributeMaxDynamicSharedMemorySize, LDS_BYTES);
        if (hipOccupancyMaxActiveBlocksPerMultiprocessor(&per_cu, (const void*)fwd<true>, NWAVES * 64, LDS_BYTES) != hipSuccess || per_cu < 1) {
            fprintf(stderr, "kernel_launch: occupancy query reports %d blocks per CU\n", per_cu); per_cu = 1; }
        (void)hipGetLastError();
        grid = cus;
    }
    if (grid < 0) return;
    if (hipMemsetAsync((char*)d_ws + WS_CTL, 0, 65536, stream) != hipSuccess) { fprintf(stderr, "kernel_launch: memset of the barrier words failed\n"); return; }
    Args a{};
    for (int i = 0; i < 13; ++i) a.in[i] = (const float*)d_in[i];
    a.out = (float*)d_out; a.ws = (unsigned char*)d_ws;
#if MK_N_LAUNCHES == 1
    a.ph_lo = 0; a.ph_hi = N_PHASES;
    void* params[] = {&a};
    hipError_t e = hipLaunchCooperativeKernel((const void*)fwd<true>, dim3(grid), dim3(NWAVES * 64), params, LDS_BYTES, stream);
    if (e != hipSuccess) fprintf(stderr, "cooperative launch failed: %s (grid %d)\n", hipGetErrorString(e), grid);
#else
    for (int ph = 0; ph < N_PHASES; ++ph) {
        a.ph_lo = ph; a.ph_hi = ph + 1;
        hipLaunchKernelGGL(fwd<false>, dim3(grid), dim3(NWAVES * 64), LDS_BYTES, stream, a);
    }
#endif
}
```

```cpp
#include <hip/hip_runtime.h>
#include <hip/hip_cooperative_groups.h>
#include <cstdio>
#include <cstdint>
namespace cg = cooperative_groups;
namespace pg8 {
#define PG8_LAS __attribute__((address_space(3)))
typedef unsigned short bf16_t;
typedef short bf16x8 __attribute__((ext_vector_type(8)));
typedef float f32x4 __attribute__((ext_vector_type(4)));
typedef unsigned u32x4 __attribute__((ext_vector_type(4)));
constexpr int BM = 256, BK = 64, HALF = 128, HTB = HALF * BK * 2  , STAGE_BYTES = 8 * HTB, NXCD = 8, WGM = 8;

__host__ __device__ __forceinline__ int lds_byte(int r, int c) { const int st = (r >> 4) * 2 + (c >> 5), rr = r & 15, cc = c & 31, ob = rr * 64 + cc * 2; return st * 1024 + (ob ^ (((ob >> 9) & 1) << 5)); }
__host__ __device__ __forceinline__ void stage_rc(int b, int& R, int& C) { const int st = b / 1024, sb = b % 1024, swz = sb ^ (((sb >> 9) & 1) << 5); R = (st >> 1) * 16 + swz / 64; C = (st & 1) * 32 + (swz % 64) / 2; }
__host__ __device__ __forceinline__ int perm32(int rho) { const int n = rho >> 4, i = rho & 15; return 8 * (i >> 2) + 4 * n + (i & 3); }

struct Unit { int pm, pn; };
struct Gemm { const bf16_t* A; const bf16_t* Bt; int M, N, K; };

struct StaticOrder {
    int nM, nN, nwg, G, c;
    __host__ __device__ void init(int M, int N, int G_, int c_) { nM = M / BM; nN = N / BM; nwg = nM * nN; G = G_; c = c_; }
    __host__ __device__ bool next(int i, Unit& u) const {
        const long L = (long)i * G + c; if (L >= nwg) return false;
        int wgid = (int)L; { const int q = nwg / NXCD, r = nwg % NXCD, xcd = wgid % NXCD, off = wgid / NXCD; wgid = (xcd < r ? xcd * (q + 1) : r * (q + 1) + (xcd - r) * q) + off; }
        const int nig = WGM * nN, gid = wgid / nig, fm = gid * WGM, gsz = (nM - fm) < WGM ? (nM - fm) : WGM;
        u.pm = fm + ((wgid % nig) % gsz); u.pn = (wgid % nig) / gsz; return true;
    }
    __device__ __forceinline__ void a_ready(const Unit&) const {}
    __device__ __forceinline__ void done(const Unit&) const {}
};

typedef float f32x2 __attribute__((ext_vector_type(2)));
__device__ __forceinline__ unsigned cvt_pk_bf16(float lo, float hi) { unsigned r; asm volatile("v_cvt_pk_bf16_f32 %0, %1, %2" : "=v"(r) : "v"(lo), "v"(hi)); return r; }
typedef __bf16 nbf16x2 __attribute__((ext_vector_type(2)));
__device__ __forceinline__ unsigned cvt_pk_native(float lo, float hi) { f32x2 v = {lo, hi}; return __builtin_bit_cast(unsigned, __builtin_convertvector(v, nbf16x2)); }
typedef float f32x2 __attribute__((ext_vector_type(2)));
template <class Epi, class Sched, bool ALIGN_EPI = false, bool SP2 = false>
__device__ __forceinline__ void gemm_phase(PG8_LAS unsigned char* lds, const Gemm g, const Sched& S, const Epi& E) {
    const int tid = threadIdx.x, wid = __builtin_amdgcn_readfirstlane(tid >> 6), lane = tid & 63, wr = wid >> 2, wc = wid & 3, fr = lane & 15, fq = lane >> 4;
    const int K = g.K, nt = K / BK;
    unsigned voffA[2], voffB[2];
#pragma unroll
    for (int i = 0; i < 2; ++i) { int R, C; stage_rc(tid * 16 + i * 8192, R, C); const int Rb = Epi::PERM ? ((R & ~31) + perm32(R & 31)) : R;
        voffA[i] = (unsigned)(R * K + C) * 2u; voffB[i] = (unsigned)(Rb * K + C) * 2u; }
    const size_t kstep = (size_t)(BK * 2);
    const size_t hstep = (size_t)HALF * K * 2;
    const size_t tstep = 2 * hstep;
    const unsigned ldsw = (unsigned)wid * 1024u;
    const int aoff = lds_byte(wr * 64 + fr, fq * 8), boff = lds_byte(wc * 32 + fr, fq * 8);
#define PG8_SA(b, h) (((b) * 2 + (h)) * HTB)
#define PG8_SB(b, h) ((4 + (b) * 2 + (h)) * HTB)
#define PG8_STAGE(bufoff, gbase, voff) do { _Pragma("unroll") for (int _i = 0; _i < 2; ++_i) \
        __builtin_amdgcn_global_load_lds((const unsigned*)((const char*)(gbase) + (voff)[_i]), (PG8_LAS unsigned*)(lds + (bufoff) + ldsw + _i * 8192), 16, 0, 0); } while (0)
#define PG8_LDA(dst, b, h) do { _Pragma("unroll") for (int m = 0; m < 4; ++m) _Pragma("unroll") for (int k = 0; k < 2; ++k) dst[m][k] = *(const PG8_LAS bf16x8*)(lds + PG8_SA(b, h) + aoff + m * 2048 + k * 1024); } while (0)
#define PG8_LDB(dst, b, h) do { _Pragma("unroll") for (int n = 0; n < 2; ++n) _Pragma("unroll") for (int k = 0; k < 2; ++k) dst[n][k] = *(const PG8_LAS bf16x8*)(lds + PG8_SB(b, h) + boff + n * 2048 + k * 1024); } while (0)
#define PG8_MMA(ai, bj, At, Bt) do { __builtin_amdgcn_s_setprio(1); _Pragma("unroll") for (int m = 0; m < 4; ++m) _Pragma("unroll") for (int n = 0; n < 2; ++n) _Pragma("unroll") for (int k = 0; k < 2; ++k) \
        acc[ai][bj][m][n] = __builtin_amdgcn_mfma_f32_16x16x32_bf16(Bt[n][k], At[m][k], acc[ai][bj][m][n], 0, 0, 0); __builtin_amdgcn_s_setprio(0); } while (0)
#define PG8_WAIT_V(n) asm volatile("s_waitcnt vmcnt(" #n ")" ::: "memory")
#define PG8_WAIT_L(n) asm volatile("s_waitcnt lgkmcnt(" #n ")" ::: "memory")
#define PG8_BAR __builtin_amdgcn_s_barrier()
#define PG8_SCHED __builtin_amdgcn_sched_barrier(0)
    Unit cur, nxt; int ui = 0;
    if (!S.next(0, cur)) return;
    f32x4 acc[2][2][4][2];
#pragma unroll
    for (int a = 0; a < 2; ++a)
#pragma unroll
        for (int b = 0; b < 2; ++b)
#pragma unroll
            for (int m = 0; m < 4; ++m)
#pragma unroll
                for (int n = 0; n < 2; ++n) acc[a][b][m][n] = (f32x4){0.f, 0.f, 0.f, 0.f};
    bf16x8 At[4][2], B0[2][2], B1[2][2];
    const char* cA = (const char*)g.A + (size_t)cur.pm * tstep; const char* cB = (const char*)g.Bt + (size_t)cur.pn * tstep;
    S.a_ready(cur);
    if constexpr (SP2) {
        PG8_STAGE(PG8_SB(0, 0), cB, voffB); PG8_STAGE(PG8_SB(0, 1), cB + hstep, voffB); PG8_STAGE(PG8_SA(0, 0), cA, voffA); PG8_STAGE(PG8_SA(0, 1), cA + hstep, voffA);
        if (wr == 1) PG8_BAR;
        PG8_WAIT_V(2); PG8_BAR;
        PG8_STAGE(PG8_SB(1, 0), cB + kstep, voffB); PG8_STAGE(PG8_SA(1, 0), cA + kstep, voffA); PG8_STAGE(PG8_SB(1, 1), cB + hstep + kstep, voffB);
        PG8_WAIT_V(6); PG8_BAR;
    } else {
        PG8_STAGE(PG8_SB(0, 0), cB, voffB); PG8_STAGE(PG8_SA(0, 0), cA, voffA); PG8_STAGE(PG8_SB(0, 1), cB + hstep, voffB); PG8_STAGE(PG8_SA(0, 1), cA + hstep, voffA);
        if (wr == 1) PG8_BAR;
        PG8_WAIT_V(4); PG8_BAR;
        PG8_STAGE(PG8_SB(1, 0), cB + kstep, voffB); PG8_STAGE(PG8_SA(1, 0), cA + kstep, voffA); PG8_STAGE(PG8_SB(1, 1), cB + hstep + kstep, voffB);
        PG8_WAIT_V(6); PG8_BAR;
    }
    for (;;) {
        const bool has_next = S.next(ui + 1, nxt);
        const char* nA = has_next ? (const char*)g.A + (size_t)nxt.pm * tstep : cA; const char* nB = has_next ? (const char*)g.Bt + (size_t)nxt.pn * tstep : cB;
        for (int t = 0; t < nt; t += 2) {
            const bool last = (t == nt - 2);
            const char* a1 = cA + (size_t)(t + 1) * kstep;
            const char* a2 = last ? nA : cA + (size_t)(t + 2) * kstep; const char* b2 = last ? nB : cB + (size_t)(t + 2) * kstep;
            const char* a3 = a2 + kstep; const char* b3 = b2 + kstep;
            if (last && has_next) S.a_ready(nxt);
            if constexpr (SP2) {
            PG8_LDB(B0, 0, 0); PG8_LDB(B1, 0, 1); PG8_SCHED; PG8_LDA(At, 0, 0); PG8_STAGE(PG8_SA(1, 1), a1 + hstep, voffA);
            PG8_WAIT_V(8); PG8_WAIT_L(0); PG8_BAR; PG8_MMA(0, 0, At, B0); PG8_MMA(0, 1, At, B1); PG8_BAR; PG8_SCHED;
            PG8_LDA(At, 0, 1); PG8_STAGE(PG8_SB(0, 0), b2, voffB); PG8_STAGE(PG8_SB(0, 1), b2 + hstep, voffB); PG8_STAGE(PG8_SA(0, 0), a2, voffA);
            PG8_WAIT_V(8); PG8_WAIT_L(0); PG8_BAR; PG8_MMA(1, 0, At, B0); PG8_MMA(1, 1, At, B1); PG8_BAR; PG8_SCHED;
            PG8_LDB(B0, 1, 0); PG8_LDB(B1, 1, 1); PG8_SCHED; PG8_LDA(At, 1, 0); PG8_STAGE(PG8_SA(0, 1), a2 + hstep, voffA);
            PG8_WAIT_V(8); PG8_WAIT_L(0); PG8_BAR; PG8_MMA(0, 0, At, B0); PG8_MMA(0, 1, At, B1); PG8_BAR; PG8_SCHED;
            PG8_LDA(At, 1, 1); PG8_STAGE(PG8_SB(1, 0), b3, voffB); PG8_STAGE(PG8_SB(1, 1), b3 + hstep, voffB); PG8_STAGE(PG8_SA(1, 0), a3, voffA);
            PG8_WAIT_V(8); PG8_WAIT_L(0); PG8_BAR; PG8_MMA(1, 0, At, B0); PG8_MMA(1, 1, At, B1); PG8_BAR; PG8_SCHED;
            } else {
            PG8_LDB(B0, 0, 0); PG8_SCHED; PG8_LDA(At, 0, 0); PG8_STAGE(PG8_SA(1, 1), a1 + hstep, voffA);
            PG8_WAIT_L(8); PG8_BAR; PG8_WAIT_L(0); PG8_MMA(0, 0, At, B0); PG8_BAR; PG8_SCHED;
            PG8_LDB(B1, 0, 1); PG8_STAGE(PG8_SB(0, 0), b2, voffB);
            PG8_BAR; PG8_WAIT_L(0); PG8_MMA(0, 1, At, B1); PG8_BAR;
            PG8_LDA(At, 0, 1); PG8_STAGE(PG8_SA(0, 0), a2, voffA);
            PG8_BAR; PG8_WAIT_L(0); PG8_MMA(1, 0, At, B0); PG8_BAR; PG8_SCHED;
            PG8_STAGE(PG8_SB(0, 1), b2 + hstep, voffB);
            PG8_WAIT_V(6); PG8_BAR; PG8_MMA(1, 1, At, B1); PG8_BAR;
            PG8_LDB(B0, 1, 0); PG8_SCHED; PG8_LDA(At, 1, 0); PG8_STAGE(PG8_SA(0, 1), a2 + hstep, voffA);
            PG8_WAIT_L(8); PG8_BAR; PG8_WAIT_L(0); PG8_MMA(0, 0, At, B0); PG8_BAR; PG8_SCHED;
            PG8_LDB(B1, 1, 1); PG8_STAGE(PG8_SB(1, 0), b3, voffB);
            PG8_BAR; PG8_WAIT_L(0); PG8_MMA(0, 1, At, B1); PG8_BAR;
            PG8_LDA(At, 1, 1); PG8_STAGE(PG8_SA(1, 0), a3, voffA);
            PG8_BAR; PG8_WAIT_L(0); PG8_MMA(1, 0, At, B0); PG8_BAR; PG8_SCHED;
            PG8_STAGE(PG8_SB(1, 1), b3 + hstep, voffB);
            PG8_WAIT_V(6); PG8_BAR; PG8_MMA(1, 1, At, B1); PG8_BAR;
            }
        }
        if constexpr (ALIGN_EPI) { if (wr == 0) PG8_BAR; }
        if constexpr (!Epi::AFTER_DRAIN) { E(acc, cur, wr, wc, fr, fq); S.done(cur); }
        if (!has_next) break;
#pragma unroll
        for (int a = 0; a < 2; ++a)
#pragma unroll
            for (int b = 0; b < 2; ++b)
#pragma unroll
                for (int m = 0; m < 4; ++m)
#pragma unroll
                    for (int n = 0; n < 2; ++n) acc[a][b][m][n] = (f32x4){0.f, 0.f, 0.f, 0.f};
        cur = nxt; cA = nA; cB = nB; ++ui;
        if constexpr (ALIGN_EPI) { if (wr == 1) PG8_BAR; }
    }
    PG8_WAIT_V(0);
    if constexpr (!ALIGN_EPI) { if (wr == 0) PG8_BAR; }
    PG8_BAR;
    if constexpr (Epi::AFTER_DRAIN) { E.fused(acc, cur, wr, wc, fr, fq, lds, wid, lane); S.done(cur); }
#undef PG8_SA
#undef PG8_SB
#undef PG8_STAGE
#undef PG8_LDA
#undef PG8_LDB
#undef PG8_MMA
#undef PG8_WAIT_V
#undef PG8_WAIT_L
#undef PG8_BAR
#undef PG8_SCHED
}
}

#define GAS __attribute__((address_space(1)))
#define LAS __attribute__((address_space(3)))
typedef unsigned short bf16;
typedef unsigned v4u __attribute__((ext_vector_type(4)));
typedef unsigned v2u __attribute__((ext_vector_type(2)));
typedef float f32x4 __attribute__((ext_vector_type(4)));
typedef short bf16x8 __attribute__((ext_vector_type(8)));
typedef short bf16x4 __attribute__((ext_vector_type(4)));

constexpr int NWAVES = 8;
constexpr int NB = 8, SEQ = 2048, D = 1024, M = NB * SEQ;
constexpr int PW = 2816, FF = 2816, NGU = 2 * FF;
constexpr int HH = 4, DK = 128, DV = 128, HW = 512;
constexpr int AH = 8, KVH = 2, AG = 4, HD = 64;
constexpr int C_Q = 0, C_F = 512, C_I = 1024, C_G = 1536, C_AQ = 2048, C_AK = 2560, C_AV = 2688;
constexpr float EPS = 1e-6f;

constexpr size_t MiB = 1u << 20;
constexpr size_t WS_CTL = 0;
constexpr size_t WS_WIN = 2 * MiB, WS_WOUT = 8 * MiB, WS_WGU = 10 * MiB, WS_WDN = 21 * MiB;
constexpr size_t WS_RSTD1 = 27 * MiB, WS_PART = 28 * MiB, WS_DTOT = 29 * MiB;
constexpr size_t WS_XB = 32 * MiB;
constexpr size_t WS_OLOC = 184 * MiB;
constexpr size_t WS_PROJ = 64 * MiB;
constexpr size_t WS_ACT = 64 * MiB;
constexpr size_t WS_MIXED = 152 * MiB;
constexpr size_t WS_HB = 184 * MiB;
constexpr size_t WS_LBUF = 216 * MiB;
constexpr size_t WS_QDS = 232 * MiB;
constexpr size_t WS_END = 256 * MiB;

constexpr int LDS_BYTES = 147456;

#define LDS_WAIT() asm volatile("s_waitcnt lgkmcnt(0)" ::: "memory")
#define VM_WAIT() asm volatile("s_waitcnt vmcnt(0)" ::: "memory")
__device__ __forceinline__ unsigned f2bf(float f) { unsigned u = __builtin_bit_cast(unsigned, f); return (u + 0x7fffu + ((u >> 16) & 1u)) >> 16; }
__device__ __forceinline__ unsigned pk2(float lo, float hi) { return f2bf(lo) | (f2bf(hi) << 16); }
__device__ __forceinline__ float bf2f(unsigned short b) { return __builtin_bit_cast(float, (unsigned)b << 16); }
__device__ __forceinline__ float bflo(unsigned w) { return __builtin_bit_cast(float, w << 16); }
__device__ __forceinline__ float bfhi(unsigned w) { return __builtin_bit_cast(float, w & 0xffff0000u); }
__device__ __forceinline__ float wave_sum(float v) {
#pragma unroll
    for (int o = 1; o < 64; o <<= 1) v += __shfl_xor(v, o);
    return v;
}
__device__ __forceinline__ float silu_f(float v) { return v / (1.0f + __expf(-v)); }

struct Frame {
    LAS unsigned char* lds;
    int tid, lane, wave, G;
    const float *x, *g1, *w_in, *lbl, *ogain, *qg, *kg, *sinks, *w_out, *g2, *w_gate, *w_up, *w_down;
    float* out;
    bf16 *WIN, *WOUT, *WGU, *WDN, *XB, *PROJ, *ACT, *MIXED, *HB, *QDS;
    float *RSTD1, *PART, *DTOT, *OLOC, *LBUF;
};

namespace pg8 {
struct EpiProj {
    static constexpr bool PERM = true, AFTER_DRAIN = false;
    bf16_t* O; const float* rstd; const float* lbl; const LAS float* rsc; int rbase;
    __device__ __forceinline__ void operator()(const f32x4 (&acc)[2][2][4][2], const Unit& u, int wr, int wc, int fr, int fq) const {
        const int row0 = u.pm * BM + wr * 64 + fr;
#pragma unroll
        for (int bj = 0; bj < 2; ++bj) {
            const int col0 = u.pn * BM + bj * HALF + wc * 32 + 8 * fq;
            const int seg = __builtin_amdgcn_readfirstlane(col0 >> 9);
            float lb[8];
#pragma unroll
            for (int i = 0; i < 8; ++i) lb[i] = 0.f;
            if (seg == 1) {
                const int ci = col0 & 511;
#pragma unroll
                for (int i = 0; i < 8; ++i) { const float l0 = lbl[ci + i], l1 = lbl[512 + ci + i]; lb[i] = __builtin_amdgcn_rcpf(1.0f + __expf(l1 - l0)); }
            }
#pragma unroll
            for (int ai = 0; ai < 2; ++ai)
#pragma unroll
                for (int m = 0; m < 4; ++m) {
                    const int row = row0 + ai * HALF + m * 16; const float rs = rsc ? rsc[row - rbase] : rstd[row];
                    float v[8];
#pragma unroll
                    for (int i = 0; i < 4; ++i) { v[i] = acc[ai][bj][m][0][i] * rs; v[4 + i] = acc[ai][bj][m][1][i] * rs; }
                    if (seg == 0) {
#pragma unroll
                        for (int i = 0; i < 8; ++i) v[i] = v[i] * __builtin_amdgcn_rcpf(1.0f + __expf(-v[i])) * 0.08838834764831845f;
                    } else if (seg == 1) {
#pragma unroll
                        for (int i = 0; i < 8; ++i) { const float s = __builtin_amdgcn_rcpf(1.0f + __expf(-v[i])); v[i] = __logf(lb[i] + (1.0f - lb[i]) * s); }
                    } else if (seg == 3) {
#pragma unroll
                        for (int i = 0; i < 8; ++i) v[i] = v[i] * __builtin_amdgcn_rcpf(1.0f + __expf(-v[i]));
                    }
                    u32x4 w; w.x = cvt_pk_bf16(v[0], v[1]); w.y = cvt_pk_bf16(v[2], v[3]); w.z = cvt_pk_bf16(v[4], v[5]); w.w = cvt_pk_bf16(v[6], v[7]);
                    *(u32x4*)(O + (size_t)row * 2816 + col0) = w;
                }
        }
    }
};
struct EpiOut {
    static constexpr bool PERM = true, AFTER_DRAIN = false;
    const bf16_t* x; float* out; bf16_t* hb; float* part;
    __device__ __forceinline__ void operator()(const f32x4 (&acc)[2][2][4][2], const Unit& u, int wr, int wc, int fr, int fq) const {
        const int row0 = u.pm * BM + wr * 64 + fr;
#pragma unroll
        for (int ai = 0; ai < 2; ++ai)
#pragma unroll
            for (int m = 0; m < 4; ++m) {
                const int row = row0 + ai * HALF + m * 16; float ss = 0.f;
#pragma unroll
                for (int bj = 0; bj < 2; ++bj) {
                    const size_t off = (size_t)row * 1024 + u.pn * BM + bj * HALF + wc * 32 + 8 * fq;
                    const u32x4 xw = *(const u32x4*)(x + off);
                    f32x4 x0, x1;
                    x0[0] = __builtin_bit_cast(float, xw.x << 16); x0[1] = __builtin_bit_cast(float, xw.x & 0xffff0000u); x0[2] = __builtin_bit_cast(float, xw.y << 16); x0[3] = __builtin_bit_cast(float, xw.y & 0xffff0000u);
                    x1[0] = __builtin_bit_cast(float, xw.z << 16); x1[1] = __builtin_bit_cast(float, xw.z & 0xffff0000u); x1[2] = __builtin_bit_cast(float, xw.w << 16); x1[3] = __builtin_bit_cast(float, xw.w & 0xffff0000u);
                    const f32x4 h0 = x0 + acc[ai][bj][m][0], h1 = x1 + acc[ai][bj][m][1];
                    u32x4 w; w.x = cvt_pk_bf16(h0[0], h0[1]); w.y = cvt_pk_bf16(h0[2], h0[3]); w.z = cvt_pk_bf16(h1[0], h1[1]); w.w = cvt_pk_bf16(h1[2], h1[3]);
                    *(u32x4*)(hb + off) = w;
                    ss += ((h0[0] * h0[0] + h0[1] * h0[1]) + (h0[2] * h0[2] + h0[3] * h0[3])) + ((h1[0] * h1[0] + h1[1] * h1[1]) + (h1[2] * h1[2] + h1[3] * h1[3]));
                }
                ss += __shfl_xor(ss, 16); ss += __shfl_xor(ss, 32);
                if (fq == 0) part[(size_t)row * 16 + u.pn * 4 + wc] = ss;
            }
    }
};
struct EpiGU {
    static constexpr bool PERM = true, AFTER_DRAIN = false;
    bf16_t* O; const float* part; const LAS float* rsc; int rbase;
    __device__ __forceinline__ void operator()(const f32x4 (&acc)[2][2][4][2], const Unit& u, int wr, int wc, int fr, int fq) const {
        const int row0 = u.pm * BM + wr * 64 + fr;
#pragma unroll
        for (int ai = 0; ai < 2; ++ai)
#pragma unroll
            for (int m = 0; m < 4; ++m) {
                const int row = row0 + ai * HALF + m * 16;
                float rs;
                if (rsc) rs = rsc[row - rbase];
                else {
                    const f32x4* pp = (const f32x4*)(part + (size_t)row * 16);
                    const f32x4 p0 = pp[0], p1 = pp[1], p2 = pp[2], p3 = pp[3];
                    const float ssq = ((p0[0] + p0[1]) + (p0[2] + p0[3])) + ((p1[0] + p1[1]) + (p1[2] + p1[3])) + ((p2[0] + p2[1]) + (p2[2] + p2[3])) + ((p3[0] + p3[1]) + (p3[2] + p3[3]));
                    rs = __builtin_amdgcn_rsqf(ssq * (1.0f / 1024.0f) + 1e-6f);
                }
                float v[8];
#pragma unroll
                for (int n = 0; n < 2; ++n)
#pragma unroll
                    for (int i = 0; i < 4; ++i) { const float g = acc[ai][0][m][n][i] * rs, up = acc[ai][1][m][n][i] * rs; v[4 * n + i] = g * __builtin_amdgcn_rcpf(1.0f + __expf(-g)) * up; }
                u32x4 w; w.x = cvt_pk_bf16(v[0], v[1]); w.y = cvt_pk_bf16(v[2], v[3]); w.z = cvt_pk_bf16(v[4], v[5]); w.w = cvt_pk_bf16(v[6], v[7]);
                *(u32x4*)(O + (size_t)row * 2816 + u.pn * HALF + wc * 32 + 8 * fq) = w;
            }
    }
};
struct EpiDown {
    static constexpr bool PERM = true, AFTER_DRAIN = false;
    float* out; const bf16_t* hb;
    __device__ __forceinline__ void operator()(const f32x4 (&acc)[2][2][4][2], const Unit& u, int wr, int wc, int fr, int fq) const {
        const int row0 = u.pm * BM + wr * 64 + fr;
#pragma unroll
        for (int ai = 0; ai < 2; ++ai)
#pragma unroll
            for (int m = 0; m < 4; ++m) {
                const int row = row0 + ai * HALF + m * 16;
#pragma unroll
                for (int bj = 0; bj < 2; ++bj) {
                    const size_t off = (size_t)row * 1024 + u.pn * BM + bj * HALF + wc * 32 + 8 * fq;
                    const u32x4 hw = *(const u32x4*)(hb + off);
                    f32x4 h0, h1;
                    h0[0] = __builtin_bit_cast(float, hw.x << 16); h0[1] = __builtin_bit_cast(float, hw.x & 0xffff0000u); h0[2] = __builtin_bit_cast(float, hw.y << 16); h0[3] = __builtin_bit_cast(float, hw.y & 0xffff0000u);
                    h1[0] = __builtin_bit_cast(float, hw.z << 16); h1[1] = __builtin_bit_cast(float, hw.z & 0xffff0000u); h1[2] = __builtin_bit_cast(float, hw.w << 16); h1[3] = __builtin_bit_cast(float, hw.w & 0xffff0000u);
                    __builtin_nontemporal_store(h0 + acc[ai][bj][m][0], (f32x4*)(out + off));
                    __builtin_nontemporal_store(h1 + acc[ai][bj][m][1], (f32x4*)(out + off + 4));
                }
            }
    }
};
}

__device__ __forceinline__ void p0_transpose_item(const float* W, int K, int N, bf16* WT, const float* gain, int mode, LAS float* scr, int item, int lane) {
    const int nblk = N / 32, kb = item / nblk, nb = item % nblk, k0 = 64 * kb, n0 = 32 * nb;
#pragma unroll 8
    for (int i = 0; i < 32; ++i) { const int kk = 2 * i + (lane >> 5); scr[kk * 33 + (lane & 31)] = __builtin_nontemporal_load(W + (size_t)(k0 + kk) * N + n0 + (lane & 31)); }
    LDS_WAIT(); asm volatile("" ::: "memory");
    const int c = lane & 7;
    float g[8];
#pragma unroll
    for (int i = 0; i < 8; ++i) g[i] = gain ? gain[k0 + 8 * c + i] : 1.0f;
    const int rbase = (mode == 0) ? n0 : (256 * (n0 >> 7) + (n0 & 127) + (mode == 2 ? 128 : 0));
#pragma unroll
    for (int j = 0; j < 4; ++j) { const int n = (lane >> 3) + 8 * j; const LAS float* s = scr + (8 * c) * 33 + n;
        v4u o; o.x = pk2(s[0 * 33] * g[0], s[1 * 33] * g[1]); o.y = pk2(s[2 * 33] * g[2], s[3 * 33] * g[3]); o.z = pk2(s[4 * 33] * g[4], s[5 * 33] * g[5]); o.w = pk2(s[6 * 33] * g[6], s[7 * 33] * g[7]);
        *(GAS v4u*)(WT + (size_t)(rbase + n) * K + k0 + 8 * c) = o; }
    LDS_WAIT(); asm volatile("" ::: "memory");
}
__device__ __forceinline__ void p0_weights_late(Frame& F, int first_block, int which) {
    int wv = threadIdx.x >> 6, ln = threadIdx.x & 63;
    asm volatile("" : "+v"(wv), "+v"(ln));
    wv = __builtin_amdgcn_readfirstlane(wv);
    LAS float* scr = (LAS float*)(F.lds + wv * 16384);
    const int gw = (blockIdx.x - first_block) * NWAVES + wv, NGW = (F.G - first_block) * NWAVES;
    constexpr int I_OUT = (D / 64) * (D / 32), I_G = (D / 64) * (FF / 32), I_DN = (FF / 64) * (D / 32);
    if (which == 0) {
        for (int it = gw; it < I_OUT + 2 * I_G; it += NGW) {
            int r = it;
            if (r < I_OUT) { p0_transpose_item(F.w_out, D, D, F.WOUT, nullptr, 0, scr, r, ln); continue; } r -= I_OUT;
            if (r < I_G) { p0_transpose_item(F.w_gate, D, FF, F.WGU, F.g2, 1, scr, r, ln); continue; } r -= I_G;
            p0_transpose_item(F.w_up, D, FF, F.WGU, F.g2, 2, scr, r, ln);
        }
    } else {
        for (int it = gw; it < I_DN; it += NGW) p0_transpose_item(F.w_down, FF, D, F.WDN, nullptr, 0, scr, it, ln);
    }
}
__device__ __forceinline__ void p0_prologue(Frame& F) {
    LAS float* scr = (LAS float*)(F.lds + F.wave * 16384);
    const int gw = blockIdx.x * NWAVES + F.wave, NGW = F.G * NWAVES;
    constexpr int I_IN = (D / 64) * (PW / 32);
    for (int it = gw; it < I_IN; it += NGW) p0_transpose_item(F.w_in, D, PW, F.WIN, F.g1, 0, scr, it, F.lane);
    for (int m = gw; m < M; m += NGW) {
        const GAS f32x4* xr = (const GAS f32x4*)(F.x + (size_t)m * D) + F.lane;
        f32x4 v[4]; float s = 0.f;
#pragma unroll
        for (int j = 0; j < 4; ++j) { v[j] = __builtin_nontemporal_load(xr + 64 * j); s += (v[j].x * v[j].x + v[j].y * v[j].y) + (v[j].z * v[j].z + v[j].w * v[j].w); }
        s = wave_sum(s);
        if (F.lane == 0) F.RSTD1[m] = 1.0f / sqrtf(s * (1.0f / D) + EPS);
        GAS unsigned long long* o8 = (GAS unsigned long long*)(F.XB + (size_t)m * D) + F.lane;
#pragma unroll
        for (int j = 0; j < 4; ++j) o8[64 * j] = (unsigned long long)pk2(v[j].x, v[j].y) | ((unsigned long long)pk2(v[j].z, v[j].w) << 32);
    }
}

#define XB_TMO      128
#define XB_XCNT(j)  (256  + 64 * (j))
#define XB_XSUB(j)  (1280 + 64 * (j))
#define XB_XGEN(j)  (2304 + 64 * (j))
#define XB_TOP      3328
#define XB_TOPGEN   3392
#define XCD_BAR_WORDS 3456
#define XB_SPIN_CAP (1u << 18)

__device__ __forceinline__ unsigned xb_ld(unsigned* p)              { return __hip_atomic_load(p, __ATOMIC_RELAXED, __HIP_MEMORY_SCOPE_AGENT); }
__device__ __forceinline__ unsigned xb_add(unsigned* p, unsigned v) { return __hip_atomic_fetch_add(p, v, __ATOMIC_RELAXED, __HIP_MEMORY_SCOPE_AGENT); }
__device__ __forceinline__ unsigned xb_xcc_id() { return (unsigned)__builtin_amdgcn_s_getreg((3 << 11) | 20) & 0xFu; }
#define XB_SPIN(cond, bar) do { unsigned _sp = 0; while (cond) { __builtin_amdgcn_s_sleep(1); \
    if ((++_sp & 255u) == 0u) { if (xb_ld(&(bar)[XB_TMO])) break; if (_sp > XB_SPIN_CAP) { atomicAdd(&(bar)[XB_TMO], 1u); break; } } } } while (0)

struct XcdBarrier {
    unsigned* bar; unsigned x;
    volatile LAS unsigned* st;
};

__device__ __forceinline__ XcdBarrier xcd_barrier_post(unsigned* bar, volatile LAS unsigned* st) {
    XcdBarrier b; b.bar = bar; b.x = xb_xcc_id(); b.st = st;
    if (threadIdx.x == 0) (void)xb_add(&bar[XB_XCNT(b.x)], 1u);
    return b;
}
__device__ __forceinline__ void xcd_barrier_complete(unsigned* bar, unsigned x, unsigned& nloc, unsigned& nx) {
    const unsigned G = gridDim.x * gridDim.y * gridDim.z;
    unsigned sum, cnt, mine, sp = 0u;
    for (;;) {
        sum = 0u; cnt = 0u; mine = 0u;
#pragma unroll
        for (unsigned j = 0; j < 16; ++j) { const unsigned c = xb_ld(&bar[XB_XCNT(j)]); sum += c; cnt += (c > 0u) ? 1u : 0u; mine = (j == x) ? c : mine; }
        if (sum == G) break;
        __builtin_amdgcn_s_sleep(1);
        if ((++sp & 255u) == 0u) { if (xb_ld(&bar[XB_TMO])) break; if (sp > XB_SPIN_CAP) { atomicAdd(&bar[XB_TMO], 1u); break; } }
    }
    nloc = mine > 0u ? mine : 1u; nx = cnt > 0u ? cnt : 1u;
}

__device__ __forceinline__ void xcd_barrier(const XcdBarrier& b) {
    asm volatile("s_waitcnt vmcnt(0)" ::: "memory");
    __syncthreads();
    if (threadIdx.x == 0) {
        unsigned* bar = b.bar;
        __builtin_amdgcn_s_waitcnt(0);
        unsigned nloc = b.st[0], nx = b.st[1];
        if (nloc == 0u) { xcd_barrier_complete(bar, b.x, nloc, nx); b.st[0] = nloc; b.st[1] = nx; }
        const unsigned old = xb_add(&bar[XB_XSUB(b.x)], 1u);
        const unsigned gen = old / nloc;
        if (old + 1u == (gen + 1u) * nloc) {
            __builtin_amdgcn_fence(__ATOMIC_RELEASE, "agent");
            asm volatile("s_waitcnt vmcnt(0)" ::: "memory");
            const unsigned og = xb_add(&bar[XB_TOP], 1u);
            const unsigned tg = og / nx;
            if (og + 1u == (tg + 1u) * nx) xb_add(&bar[XB_TOPGEN], 1u);
            else XB_SPIN(xb_ld(&bar[XB_TOPGEN]) == tg, bar);
            __builtin_amdgcn_fence(__ATOMIC_ACQUIRE, "agent");
            xb_add(&bar[XB_XGEN(b.x)], 1u);
            asm volatile("s_waitcnt vmcnt(0)" ::: "memory");
        } else {
            XB_SPIN(xb_ld(&bar[XB_XGEN(b.x)]) == gen, bar);
            __builtin_amdgcn_fence(__ATOMIC_ACQUIRE, "agent");
            asm volatile("s_waitcnt vmcnt(0)" ::: "memory");
        }
    }
    __syncthreads();
}
#define NAIVE_ATTN 0
#define NAIVE_HGRN 0

__device__ __forceinline__ void hgrn_naive(Frame& F) {
    if (blockIdx.x >= 64 || F.wave != 0) return;
    const int item = blockIdx.x; const int b = item >> 3, h = (item >> 1) & 3, v = (item & 1) * 64 + F.lane;
    float S[128];
#pragma unroll
    for (int c = 0; c < 128; ++c) S[c] = 0.f;
    for (int t = 0; t < SEQ; ++t) {
        const size_t row = (size_t)b * SEQ + t; const bf16* pr = F.PROJ + row * PW;
        const float vv = bf2f(pr[C_I + h * 128 + v]);
        float o = 0.f;
#pragma unroll
        for (int c8 = 0; c8 < 16; ++c8) {
            const v4u qw = *(const v4u*)(pr + C_Q + h * 128 + c8 * 8); const v4u fw = *(const v4u*)(pr + C_F + h * 128 + c8 * 8);
#pragma unroll
            for (int i = 0; i < 4; ++i) {
                const float q0 = bflo(qw[i]), q1 = bfhi(qw[i]); const float f0 = __expf(bflo(fw[i])), f1 = __expf(bfhi(fw[i]));
                S[c8 * 8 + 2 * i] = f0 * S[c8 * 8 + 2 * i] + (1.0f - f0) * vv; o += q0 * S[c8 * 8 + 2 * i];
                S[c8 * 8 + 2 * i + 1] = f1 * S[c8 * 8 + 2 * i + 1] + (1.0f - f1) * vv; o += q1 * S[c8 * 8 + 2 * i + 1];
            }
        }
        F.OLOC[row * 512 + h * 128 + v] = o;
    }
}
__device__ __forceinline__ void attn_naive(Frame& F) {
    for (int id = blockIdx.x * 512 + F.tid; id < NB * AH * SEQ; id += F.G * 512) {
        const int t = id & 2047, qh = (id >> 11) & 7, b = id >> 14, kvh = qh >> 2;
        const size_t row = (size_t)b * SEQ + t;
        float q[64]; float ss = 0.f;
        { const bf16* qr = F.PROJ + row * PW + C_AQ + qh * 64;
#pragma unroll
          for (int d8 = 0; d8 < 8; ++d8) { const v4u w = *(const v4u*)(qr + d8 * 8);
#pragma unroll
              for (int i = 0; i < 4; ++i) { q[d8 * 8 + 2 * i] = bflo(w[i]); q[d8 * 8 + 2 * i + 1] = bfhi(w[i]); } }
#pragma unroll
          for (int d = 0; d < 64; ++d) ss += q[d] * q[d];
          const float rs = 1.0f / sqrtf(ss * (1.0f / 64.0f) + EPS);
#pragma unroll
          for (int d = 0; d < 64; ++d) q[d] = q[d] * rs * F.qg[d] * 0.125f * F.kg[d]; }
        float m = F.sinks[qh], l = 1.0f; float acc[64];
#pragma unroll
        for (int d = 0; d < 64; ++d) acc[d] = 0.f;
        const int k0 = t - 127 < 0 ? 0 : t - 127;
        for (int kp = k0; kp <= t; ++kp) {
            const bf16* kr = F.PROJ + ((size_t)b * SEQ + kp) * PW + C_AK + kvh * 64;
            float kss = 0.f, dot = 0.f;
#pragma unroll
            for (int d8 = 0; d8 < 8; ++d8) { const v4u w = *(const v4u*)(kr + d8 * 8);
#pragma unroll
                for (int i = 0; i < 4; ++i) { const float a = bflo(w[i]), c = bfhi(w[i]); kss += a * a + c * c; dot += q[d8 * 8 + 2 * i] * a + q[d8 * 8 + 2 * i + 1] * c; } }
            const float s = dot / sqrtf(kss * (1.0f / 64.0f) + EPS);
            const float mn = fmaxf(m, s), sc = __expf(m - mn), p = __expf(s - mn);
            l = l * sc + p; m = mn;
            const bf16* vr = F.PROJ + ((size_t)b * SEQ + kp) * PW + C_AV + kvh * 64;
#pragma unroll
            for (int d8 = 0; d8 < 8; ++d8) { const v4u w = *(const v4u*)(vr + d8 * 8);
#pragma unroll
                for (int i = 0; i < 4; ++i) { acc[d8 * 8 + 2 * i] = acc[d8 * 8 + 2 * i] * sc + p * bflo(w[i]); acc[d8 * 8 + 2 * i + 1] = acc[d8 * 8 + 2 * i + 1] * sc + p * bfhi(w[i]); } }
        }
        const float il = 1.0f / l;
        bf16* orow = F.MIXED + row * D + 512 + qh * 64;
#pragma unroll
        for (int d8 = 0; d8 < 8; ++d8) { v4u w;
#pragma unroll
            for (int i = 0; i < 4; ++i) w[i] = pk2(acc[d8 * 8 + 2 * i] * il, acc[d8 * 8 + 2 * i + 1] * il);
            *(v4u*)(orow + d8 * 8) = w; }
    }
}
__device__ __forceinline__ void hgrn_norm_naive(Frame& F) {
    const int gw = blockIdx.x * NWAVES + F.wave, NGW = F.G * NWAVES;
    for (int it = gw; it < M * 4; it += NGW) {
        const int row = it >> 2, h = it & 3;
        const float* o = F.OLOC + (size_t)row * 512 + h * 128;
        const float a = o[F.lane], c = o[64 + F.lane];
        const float ss = wave_sum(a * a + c * c); const float rs = 1.0f / sqrtf(ss * (1.0f / 128.0f) + EPS);
        const bf16* gr = F.PROJ + (size_t)row * PW + C_G + h * 128;
        bf16* mr = F.MIXED + (size_t)row * D + h * 128;
        mr[F.lane] = (bf16)f2bf(a * rs * F.ogain[F.lane] * bf2f(gr[F.lane]));
        mr[64 + F.lane] = (bf16)f2bf(c * rs * F.ogain[64 + F.lane] * bf2f(gr[64 + F.lane]));
    }
}

#ifndef PROBE_DUP
#define PROBE_DUP 0
#endif
#ifndef HGRN_WS
#define HGRN_WS 1
#endif
__device__ __forceinline__ bf16x8 pack8(const f32x4 a, const f32x4 b) {
    v4u w; w.x = pg8::cvt_pk_native(a[0], a[1]); w.y = pg8::cvt_pk_native(a[2], a[3]); w.z = pg8::cvt_pk_native(b[0], b[1]); w.w = pg8::cvt_pk_native(b[2], b[3]);
    return __builtin_bit_cast(bf16x8, w);
}
__device__ __forceinline__ bf16x8 join8(const v2u lo, const v2u hi) { v4u w; w.x = lo.x; w.y = lo.y; w.z = hi.x; w.w = hi.y; return __builtin_bit_cast(bf16x8, w); }
#define MFMA16(a, b, c) __builtin_amdgcn_mfma_f32_16x16x32_bf16((a), (b), (c), 0, 0, 0)
#define LDS_BARRIER() do { asm volatile("s_waitcnt lgkmcnt(0)" ::: "memory"); __builtin_amdgcn_s_barrier(); asm volatile("" ::: "memory"); } while (0)

constexpr int KS_STRIDE = 72, VT2_STRIDE = 264;
constexpr int AT_KS = 0, AT_VT = 256 * KS_STRIDE * 2;
__device__ __forceinline__ void attn_item(Frame& F, int item) {
    const int b = item >> 5, kvh = (item >> 4) & 1, qb = item & 15, p0 = qb * 128;
    const int tid = F.tid, lane = F.lane, w = F.wave, quad = lane >> 4, l15 = lane & 15;
    LAS bf16* Ks = (LAS bf16*)(F.lds + AT_KS); LAS bf16* Vt = (LAS bf16*)(F.lds + AT_VT);
    const size_t row = (size_t)b * SEQ + p0 + 16 * w + l15;
    {
        const int key = tid >> 1, half = tid & 1, pos = p0 - 128 + key;
        v4u kw[4], vw[4];
        if (pos >= 0) {
            const v4u* kr = (const v4u*)(F.PROJ + ((size_t)b * SEQ + pos) * PW + C_AK + kvh * 64 + half * 32);
            const v4u* vr = (const v4u*)(F.PROJ + ((size_t)b * SEQ + pos) * PW + C_AV + kvh * 64 + half * 32);
#pragma unroll
            for (int i = 0; i < 4; ++i) { kw[i] = kr[i]; vw[i] = vr[i]; }
        } else {
#pragma unroll
            for (int i = 0; i < 4; ++i) { kw[i] = (v4u){0u, 0u, 0u, 0u}; vw[i] = (v4u){0u, 0u, 0u, 0u}; }
        }
        float ss = 0.f;
#pragma unroll
        for (int i = 0; i < 4; ++i)
#pragma unroll
            for (int j = 0; j < 4; ++j) { const float a = bflo(kw[i][j]), c = bfhi(kw[i][j]); ss += a * a + c * c; }
        ss += __shfl_xor(ss, 1);
        const float rs = __builtin_amdgcn_rsqf(ss * (1.0f / 64.0f) + EPS);
#pragma unroll
        for (int i = 0; i < 4; ++i) {
            const f32x4 g0 = *(const f32x4*)(F.kg + half * 32 + 8 * i), g1 = *(const f32x4*)(F.kg + half * 32 + 8 * i + 4);
            v4u o;
            o.x = pk2(bflo(kw[i][0]) * rs * g0[0], bfhi(kw[i][0]) * rs * g0[1]); o.y = pk2(bflo(kw[i][1]) * rs * g0[2], bfhi(kw[i][1]) * rs * g0[3]);
            o.z = pk2(bflo(kw[i][2]) * rs * g1[0], bfhi(kw[i][2]) * rs * g1[1]); o.w = pk2(bflo(kw[i][3]) * rs * g1[2], bfhi(kw[i][3]) * rs * g1[3]);
            *(LAS v4u*)(Ks + key * KS_STRIDE + half * 32 + 8 * i) = o;
#pragma unroll
            for (int j = 0; j < 4; ++j) {
                Vt[(half * 32 + 8 * i + 2 * j) * VT2_STRIDE + key] = (bf16)(vw[i][j] & 0xffffu);
                Vt[(half * 32 + 8 * i + 2 * j + 1) * VT2_STRIDE + key] = (bf16)(vw[i][j] >> 16);
            }
        }
    }
    __syncthreads();
    bf16x8 kf[9][2];
#pragma unroll
    for (int kt = 0; kt < 9; ++kt)
#pragma unroll
        for (int ks = 0; ks < 2; ++ks) kf[kt][ks] = *(const LAS bf16x8*)(Ks + (16 * w + 16 * kt + l15) * KS_STRIDE + 32 * ks + 8 * quad);
    const float NEG = -1e30f;
    for (int g = 0; g < AG; ++g) {
        const int qh = kvh * AG + g;
        bf16x8 bq[2];
        {
            v4u qw[2]; float ss = 0.f;
#pragma unroll
            for (int ks = 0; ks < 2; ++ks) { qw[ks] = *(const v4u*)(F.PROJ + row * PW + C_AQ + qh * 64 + 32 * ks + 8 * quad);
#pragma unroll
                for (int j = 0; j < 4; ++j) { const float a = bflo(qw[ks][j]), c = bfhi(qw[ks][j]); ss += a * a + c * c; } }
            ss += __shfl_xor(ss, 16); ss += __shfl_xor(ss, 32);
            const float rs = 0.125f * __builtin_amdgcn_rsqf(ss * (1.0f / 64.0f) + EPS);
#pragma unroll
            for (int ks = 0; ks < 2; ++ks) {
                const f32x4 g0 = *(const f32x4*)(F.qg + 32 * ks + 8 * quad), g1 = *(const f32x4*)(F.qg + 32 * ks + 8 * quad + 4);
                v4u o;
                o.x = pk2(bflo(qw[ks][0]) * rs * g0[0], bfhi(qw[ks][0]) * rs * g0[1]); o.y = pk2(bflo(qw[ks][1]) * rs * g0[2], bfhi(qw[ks][1]) * rs * g0[3]);
                o.z = pk2(bflo(qw[ks][2]) * rs * g1[0], bfhi(qw[ks][2]) * rs * g1[1]); o.w = pk2(bflo(qw[ks][3]) * rs * g1[2], bfhi(qw[ks][3]) * rs * g1[3]);
                bq[ks] = __builtin_bit_cast(bf16x8, o);
            }
        }
        f32x4 sc[9];
#pragma unroll
        for (int kt = 0; kt < 9; ++kt) { sc[kt] = (f32x4){0.f, 0.f, 0.f, 0.f};
#pragma unroll
            for (int ks = 0; ks < 2; ++ks) sc[kt] = MFMA16(kf[kt][ks], bq[ks], sc[kt]); }
#pragma unroll
        for (int r = 0; r < 4; ++r) { if (!(l15 < 4 * quad + r)) sc[0][r] = NEG; if (!(l15 >= 4 * quad + r)) sc[8][r] = NEG; }
        if (qb == 0) {
#pragma unroll
            for (int kt = 0; kt < 9; ++kt)
#pragma unroll
                for (int r = 0; r < 4; ++r) if (16 * w + 16 * kt + 4 * quad + r < 128) sc[kt][r] = NEG;
        }
        const float sink = F.sinks[qh];
        float m = sink;
#pragma unroll
        for (int kt = 0; kt < 9; ++kt)
#pragma unroll
            for (int r = 0; r < 4; ++r) m = fmaxf(m, sc[kt][r]);
        m = fmaxf(m, __shfl_xor(m, 16)); m = fmaxf(m, __shfl_xor(m, 32));
        float l = 0.f;
#pragma unroll
        for (int kt = 0; kt < 9; ++kt)
#pragma unroll
            for (int r = 0; r < 4; ++r) { const float p = __expf(sc[kt][r] - m); sc[kt][r] = p; l += p; }
        l += __shfl_xor(l, 16); l += __shfl_xor(l, 32);
        l += __expf(sink - m);
        const float il = __builtin_amdgcn_rcpf(l);
        bf16x8 pf[5];
#pragma unroll
        for (int kk = 0; kk < 4; ++kk) pf[kk] = pack8(sc[2 * kk], sc[2 * kk + 1]);
        pf[4] = pack8(sc[8], (f32x4){0.f, 0.f, 0.f, 0.f});
#pragma unroll
        for (int dt = 0; dt < 4; ++dt) {
            f32x4 o = (f32x4){0.f, 0.f, 0.f, 0.f};
            const LAS bf16* vrow = Vt + (16 * dt + l15) * VT2_STRIDE + 16 * w + 4 * quad;
#pragma unroll
            for (int kk = 0; kk < 5; ++kk) {
                const v2u lo = *(const LAS v2u*)(vrow + 32 * kk);
                v2u hi = (v2u){0u, 0u}; if (kk < 4) hi = *(const LAS v2u*)(vrow + 32 * kk + 16);
                o = MFMA16(join8(lo, hi), pf[kk], o);
            }
            v2u ow; ow.x = pk2(o[0] * il, o[1] * il); ow.y = pk2(o[2] * il, o[3] * il);
            *(v2u*)(F.MIXED + row * D + 512 + qh * 64 + 16 * dt + 4 * quad) = ow;
        }
    }
    __syncthreads();
}

constexpr int QD_STRIDE = 136, KT_STRIDE = 40;
#define QDOFF(t) ((t) * QD_STRIDE + ((t) >> 3) * 16)
#define VTOFF(v) ((v) * KT_STRIDE + ((v) >> 3) * 32)
constexpr int HB_QD = 0, HB_KH = 8832, HB_KDT = 17664, HB_VT = 27904, HB_DEC = 39104, HB_BYTES = 39616;
static_assert(31 * QD_STRIDE + 3 * 16 + 128 <= (HB_KH - HB_QD) / 2 && 127 * KT_STRIDE + 15 * 32 + 32 <= (HB_DEC - HB_VT) / 2 && 128 * KT_STRIDE * 2 <= HB_VT - HB_KDT && 2 * HB_BYTES <= 131072, "HGRN LDS map");
__device__ __forceinline__ void hgrn_local(Frame& F, int item) {
    const int b = item >> 5, h = (item >> 3) & 3, seg = item & 7;
    const int tid = F.tid, lane = F.lane, w = F.wave, quad = lane >> 4, l15 = lane & 15;
    const int c = tid >> 2, part = tid & 3;
    const int vt_t = tid & 31, vt_v8 = tid >> 5;
    const size_t row0 = (size_t)b * SEQ + seg * 256;
    const bf16* pq = F.PROJ + row0 * PW + C_Q + h * 128 + c;
    const bf16* pf = F.PROJ + row0 * PW + C_F + h * 128 + c;
    const bf16* pv = F.PROJ + row0 * PW + C_I + h * 128 + vt_v8 * 8;
    f32x4 S[8];
#pragma unroll
    for (int i = 0; i < 8; ++i) S[i] = (f32x4){0.f, 0.f, 0.f, 0.f};
    float Bprev = 0.f;
    bf16 rq[8], rf[8]; v4u rv;
#define HG_LOAD_RAW(ch) do { _Pragma("unroll") for (int j = 0; j < 8; ++j) { const size_t t_ = (size_t)((ch) * 32 + 8 * part + j); rq[j] = pq[t_ * PW]; rf[j] = pf[t_ * PW]; } \
        rv = *(const v4u*)(pv + (size_t)((ch) * 32 + vt_t) * PW); } while (0)
#define HG_ELEM(ch) do { \
        LAS unsigned char* bb_ = F.lds + ((ch) & 1) * HB_BYTES; \
        LAS bf16* QD_ = (LAS bf16*)(bb_ + HB_QD); LAS bf16* KH_ = (LAS bf16*)(bb_ + HB_KH); LAS bf16* KDT_ = (LAS bf16*)(bb_ + HB_KDT); LAS bf16* VT_ = (LAS bf16*)(bb_ + HB_VT); LAS float* DEC_ = (LAS float*)(bb_ + HB_DEC); \
        float lf_[8], bl_[8]; float run_ = 0.f; \
        _Pragma("unroll") for (int j = 0; j < 8; ++j) { lf_[j] = bf2f(rf[j]); run_ += lf_[j]; bl_[j] = run_; } \
        const int b4_ = lane & ~3; \
        const float t0_ = __shfl(run_, b4_), t1_ = __shfl(run_, b4_ + 1), t2_ = __shfl(run_, b4_ + 2), t3_ = __shfl(run_, b4_ + 3); \
        const float pre_ = (part > 0 ? t0_ : 0.f) + (part > 1 ? t1_ : 0.f) + (part > 2 ? t2_ : 0.f); \
        const float btot_ = (t0_ + t1_) + (t2_ + t3_); \
        const float eprev_ = __expf(Bprev); \
        float kd_[8]; const float ebtot_ = __expf(btot_); float eip_ = __builtin_amdgcn_rcpf(__expf(pre_)); \
        _Pragma("unroll") for (int j = 0; j < 8; ++j) { const int t_ = 8 * part + j; const float bt_ = pre_ + bl_[j]; \
            const float e_ = __expf(bt_), ei_ = __builtin_amdgcn_rcpf(e_); \
            const float k_ = 1.0f - e_ * eip_; eip_ = ei_; const float qd_ = bf2f(rq[j]) * e_; const float kh_ = k_ * ei_; \
            const unsigned pw_ = pg8::cvt_pk_native(qd_, kh_); \
            QD_[QDOFF(t_) + c] = (bf16)(pw_ & 0xffffu); KH_[QDOFF(t_) + c] = (bf16)(pw_ >> 16); kd_[j] = kh_ * ebtot_; \
            F.QDS[(row0 + (size_t)((ch) * 32 + t_)) * 512 + h * 128 + c] = (bf16)f2bf(qd_ * eprev_); } \
        { v4u o_; o_.x = pk2(kd_[0], kd_[1]); o_.y = pk2(kd_[2], kd_[3]); o_.z = pk2(kd_[4], kd_[5]); o_.w = pk2(kd_[6], kd_[7]); *(LAS v4u*)(KDT_ + c * KT_STRIDE + 8 * part) = o_; } \
        if (part == 0) DEC_[c] = ebtot_; \
        Bprev += btot_; \
        _Pragma("unroll") for (int i = 0; i < 4; ++i) { VT_[VTOFF(8 * vt_v8 + 2 * i) + vt_t] = (bf16)(rv[i] & 0xffffu); VT_[VTOFF(8 * vt_v8 + 2 * i + 1) + vt_t] = (bf16)(rv[i] >> 16); } \
    } while (0)

    HG_LOAD_RAW(0);
    HG_ELEM(0);
    HG_LOAD_RAW(1);
    LDS_BARRIER();
    for (int ch = 0; ch < 8; ++ch) {
        if (ch + 1 < 8) { HG_ELEM(ch + 1); if (ch + 2 < 8) HG_LOAD_RAW(ch + 2); }
        const LAS unsigned char* bb = F.lds + (ch & 1) * HB_BYTES;
        const LAS bf16* QD = (const LAS bf16*)(bb + HB_QD); const LAS bf16* KH = (const LAS bf16*)(bb + HB_KH); const LAS bf16* KDT = (const LAS bf16*)(bb + HB_KDT);
        const LAS bf16* VT = (const LAS bf16*)(bb + HB_VT); const LAS float* DEC = (const LAS float*)(bb + HB_DEC);
        f32x4 T00 = (f32x4){0.f, 0.f, 0.f, 0.f}, T01 = T00, T11 = T00;
#pragma unroll
        for (int kk = 0; kk < 4; ++kk) {
            const bf16x8 kh0 = *(const LAS bf16x8*)(KH + QDOFF(l15) + 32 * kk + 8 * quad), kh1 = *(const LAS bf16x8*)(KH + QDOFF(16 + l15) + 32 * kk + 8 * quad);
            const bf16x8 q0 = *(const LAS bf16x8*)(QD + QDOFF(l15) + 32 * kk + 8 * quad), q1 = *(const LAS bf16x8*)(QD + QDOFF(16 + l15) + 32 * kk + 8 * quad);
            T00 = MFMA16(kh0, q0, T00); T01 = MFMA16(kh0, q1, T01); T11 = MFMA16(kh1, q1, T11);
        }
#pragma unroll
        for (int r = 0; r < 4; ++r) { if (4 * quad + r > l15) { T00[r] = 0.f; T11[r] = 0.f; } }
        const bf16x8 a0 = pack8(T00, (f32x4){0.f, 0.f, 0.f, 0.f}), a1 = pack8(T01, T11);
        const LAS bf16* vrow = VT + VTOFF(16 * w + l15);
        const bf16x8 bv = join8(*(const LAS v2u*)(vrow + 4 * quad), *(const LAS v2u*)(vrow + 16 + 4 * quad));
        f32x4 O0 = (f32x4){0.f, 0.f, 0.f, 0.f}, O1 = O0;
#pragma unroll
        for (int kk = 0; kk < 4; ++kk) {
            const bf16x8 aq0 = join8(*(const LAS v2u*)(QD + QDOFF(l15) + 32 * kk + 4 * quad), *(const LAS v2u*)(QD + QDOFF(l15) + 32 * kk + 16 + 4 * quad));
            const bf16x8 aq1 = join8(*(const LAS v2u*)(QD + QDOFF(16 + l15) + 32 * kk + 4 * quad), *(const LAS v2u*)(QD + QDOFF(16 + l15) + 32 * kk + 16 + 4 * quad));
            const bf16x8 bs = pack8(S[2 * kk], S[2 * kk + 1]);
            O0 = MFMA16(aq0, bs, O0); O1 = MFMA16(aq1, bs, O1);
        }
        O0 = MFMA16(a0, bv, O0); O1 = MFMA16(a1, bv, O1);
        {
            float* op = F.OLOC + (row0 + (size_t)(ch * 32 + 4 * quad)) * 512 + h * 128 + 16 * w + l15;
#pragma unroll
            for (int r = 0; r < 4; ++r) { op[(size_t)r * 512] = O0[r]; op[(size_t)(16 + r) * 512] = O1[r]; }
        }
        const bf16x8 bvn = *(const LAS bf16x8*)(vrow + 8 * quad);
#pragma unroll
        for (int tc = 0; tc < 8; ++tc) {
            const f32x4 dec = *(const LAS f32x4*)(DEC + 16 * tc + 4 * quad);
            S[tc] = S[tc] * dec;
            const bf16x8 ak = *(const LAS bf16x8*)(KDT + (16 * tc + l15) * KT_STRIDE + 8 * quad);
            S[tc] = MFMA16(ak, bvn, S[tc]);
        }
        LDS_BARRIER();
    }
#undef HG_LOAD_RAW
#undef HG_ELEM
    {
        f32x4* Lp = (f32x4*)F.LBUF + (size_t)(item * 8 + w) * 8 * 64 + lane;
#pragma unroll
        for (int tc = 0; tc < 8; ++tc) {
            const f32x4 val = S[tc] + 0.0f;
            asm volatile("global_store_dwordx4 %0, %1, off sc0 sc1\n\ts_nop 1" :: "v"(Lp + tc * 64), "v"(val) : "memory");
        }
        if (part == 0) { const float val = __expf(Bprev); asm volatile("global_store_dword %0, %1, off sc0 sc1" :: "v"(F.DTOT + item * 128 + c), "v"(val) : "memory"); }
    }
}
__device__ __forceinline__ void hgrn_local_ws2(Frame& F, int item) {
    const int b = item >> 5, h = (item >> 3) & 3, seg = item & 7;
    const int tid = F.tid, lane = F.lane, w = F.wave, quad = lane >> 4, l15 = lane & 15;
    const int c = tid >> 2, part = tid & 3;
    const int vt_t = tid & 31, vt_v8 = tid >> 5;
    const size_t row0 = (size_t)b * SEQ + seg * 256;
    const bf16* pq = F.PROJ + row0 * PW + C_Q + h * 128 + c;
    const bf16* pf = F.PROJ + row0 * PW + C_F + h * 128 + c;
    const bf16* pv = F.PROJ + row0 * PW + C_I + h * 128 + vt_v8 * 8;
    f32x4 S[2][8];
#pragma unroll
    for (int g = 0; g < 2; ++g)
#pragma unroll
        for (int i = 0; i < 8; ++i) S[g][i] = (f32x4){0.f, 0.f, 0.f, 0.f};
    float Bprev = 0.f;
    bf16 rq[8], rf[8]; v4u rv;
#define HG_LOAD_RAW(ch) do { _Pragma("unroll") for (int j = 0; j < 8; ++j) { const size_t t_ = (size_t)((ch) * 32 + 8 * part + j); rq[j] = pq[t_ * PW]; rf[j] = pf[t_ * PW]; } \
        rv = *(const v4u*)(pv + (size_t)((ch) * 32 + vt_t) * PW); } while (0)
#define HG_ELEM(ch) do { \
        LAS unsigned char* bb_ = F.lds + ((ch) & 1) * HB_BYTES; \
        LAS bf16* QD_ = (LAS bf16*)(bb_ + HB_QD); LAS bf16* KH_ = (LAS bf16*)(bb_ + HB_KH); LAS bf16* KDT_ = (LAS bf16*)(bb_ + HB_KDT); LAS bf16* VT_ = (LAS bf16*)(bb_ + HB_VT); LAS float* DEC_ = (LAS float*)(bb_ + HB_DEC); \
        float lf_[8], bl_[8]; float run_ = 0.f; \
        _Pragma("unroll") for (int j = 0; j < 8; ++j) { lf_[j] = bf2f(rf[j]); run_ += lf_[j]; bl_[j] = run_; } \
        const int b4_ = lane & ~3; \
        const float t0_ = __shfl(run_, b4_), t1_ = __shfl(run_, b4_ + 1), t2_ = __shfl(run_, b4_ + 2), t3_ = __shfl(run_, b4_ + 3); \
        const float pre_ = (part > 0 ? t0_ : 0.f) + (part > 1 ? t1_ : 0.f) + (part > 2 ? t2_ : 0.f); \
        const float btot_ = (t0_ + t1_) + (t2_ + t3_); \
        const float eprev_ = __expf(Bprev); \
        float kd_[8]; const float ebtot_ = __expf(btot_); float eip_ = __builtin_amdgcn_rcpf(__expf(pre_)); \
        _Pragma("unroll") for (int j = 0; j < 8; ++j) { const int t_ = 8 * part + j; const float bt_ = pre_ + bl_[j]; \
            const float e_ = __expf(bt_), ei_ = __builtin_amdgcn_rcpf(e_); \
            const float k_ = 1.0f - e_ * eip_; eip_ = ei_; const float qd_ = bf2f(rq[j]) * e_; const float kh_ = k_ * ei_; \
            const unsigned pw_ = pg8::cvt_pk_native(qd_, kh_); \
            QD_[QDOFF(t_) + c] = (bf16)(pw_ & 0xffffu); KH_[QDOFF(t_) + c] = (bf16)(pw_ >> 16); kd_[j] = kh_ * ebtot_; \
            F.QDS[(row0 + (size_t)((ch) * 32 + t_)) * 512 + h * 128 + c] = (bf16)f2bf(qd_ * eprev_); } \
        { v4u o_; o_.x = pk2(kd_[0], kd_[1]); o_.y = pk2(kd_[2], kd_[3]); o_.z = pk2(kd_[4], kd_[5]); o_.w = pk2(kd_[6], kd_[7]); *(LAS v4u*)(KDT_ + c * KT_STRIDE + 8 * part) = o_; } \
        if (part == 0) DEC_[c] = ebtot_; \
        Bprev += btot_; \
        _Pragma("unroll") for (int i = 0; i < 4; ++i) { VT_[VTOFF(8 * vt_v8 + 2 * i) + vt_t] = (bf16)(rv[i] & 0xffffu); VT_[VTOFF(8 * vt_v8 + 2 * i + 1) + vt_t] = (bf16)(rv[i] >> 16); } \
    } while (0)

    HG_LOAD_RAW(0);
    HG_ELEM(0);
    HG_LOAD_RAW(1);
    LDS_BARRIER();
    for (int ch = 0; ch < 8; ++ch) {
        if (w >= 4) { if (ch + 1 < 8) { HG_ELEM(ch + 1); if (ch + 2 < 8) HG_LOAD_RAW(ch + 2); } }
        if (w < 4) {
            const LAS unsigned char* bb = F.lds + (ch & 1) * HB_BYTES;
            const LAS bf16* QD = (const LAS bf16*)(bb + HB_QD); const LAS bf16* KH = (const LAS bf16*)(bb + HB_KH); const LAS bf16* KDT = (const LAS bf16*)(bb + HB_KDT);
            const LAS bf16* VT = (const LAS bf16*)(bb + HB_VT); const LAS float* DEC = (const LAS float*)(bb + HB_DEC);
            f32x4 T00 = (f32x4){0.f, 0.f, 0.f, 0.f}, T01 = T00, T11 = T00;
#pragma unroll
            for (int kk = 0; kk < 4; ++kk) {
                const bf16x8 kh0 = *(const LAS bf16x8*)(KH + QDOFF(l15) + 32 * kk + 8 * quad), kh1 = *(const LAS bf16x8*)(KH + QDOFF(16 + l15) + 32 * kk + 8 * quad);
                const bf16x8 q0 = *(const LAS bf16x8*)(QD + QDOFF(l15) + 32 * kk + 8 * quad), q1 = *(const LAS bf16x8*)(QD + QDOFF(16 + l15) + 32 * kk + 8 * quad);
                T00 = MFMA16(kh0, q0, T00); T01 = MFMA16(kh0, q1, T01); T11 = MFMA16(kh1, q1, T11);
            }
#pragma unroll
            for (int r = 0; r < 4; ++r) { if (4 * quad + r > l15) { T00[r] = 0.f; T11[r] = 0.f; } }
            const bf16x8 a0 = pack8(T00, (f32x4){0.f, 0.f, 0.f, 0.f}), a1 = pack8(T01, T11);
            f32x4 O[2][2];
#pragma unroll
            for (int g = 0; g < 2; ++g) { O[g][0] = (f32x4){0.f, 0.f, 0.f, 0.f}; O[g][1] = O[g][0]; }
#pragma unroll
            for (int kk = 0; kk < 4; ++kk) {
                const bf16x8 aq0 = join8(*(const LAS v2u*)(QD + QDOFF(l15) + 32 * kk + 4 * quad), *(const LAS v2u*)(QD + QDOFF(l15) + 32 * kk + 16 + 4 * quad));
                const bf16x8 aq1 = join8(*(const LAS v2u*)(QD + QDOFF(16 + l15) + 32 * kk + 4 * quad), *(const LAS v2u*)(QD + QDOFF(16 + l15) + 32 * kk + 16 + 4 * quad));
#pragma unroll
                for (int g = 0; g < 2; ++g) { const bf16x8 bs = pack8(S[g][2 * kk], S[g][2 * kk + 1]); O[g][0] = MFMA16(aq0, bs, O[g][0]); O[g][1] = MFMA16(aq1, bs, O[g][1]); }
            }
#pragma unroll
            for (int g = 0; g < 2; ++g) {
                const LAS bf16* vrow = VT + VTOFF(32 * w + 16 * g + l15);
                const bf16x8 bv = join8(*(const LAS v2u*)(vrow + 4 * quad), *(const LAS v2u*)(vrow + 16 + 4 * quad));
                O[g][0] = MFMA16(a0, bv, O[g][0]); O[g][1] = MFMA16(a1, bv, O[g][1]);
                float* op = F.OLOC + (row0 + (size_t)(ch * 32 + 4 * quad)) * 512 + h * 128 + 32 * w + 16 * g + l15;
#pragma unroll
                for (int r = 0; r < 4; ++r) { op[(size_t)r * 512] = O[g][0][r]; op[(size_t)(16 + r) * 512] = O[g][1][r]; }
            }
            const bf16x8 bvn0 = *(const LAS bf16x8*)(VT + VTOFF(32 * w + l15) + 8 * quad), bvn1 = *(const LAS bf16x8*)(VT + VTOFF(32 * w + 16 + l15) + 8 * quad);
#pragma unroll
            for (int tc = 0; tc < 8; ++tc) {
                const f32x4 dec = *(const LAS f32x4*)(DEC + 16 * tc + 4 * quad);
                const bf16x8 ak = *(const LAS bf16x8*)(KDT + (16 * tc + l15) * KT_STRIDE + 8 * quad);
                S[0][tc] = S[0][tc] * dec; S[1][tc] = S[1][tc] * dec;
                S[0][tc] = MFMA16(ak, bvn0, S[0][tc]); S[1][tc] = MFMA16(ak, bvn1, S[1][tc]);
            }
            if (ch + 1 < 8) { HG_ELEM(ch + 1); if (ch + 2 < 8) HG_LOAD_RAW(ch + 2); }
        }
        LDS_BARRIER();
    }
#undef HG_LOAD_RAW
#undef HG_ELEM
    if (w < 4) {
#pragma unroll
        for (int g = 0; g < 2; ++g) {
            f32x4* Lp = (f32x4*)F.LBUF + (size_t)(item * 8 + 2 * w + g) * 8 * 64 + lane;
#pragma unroll
            for (int tc = 0; tc < 8; ++tc) {
                const f32x4 val = S[g][tc] + 0.0f;
                asm volatile("global_store_dwordx4 %0, %1, off sc0 sc1\n\ts_nop 1" :: "v"(Lp + tc * 64), "v"(val) : "memory");
            }
        }
    }
    if (part == 0) { const float val = __expf(Bprev); asm volatile("global_store_dword %0, %1, off sc0 sc1" :: "v"(F.DTOT + item * 128 + c), "v"(val) : "memory"); }
}
__device__ __forceinline__ void hgrn_publish(Frame& F, unsigned* cnt, int item) {
    asm volatile("s_waitcnt vmcnt(0)" ::: "memory");
    __syncthreads();
    if (F.tid == 0) __hip_atomic_fetch_add(cnt + 64 * (item >> 3), 1u, __ATOMIC_RELAXED, __HIP_MEMORY_SCOPE_AGENT);
}
__device__ __forceinline__ void hgrn_wait(Frame& F, unsigned* cnt, int item) {
    if (F.tid == 0) {
        unsigned sp = 0;
        while (__hip_atomic_load(cnt + 64 * (item >> 3), __ATOMIC_RELAXED, __HIP_MEMORY_SCOPE_AGENT) < 8u) { __builtin_amdgcn_s_sleep(2); if (++sp > (1u << 22)) break; }
        __builtin_amdgcn_fence(__ATOMIC_ACQUIRE, "agent");
        asm volatile("s_waitcnt vmcnt(0)" ::: "memory");
    }
    __syncthreads();
}

constexpr int ST_STRIDE = 136;
__device__ __forceinline__ void hgrn_correct(Frame& F, int item) {
    const int b = item >> 5, h = (item >> 3) & 3, seg = item & 7;
    const int lane = F.lane, w = F.wave, quad = lane >> 4, l15 = lane & 15;
    const size_t row0 = (size_t)b * SEQ + seg * 256;
    LAS bf16* ST = (LAS bf16*)F.lds;
    v4u qf[2][4];
    if (seg > 0) {
#pragma unroll
        for (int tt = 0; tt < 2; ++tt)
#pragma unroll
            for (int kk = 0; kk < 4; ++kk) qf[tt][kk] = *(const v4u*)(F.QDS + (row0 + 32 * w + 16 * tt + l15) * 512 + h * 128 + 32 * kk + 8 * quad);
    }
    if (seg > 0) {
        f32x4 S[8];
#pragma unroll
        for (int i = 0; i < 8; ++i) S[i] = (f32x4){0.f, 0.f, 0.f, 0.f};
        f32x4 Lc[8], Dc[8];
        {
            const int im = item - seg;
            const f32x4* Lp = (const f32x4*)F.LBUF + (size_t)(im * 8 + w) * 8 * 64 + lane; const float* Dp = F.DTOT + im * 128;
#pragma unroll
            for (int tc = 0; tc < 8; ++tc) { Dc[tc] = *(const f32x4*)(Dp + 16 * tc + 4 * quad); Lc[tc] = Lp[tc * 64]; }
        }
        for (int m = 0; m < seg; ++m) {
            f32x4 Ln[8], Dn[8];
            const int im = item - seg + (m + 1 < seg ? m + 1 : m);
            const f32x4* Lp = (const f32x4*)F.LBUF + (size_t)(im * 8 + w) * 8 * 64 + lane; const float* Dp = F.DTOT + im * 128;
#pragma unroll
            for (int tc = 0; tc < 8; ++tc) { Dn[tc] = *(const f32x4*)(Dp + 16 * tc + 4 * quad); Ln[tc] = Lp[tc * 64]; }
#pragma unroll
            for (int tc = 0; tc < 8; ++tc) { S[tc] = Dc[tc] * S[tc] + Lc[tc]; Lc[tc] = Ln[tc]; Dc[tc] = Dn[tc]; }
        }
#pragma unroll
        for (int tc = 0; tc < 8; ++tc) { v2u o; o.x = pg8::cvt_pk_native(S[tc][0], S[tc][1]); o.y = pg8::cvt_pk_native(S[tc][2], S[tc][3]);
            *(LAS v2u*)(ST + (16 * w + l15) * ST_STRIDE + 16 * tc + 4 * quad) = o; }
    }
    f32x4 OL[2][8]; v2u GW[2][8];
#pragma unroll
    for (int tt = 0; tt < 2; ++tt) {
        const size_t row = row0 + 32 * w + 16 * tt + l15;
#pragma unroll
        for (int vt = 0; vt < 8; ++vt) { OL[tt][vt] = *(const f32x4*)(F.OLOC + row * 512 + h * 128 + 4 * quad + 16 * vt); GW[tt][vt] = *(const v2u*)(F.PROJ + row * PW + C_G + h * 128 + 4 * quad + 16 * vt); }
    }
    __syncthreads();
    f32x4 O[8][2];
#pragma unroll
    for (int vt = 0; vt < 8; ++vt) { O[vt][0] = (f32x4){0.f, 0.f, 0.f, 0.f}; O[vt][1] = O[vt][0]; }
    if (seg > 0) {
#pragma unroll
        for (int vt = 0; vt < 8; ++vt)
#pragma unroll
            for (int kk = 0; kk < 4; ++kk) {
                const bf16x8 a = *(const LAS bf16x8*)(ST + (16 * vt + l15) * ST_STRIDE + 32 * kk + 8 * quad);
                O[vt][0] = MFMA16(a, __builtin_bit_cast(bf16x8, qf[0][kk]), O[vt][0]);
                O[vt][1] = MFMA16(a, __builtin_bit_cast(bf16x8, qf[1][kk]), O[vt][1]);
            }
    }
#pragma unroll
    for (int tt = 0; tt < 2; ++tt) {
        const size_t row = row0 + 32 * w + 16 * tt + l15;
        float ss = 0.f;
#pragma unroll
        for (int vt = 0; vt < 8; ++vt) { const f32x4 o = O[vt][tt] + OL[tt][vt]; O[vt][tt] = o; ss += (o[0] * o[0] + o[1] * o[1]) + (o[2] * o[2] + o[3] * o[3]); }
        ss += __shfl_xor(ss, 16); ss += __shfl_xor(ss, 32);
        const float rs = __builtin_amdgcn_rsqf(ss * (1.0f / 128.0f) + EPS);
        bf16* mp = F.MIXED + row * D + h * 128 + 4 * quad;
#pragma unroll
        for (int vt = 0; vt < 8; ++vt) {
            const v2u gw = GW[tt][vt];
            const f32x4 og = *(const f32x4*)(F.ogain + 16 * vt + 4 * quad);
            const f32x4 o = O[vt][tt];
            v2u ow; ow.x = pk2(o[0] * rs * og[0] * bflo(gw.x), o[1] * rs * og[1] * bfhi(gw.x)); ow.y = pk2(o[2] * rs * og[2] * bflo(gw.y), o[3] * rs * og[3] * bfhi(gw.y));
            *(v2u*)(mp + 16 * vt) = ow;
        }
    }
    __syncthreads();
}
__device__ __forceinline__ int mix_first_item(const Frame& F) { const int bx = blockIdx.x; return (F.G == 256) ? (bx & 7) * 32 + (bx >> 3) : bx; }
__device__ __forceinline__ void mix_phase_a(Frame& F, bool handoff, unsigned* cnt) {
#if !NAIVE_HGRN
    for (int it = mix_first_item(F); it < NB * HH * 8; it += F.G) {
#if HGRN_WS
        hgrn_local_ws2(F, it);
#else
        hgrn_local(F, it);
#endif
        if (handoff) hgrn_publish(F, cnt, it); }
    __syncthreads();
#else
    hgrn_naive(F); __syncthreads();
#endif
#if !NAIVE_ATTN
    for (int it = mix_first_item(F); it < NB * KVH * 16; it += F.G) attn_item(F, it);
#else
    attn_naive(F); __syncthreads();
#endif
}
__device__ __forceinline__ void mix_phase_b(Frame& F, bool handoff, unsigned* cnt) {
#if !NAIVE_HGRN
    for (int it = mix_first_item(F); it < NB * HH * 8; it += F.G) { if (handoff) hgrn_wait(F, cnt, it); hgrn_correct(F, it); }
#else
    hgrn_norm_naive(F);
#endif
}
#define MK_N_LAUNCHES 1
#define NAIVE_MIX 0

#ifndef MK_N_LAUNCHES
#define MK_N_LAUNCHES 1
#endif
#ifndef NAIVE_MIX
#define NAIVE_MIX 0
#endif
constexpr int N_PHASES = 7;
struct Args { const float* in[13]; float* out; unsigned char* ws; int ph_lo, ph_hi; };
template <bool COOP>
__global__ void __launch_bounds__(NWAVES * 64, 2) fwd(Args args) {
    extern __shared__ __attribute__((aligned(16))) unsigned char lds[];
    Frame F;
    F.lds = (LAS unsigned char*)lds;
    F.tid = threadIdx.x; F.lane = F.tid & 63; F.wave = __builtin_amdgcn_readfirstlane(F.tid >> 6); F.G = gridDim.x;
    unsigned char* ws = args.ws;
    F.x = args.in[0]; F.g1 = args.in[1]; F.w_in = args.in[2]; F.lbl = args.in[3]; F.ogain = args.in[4]; F.qg = args.in[5]; F.kg = args.in[6];
    F.sinks = args.in[7]; F.w_out = args.in[8]; F.g2 = args.in[9]; F.w_gate = args.in[10]; F.w_up = args.in[11]; F.w_down = args.in[12]; F.out = args.out;
    F.WIN = (bf16*)(ws + WS_WIN); F.WOUT = (bf16*)(ws + WS_WOUT); F.WGU = (bf16*)(ws + WS_WGU); F.WDN = (bf16*)(ws + WS_WDN);
    F.XB = (bf16*)(ws + WS_XB); F.PROJ = (bf16*)(ws + WS_PROJ); F.ACT = (bf16*)(ws + WS_ACT); F.MIXED = (bf16*)(ws + WS_MIXED); F.HB = (bf16*)(ws + WS_HB); F.QDS = (bf16*)(ws + WS_QDS);
    F.RSTD1 = (float*)(ws + WS_RSTD1); F.PART = (float*)(ws + WS_PART); F.DTOT = (float*)(ws + WS_DTOT); F.OLOC = (float*)(ws + WS_OLOC); F.LBUF = (float*)(ws + WS_LBUF);
    const int lo = args.ph_lo, hi = args.ph_hi;
#define IN(k) (lo <= (k) && (k) < hi)
#ifndef USE_CG_SYNC
#define USE_CG_SYNC 0
#endif
    XcdBarrier bar; bar.bar = (unsigned*)(ws + WS_CTL) + 4096; bar.x = 0; bar.st = nullptr;
    if constexpr (COOP) {
        for (int u = F.tid; u < (LDS_BYTES - 131072) / 4; u += NWAVES * 64) ((LAS unsigned*)(F.lds + 131072))[u] = 0u;
        __syncthreads();
        bar = xcd_barrier_post((unsigned*)(ws + WS_CTL) + 4096, (volatile LAS unsigned*)(F.lds + 131072 + 352));
    }
#define SEAM(k) do { if constexpr (COOP) { if (IN(k) && IN((k) + 1)) { if (USE_CG_SYNC) cg::this_grid().sync(); else xcd_barrier(bar); } } } while (0)

#ifndef PROBE_DUP
#define PROBE_DUP 0
#endif
#ifndef PROBE_SYNC
#define PROBE_SYNC 0
#endif
    const bool handoff23 = COOP && !NAIVE_MIX && !NAIVE_HGRN && (F.G == NB * HH * 8) && IN(2) && IN(3);
    unsigned* cnt23 = (unsigned*)(ws + WS_CTL) + 8192;
    if (IN(0)) { p0_prologue(F); if (PROBE_DUP & 1) { __syncthreads(); p0_prologue(F); } SEAM(0); if constexpr (COOP) { for (int i_ = 0; i_ < PROBE_SYNC; ++i_) xcd_barrier(bar); } }
    if (IN(1)) {
        pg8::Gemm g{F.XB, F.WIN, M, PW, D}; pg8::StaticOrder S; S.init(M, PW, F.G, (int)blockIdx.x);
        LAS float* rsc1 = (LAS float*)(F.lds + 131072 + 1024); const int rbase1 = (int)(blockIdx.x & 7) * 2048; const bool rs1_cached = (F.G == 256);
        if (rs1_cached) { for (int r = F.tid; r < 2048; r += NWAVES * 64) rsc1[r] = F.RSTD1[rbase1 + r]; __syncthreads(); }
        pg8::EpiProj E{F.PROJ, F.RSTD1, F.lbl, rs1_cached ? (const LAS float*)rsc1 : (const LAS float*)nullptr, rbase1};
        pg8::gemm_phase<pg8::EpiProj, pg8::StaticOrder, true, true>(F.lds, g, S, E);
        if (PROBE_DUP & 2) { __syncthreads(); pg8::gemm_phase<pg8::EpiProj, pg8::StaticOrder, true, true>(F.lds, g, S, E); }
        {
            const int nwg = (M / 256) * (PW / 256), rem = nwg % F.G;
            const int first_late = (rem == 0) ? 0 : rem;
            if ((int)blockIdx.x >= first_late) { __syncthreads(); p0_weights_late(F, first_late, 0); }
        }
        SEAM(1);
    }
    if (IN(2)) {
#if NAIVE_MIX
        attn_naive(F); hgrn_naive(F);
#else
        mix_phase_a(F, handoff23, cnt23);
#endif
        if (!handoff23) SEAM(2);
    }
    if (IN(3)) {
#if NAIVE_MIX
        hgrn_norm_naive(F);
#else
        mix_phase_b(F, handoff23, cnt23);
#endif

        SEAM(3);
    }
    if (IN(4)) {
        pg8::Gemm g{F.MIXED, F.WOUT, M, D, D}; pg8::StaticOrder S; S.init(M, D, F.G, (int)blockIdx.x);
        pg8::EpiOut E{F.XB, F.out, F.HB, F.PART};
        pg8::gemm_phase<pg8::EpiOut, pg8::StaticOrder, true, true>(F.lds, g, S, E);
        if (PROBE_DUP & 16) { __syncthreads(); pg8::gemm_phase<pg8::EpiOut, pg8::StaticOrder, true, true>(F.lds, g, S, E); }
        SEAM(4);
    }
    if (IN(5)) {
        pg8::Gemm g{F.HB, F.WGU, M, NGU, D}; pg8::StaticOrder S; S.init(M, NGU, F.G, (int)blockIdx.x);
        LAS float* rsc = (LAS float*)(F.lds + 131072 + 1024); const int rbase = (int)(blockIdx.x & 7) * 2048; const bool rs_cached = (F.G == 256);
        if (rs_cached) {
            for (int r = F.tid; r < 2048; r += NWAVES * 64) {
                const f32x4* pp = (const f32x4*)(F.PART + (size_t)(rbase + r) * 16);
                const f32x4 p0 = pp[0], p1 = pp[1], p2 = pp[2], p3 = pp[3];
                const float ssq = ((p0[0] + p0[1]) + (p0[2] + p0[3])) + ((p1[0] + p1[1]) + (p1[2] + p1[3])) + ((p2[0] + p2[1]) + (p2[2] + p2[3])) + ((p3[0] + p3[1]) + (p3[2] + p3[3]));
                rsc[r] = __builtin_amdgcn_rsqf(ssq * (1.0f / 1024.0f) + 1e-6f);
            }
            __syncthreads();
        }
        pg8::EpiGU E{F.ACT, F.PART, rs_cached ? (const LAS float*)rsc : (const LAS float*)nullptr, rbase};
        pg8::gemm_phase<pg8::EpiGU, pg8::StaticOrder, true, true>(F.lds, g, S, E);
        if (PROBE_DUP & 32) { __syncthreads(); pg8::gemm_phase<pg8::EpiGU, pg8::StaticOrder, true, true>(F.lds, g, S, E); }
        {
            const int nwg = (M / 256) * (NGU / 256), rem = nwg % F.G;
            const int first_late = (rem == 0) ? 0 : rem;
            if ((int)blockIdx.x >= first_late) { __syncthreads(); p0_weights_late(F, first_late, 1); }
        }
        SEAM(5);
    }
    if (IN(6)) {
        pg8::Gemm g{F.ACT, F.WDN, M, D, FF}; pg8::StaticOrder S; S.init(M, D, F.G, (int)blockIdx.x);
        pg8::EpiDown E{F.out, F.HB};
        pg8::gemm_phase<pg8::EpiDown, pg8::StaticOrder, true, true>(F.lds, g, S, E);
        if (PROBE_DUP & 256) { __syncthreads(); pg8::gemm_phase<pg8::EpiDown, pg8::StaticOrder, true, true>(F.lds, g, S, E); }
    }
#undef IN
#undef SEAM
}

extern "C" void kernel_launch(void* const* d_in, const int* in_sizes, int n_in, void* d_out, int out_size, void* d_ws, size_t ws_size, hipStream_t stream) {
    static int grid = 0;
    if (grid == 0) {
        if (n_in != 13 || in_sizes[0] != M * D || out_size != M * D || ws_size < WS_END) { fprintf(stderr, "kernel_launch: unexpected shapes (n_in %d, in0 %d, out %d, ws %zu)\n", n_in, n_in > 0 ? in_sizes[0] : -1, out_size, ws_size); grid = -1; return; }
        int dev = 0, cus = 0, per_cu = 0;
        if (hipGetDevice(&dev) != hipSuccess || hipDeviceGetAttribute(&cus, hipDeviceAttributeMultiprocessorCount, dev) != hipSuccess) { grid = -1; return; }
        (void)hipFuncSetAttribute((const void*)fwd<true>, hipFuncAttributeMaxDynamicSharedMemorySize, LDS_BYTES);
        (void)hipFuncSetAttribute((const void*)fwd<false>, hipFuncAttributeMaxDynamicSharedMemorySize, LDS_BYTES);
        if (hipOccupancyMaxActiveBlocksPerMultiprocessor(&per_cu, (const void*)fwd<true>, NWAVES * 64, LDS_BYTES) != hipSuccess || per_cu < 1) {
            fprintf(stderr, "kernel_launch: occupancy query reports %d blocks per CU\n", per_cu); per_cu = 1; }
        (void)hipGetLastError();
        grid = cus;
    }
    if (grid < 0) return;
    if (hipMemsetAsync((char*)d_ws + WS_CTL, 0, 65536, stream) != hipSuccess) { fprintf(stderr, "kernel_launch: memset of the barrier words failed\n"); return; }
    Args a{};
    for (int i = 0; i < 13; ++i) a.in[i] = (const float*)d_in[i];
    a.out = (float*)d_out; a.ws = (unsigned char*)d_ws;
#if MK_N_LAUNCHES == 1
    a.ph_lo = 0; a.ph_hi = N_PHASES;
    void* params[] = {&a};
    hipError_t e = hipLaunchCooperativeKernel((const void*)fwd<true>, dim3(grid), dim3(NWAVES * 64), params, LDS_BYTES, stream);
    if (e != hipSuccess) fprintf(stderr, "cooperative launch failed: %s (grid %d)\n", hipGetErrorString(e), grid);
#else
    for (int ph = 0; ph < N_PHASES; ++ph) {
        a.ph_lo = ph; a.ph_hi = ph + 1;
        hipLaunchKernelGGL(fwd<false>, dim3(grid), dim3(NWAVES * 64), LDS_BYTES, stream, a);
    }
#endif
}
```

```cpp
#include <hip/hip_runtime.h>
#include <hip/hip_cooperative_groups.h>
#include <cstdio>
#include <cstdint>
namespace cg = cooperative_groups;
namespace pg8 {
#define PG8_LAS __attribute__((address_space(3)))
typedef unsigned short bf16_t;
typedef short bf16x8 __attribute__((ext_vector_type(8)));
typedef float f32x4 __attribute__((ext_vector_type(4)));
typedef unsigned u32x4 __attribute__((ext_vector_type(4)));
constexpr int BM = 256, BK = 64, HALF = 128, HTB = HALF * BK * 2  , STAGE_BYTES = 8 * HTB, NXCD = 8, WGM = 8;

__host__ __device__ __forceinline__ int lds_byte(int r, int c) { const int st = (r >> 4) * 2 + (c >> 5), rr = r & 15, cc = c & 31, ob = rr * 64 + cc * 2; return st * 1024 + (ob ^ (((ob >> 9) & 1) << 5)); }
__host__ __device__ __forceinline__ void stage_rc(int b, int& R, int& C) { const int st = b / 1024, sb = b % 1024, swz = sb ^ (((sb >> 9) & 1) << 5); R = (st >> 1) * 16 + swz / 64; C = (st & 1) * 32 + (swz % 64) / 2; }
__host__ __device__ __forceinline__ int perm32(int rho) { const int n = rho >> 4, i = rho & 15; return 8 * (i >> 2) + 4 * n + (i & 3); }

struct Unit { int pm, pn; };
struct Gemm { const bf16_t* A; const bf16_t* Bt; int M, N, K; };

struct StaticOrder {
    int nM, nN, nwg, G, c;
    __host__ __device__ void init(int M, int N, int G_, int c_) { nM = M / BM; nN = N / BM; nwg = nM * nN; G = G_; c = c_; }
    __host__ __device__ bool next(int i, Unit& u) const {
        const long L = (long)i * G + c; if (L >= nwg) return false;
        int wgid = (int)L; { const int q = nwg / NXCD, r = nwg % NXCD, xcd = wgid % NXCD, off = wgid / NXCD; wgid = (xcd < r ? xcd * (q + 1) : r * (q + 1) + (xcd - r) * q) + off; }
        const int nig = WGM * nN, gid = wgid / nig, fm = gid * WGM, gsz = (nM - fm) < WGM ? (nM - fm) : WGM;
        u.pm = fm + ((wgid % nig) % gsz); u.pn = (wgid % nig) / gsz; return true;
    }
    __device__ __forceinline__ void a_ready(const Unit&) const {}
    __device__ __forceinline__ void done(const Unit&) const {}
};

typedef float f32x2 __attribute__((ext_vector_type(2)));
typedef __bf16 nbf16x2e __attribute__((ext_vector_type(2)));
__device__ __forceinline__ unsigned cvt_pk_bf16(float lo, float hi) { f32x2 v = {lo, hi}; return __builtin_bit_cast(unsigned, __builtin_convertvector(v, nbf16x2e)); }
typedef __bf16 nbf16x2 __attribute__((ext_vector_type(2)));
__device__ __forceinline__ unsigned cvt_pk_native(float lo, float hi) { f32x2 v = {lo, hi}; return __builtin_bit_cast(unsigned, __builtin_convertvector(v, nbf16x2)); }
typedef float f32x2 __attribute__((ext_vector_type(2)));
template <class Epi, class Sched, bool ALIGN_EPI = false, bool SP2 = false>
__device__ __forceinline__ void gemm_phase(PG8_LAS unsigned char* lds, const Gemm g, const Sched& S, const Epi& E) {
    const int tid = threadIdx.x, wid = __builtin_amdgcn_readfirstlane(tid >> 6), lane = tid & 63, wr = wid >> 2, wc = wid & 3, fr = lane & 15, fq = lane >> 4;
    const int K = g.K, nt = K / BK;
    unsigned voffA[2], voffB[2];
#pragma unroll
    for (int i = 0; i < 2; ++i) { int R, C; stage_rc(tid * 16 + i * 8192, R, C); const int Rb = Epi::PERM ? ((R & ~31) + perm32(R & 31)) : R;
        voffA[i] = (unsigned)(R * K + C) * 2u; voffB[i] = (unsigned)(Rb * K + C) * 2u; }
    const size_t kstep = (size_t)(BK * 2);
    const size_t hstep = (size_t)HALF * K * 2;
    const size_t tstep = 2 * hstep;
    const unsigned ldsw = (unsigned)wid * 1024u;
    const int aoff = lds_byte(wr * 64 + fr, fq * 8), boff = lds_byte(wc * 32 + fr, fq * 8);
#define PG8_SA(b, h) (((b) * 2 + (h)) * HTB)
#define PG8_SB(b, h) ((4 + (b) * 2 + (h)) * HTB)
#define PG8_STAGE(bufoff, gbase, voff) do { _Pragma("unroll") for (int _i = 0; _i < 2; ++_i) \
        __builtin_amdgcn_global_load_lds((const unsigned*)((const char*)(gbase) + (voff)[_i]), (PG8_LAS unsigned*)(lds + (bufoff) + ldsw + _i * 8192), 16, 0, 0); } while (0)
#define PG8_LDA(dst, b, h) do { _Pragma("unroll") for (int m = 0; m < 4; ++m) _Pragma("unroll") for (int k = 0; k < 2; ++k) dst[m][k] = *(const PG8_LAS bf16x8*)(lds + PG8_SA(b, h) + aoff + m * 2048 + k * 1024); } while (0)
#define PG8_LDB(dst, b, h) do { _Pragma("unroll") for (int n = 0; n < 2; ++n) _Pragma("unroll") for (int k = 0; k < 2; ++k) dst[n][k] = *(const PG8_LAS bf16x8*)(lds + PG8_SB(b, h) + boff + n * 2048 + k * 1024); } while (0)
#define PG8_MMA(ai, bj, At, Bt) do { __builtin_amdgcn_s_setprio(1); _Pragma("unroll") for (int m = 0; m < 4; ++m) _Pragma("unroll") for (int n = 0; n < 2; ++n) _Pragma("unroll") for (int k = 0; k < 2; ++k) \
        acc[ai][bj][m][n] = __builtin_amdgcn_mfma_f32_16x16x32_bf16(Bt[n][k], At[m][k], acc[ai][bj][m][n], 0, 0, 0); __builtin_amdgcn_s_setprio(0); } while (0)
#define PG8_WAIT_V(n) asm volatile("s_waitcnt vmcnt(" #n ")" ::: "memory")
#define PG8_WAIT_L(n) asm volatile("s_waitcnt lgkmcnt(" #n ")" ::: "memory")
#define PG8_BAR __builtin_amdgcn_s_barrier()
#define PG8_SCHED __builtin_amdgcn_sched_barrier(0)
    Unit cur, nxt; int ui = 0;
    if (!S.next(0, cur)) return;
    f32x4 acc[2][2][4][2];
#pragma unroll
    for (int a = 0; a < 2; ++a)
#pragma unroll
        for (int b = 0; b < 2; ++b)
#pragma unroll
            for (int m = 0; m < 4; ++m)
#pragma unroll
                for (int n = 0; n < 2; ++n) acc[a][b][m][n] = (f32x4){0.f, 0.f, 0.f, 0.f};
    bf16x8 At[4][2], B0[2][2], B1[2][2];
    const char* cA = (const char*)g.A + (size_t)cur.pm * tstep; const char* cB = (const char*)g.Bt + (size_t)cur.pn * tstep;
    S.a_ready(cur);
    if constexpr (SP2) {
        PG8_STAGE(PG8_SB(0, 0), cB, voffB); PG8_STAGE(PG8_SB(0, 1), cB + hstep, voffB); PG8_STAGE(PG8_SA(0, 0), cA, voffA); PG8_STAGE(PG8_SA(0, 1), cA + hstep, voffA);
        if (wr == 1) PG8_BAR;
        PG8_WAIT_V(2); PG8_BAR;
        PG8_STAGE(PG8_SB(1, 0), cB + kstep, voffB); PG8_STAGE(PG8_SA(1, 0), cA + kstep, voffA); PG8_STAGE(PG8_SB(1, 1), cB + hstep + kstep, voffB);
        PG8_WAIT_V(6); PG8_BAR;
    } else {
        PG8_STAGE(PG8_SB(0, 0), cB, voffB); PG8_STAGE(PG8_SA(0, 0), cA, voffA); PG8_STAGE(PG8_SB(0, 1), cB + hstep, voffB); PG8_STAGE(PG8_SA(0, 1), cA + hstep, voffA);
        if (wr == 1) PG8_BAR;
        PG8_WAIT_V(4); PG8_BAR;
        PG8_STAGE(PG8_SB(1, 0), cB + kstep, voffB); PG8_STAGE(PG8_SA(1, 0), cA + kstep, voffA); PG8_STAGE(PG8_SB(1, 1), cB + hstep + kstep, voffB);
        PG8_WAIT_V(6); PG8_BAR;
    }
    for (;;) {
        const bool has_next = S.next(ui + 1, nxt);
        const char* nA = has_next ? (const char*)g.A + (size_t)nxt.pm * tstep : cA; const char* nB = has_next ? (const char*)g.Bt + (size_t)nxt.pn * tstep : cB;
        for (int t = 0; t < nt; t += 2) {
            const bool last = (t == nt - 2);
            const char* a1 = cA + (size_t)(t + 1) * kstep;
            const char* a2 = last ? nA : cA + (size_t)(t + 2) * kstep; const char* b2 = last ? nB : cB + (size_t)(t + 2) * kstep;
            const char* a3 = a2 + kstep; const char* b3 = b2 + kstep;
            if (last && has_next) S.a_ready(nxt);
            if constexpr (SP2) {
            PG8_LDB(B0, 0, 0); PG8_LDB(B1, 0, 1); PG8_SCHED; PG8_LDA(At, 0, 0); PG8_STAGE(PG8_SA(1, 1), a1 + hstep, voffA);
            PG8_WAIT_V(8); PG8_WAIT_L(0); PG8_BAR; PG8_MMA(0, 0, At, B0); PG8_MMA(0, 1, At, B1); PG8_BAR; PG8_SCHED;
            PG8_LDA(At, 0, 1); PG8_STAGE(PG8_SB(0, 0), b2, voffB); PG8_STAGE(PG8_SB(0, 1), b2 + hstep, voffB); PG8_STAGE(PG8_SA(0, 0), a2, voffA);
            PG8_WAIT_V(8); PG8_WAIT_L(0); PG8_BAR; PG8_MMA(1, 0, At, B0); PG8_MMA(1, 1, At, B1); PG8_BAR; PG8_SCHED;
            PG8_LDB(B0, 1, 0); PG8_LDB(B1, 1, 1); PG8_SCHED; PG8_LDA(At, 1, 0); PG8_STAGE(PG8_SA(0, 1), a2 + hstep, voffA);
            PG8_WAIT_V(8); PG8_WAIT_L(0); PG8_BAR; PG8_MMA(0, 0, At, B0); PG8_MMA(0, 1, At, B1); PG8_BAR; PG8_SCHED;
            PG8_LDA(At, 1, 1); PG8_STAGE(PG8_SB(1, 0), b3, voffB); PG8_STAGE(PG8_SB(1, 1), b3 + hstep, voffB); PG8_STAGE(PG8_SA(1, 0), a3, voffA);
            PG8_WAIT_V(8); PG8_WAIT_L(0); PG8_BAR; PG8_MMA(1, 0, At, B0); PG8_MMA(1, 1, At, B1); PG8_BAR; PG8_SCHED;
            } else {
            PG8_LDB(B0, 0, 0); PG8_SCHED; PG8_LDA(At, 0, 0); PG8_STAGE(PG8_SA(1, 1), a1 + hstep, voffA);
            PG8_WAIT_L(8); PG8_BAR; PG8_WAIT_L(0); PG8_MMA(0, 0, At, B0); PG8_BAR; PG8_SCHED;
            PG8_LDB(B1, 0, 1); PG8_STAGE(PG8_SB(0, 0), b2, voffB);
            PG8_BAR; PG8_WAIT_L(0); PG8_MMA(0, 1, At, B1); PG8_BAR;
            PG8_LDA(At, 0, 1); PG8_STAGE(PG8_SA(0, 0), a2, voffA);
            PG8_BAR; PG8_WAIT_L(0); PG8_MMA(1, 0, At, B0); PG8_BAR; PG8_SCHED;
            PG8_STAGE(PG8_SB(0, 1), b2 + hstep, voffB);
            PG8_WAIT_V(6); PG8_BAR; PG8_MMA(1, 1, At, B1); PG8_BAR;
            PG8_LDB(B0, 1, 0); PG8_SCHED; PG8_LDA(At, 1, 0); PG8_STAGE(PG8_SA(0, 1), a2 + hstep, voffA);
            PG8_WAIT_L(8); PG8_BAR; PG8_WAIT_L(0); PG8_MMA(0, 0, At, B0); PG8_BAR; PG8_SCHED;
            PG8_LDB(B1, 1, 1); PG8_STAGE(PG8_SB(1, 0), b3, voffB);
            PG8_BAR; PG8_WAIT_L(0); PG8_MMA(0, 1, At, B1); PG8_BAR;
            PG8_LDA(At, 1, 1); PG8_STAGE(PG8_SA(1, 0), a3, voffA);
            PG8_BAR; PG8_WAIT_L(0); PG8_MMA(1, 0, At, B0); PG8_BAR; PG8_SCHED;
            PG8_STAGE(PG8_SB(1, 1), b3 + hstep, voffB);
            PG8_WAIT_V(6); PG8_BAR; PG8_MMA(1, 1, At, B1); PG8_BAR;
            }
        }
        if constexpr (ALIGN_EPI) { if (wr == 0) PG8_BAR; }
        if constexpr (!Epi::AFTER_DRAIN) { E(acc, cur, wr, wc, fr, fq); S.done(cur); }
        if (!has_next) break;
#pragma unroll
        for (int a = 0; a < 2; ++a)
#pragma unroll
            for (int b = 0; b < 2; ++b)
#pragma unroll
                for (int m = 0; m < 4; ++m)
#pragma unroll
                    for (int n = 0; n < 2; ++n) acc[a][b][m][n] = (f32x4){0.f, 0.f, 0.f, 0.f};
        cur = nxt; cA = nA; cB = nB; ++ui;
        if constexpr (ALIGN_EPI) { if (wr == 1) PG8_BAR; }
    }
    PG8_WAIT_V(0);
    if constexpr (!ALIGN_EPI) { if (wr == 0) PG8_BAR; }
    PG8_BAR;
    if constexpr (Epi::AFTER_DRAIN) { E.fused(acc, cur, wr, wc, fr, fq, lds, wid, lane); S.done(cur); }
#undef PG8_SA
#undef PG8_SB
#undef PG8_STAGE
#undef PG8_LDA
#undef PG8_LDB
#undef PG8_MMA
#undef PG8_WAIT_V
#undef PG8_WAIT_L
#undef PG8_BAR
#undef PG8_SCHED
}
}

#define GAS __attribute__((address_space(1)))
#define LAS __attribute__((address_space(3)))
typedef unsigned short bf16;
typedef unsigned v4u __attribute__((ext_vector_type(4)));
typedef unsigned v2u __attribute__((ext_vector_type(2)));
typedef float f32x4 __attribute__((ext_vector_type(4)));
typedef short bf16x8 __attribute__((ext_vector_type(8)));
typedef short bf16x4 __attribute__((ext_vector_type(4)));

constexpr int NWAVES = 8;
constexpr int NB = 8, SEQ = 2048, D = 1024, M = NB * SEQ;
constexpr int PW = 2816, FF = 2816, NGU = 2 * FF;
constexpr int HH = 4, DK = 128, DV = 128, HW = 512;
constexpr int AH = 8, KVH = 2, AG = 4, HD = 64;
constexpr int C_Q = 0, C_F = 512, C_I = 1024, C_G = 1536, C_AQ = 2048, C_AK = 2560, C_AV = 2688;
constexpr float EPS = 1e-6f;

constexpr size_t MiB = 1u << 20;
constexpr size_t WS_CTL = 0;
constexpr size_t WS_WIN = 2 * MiB, WS_WOUT = 8 * MiB, WS_WGU = 10 * MiB, WS_WDN = 21 * MiB;
constexpr size_t WS_RSTD1 = 27 * MiB, WS_PART = 28 * MiB, WS_DTOT = 29 * MiB;
constexpr size_t WS_XB = 32 * MiB;
constexpr size_t WS_OLOC = 184 * MiB;
constexpr size_t WS_PROJ = 64 * MiB;
constexpr size_t WS_ACT = 64 * MiB;
constexpr size_t WS_MIXED = 152 * MiB;
constexpr size_t WS_HB = 184 * MiB;
constexpr size_t WS_LBUF = 216 * MiB;
constexpr size_t WS_QDS = 232 * MiB;
constexpr size_t WS_END = 256 * MiB;

constexpr int LDS_BYTES = 147456;

#define LDS_WAIT() asm volatile("s_waitcnt lgkmcnt(0)" ::: "memory")
#define VM_WAIT() asm volatile("s_waitcnt vmcnt(0)" ::: "memory")
__device__ __forceinline__ unsigned f2bf(float f) { unsigned u = __builtin_bit_cast(unsigned, f); return (u + 0x7fffu + ((u >> 16) & 1u)) >> 16; }
__device__ __forceinline__ unsigned pk2(float lo, float hi) { return f2bf(lo) | (f2bf(hi) << 16); }
__device__ __forceinline__ float bf2f(unsigned short b) { return __builtin_bit_cast(float, (unsigned)b << 16); }
__device__ __forceinline__ float bflo(unsigned w) { return __builtin_bit_cast(float, w << 16); }
__device__ __forceinline__ float bfhi(unsigned w) { return __builtin_bit_cast(float, w & 0xffff0000u); }
__device__ __forceinline__ float wave_sum(float v) {
#pragma unroll
    for (int o = 1; o < 64; o <<= 1) v += __shfl_xor(v, o);
    return v;
}
__device__ __forceinline__ float silu_f(float v) { return v / (1.0f + __expf(-v)); }

struct Frame {
    LAS unsigned char* lds;
    int tid, lane, wave, G;
    const float *x, *g1, *w_in, *lbl, *ogain, *qg, *kg, *sinks, *w_out, *g2, *w_gate, *w_up, *w_down;
    float* out;
    bf16 *WIN, *WOUT, *WGU, *WDN, *XB, *PROJ, *ACT, *MIXED, *HB, *QDS;
    float *RSTD1, *PART, *DTOT, *OLOC, *LBUF;
};

namespace pg8 {
struct EpiProj {
    static constexpr bool PERM = true, AFTER_DRAIN = false;
    bf16_t* O; const float* rstd; const float* lbl; const LAS float* rsc; int rbase;
    __device__ __forceinline__ void operator()(const f32x4 (&acc)[2][2][4][2], const Unit& u, int wr, int wc, int fr, int fq) const {
        const int row0 = u.pm * BM + wr * 64 + fr;
#pragma unroll
        for (int bj = 0; bj < 2; ++bj) {
            const int col0 = u.pn * BM + bj * HALF + wc * 32 + 8 * fq;
            const int seg = __builtin_amdgcn_readfirstlane(col0 >> 9);
            float lb[8];
#pragma unroll
            for (int i = 0; i < 8; ++i) lb[i] = 0.f;
            if (seg == 1) {
                const int ci = col0 & 511;
#pragma unroll
                for (int i = 0; i < 8; ++i) { const float l0 = lbl[ci + i], l1 = lbl[512 + ci + i]; lb[i] = __builtin_amdgcn_rcpf(1.0f + __expf(l1 - l0)); }
            }
#pragma unroll
            for (int ai = 0; ai < 2; ++ai)
#pragma unroll
                for (int m = 0; m < 4; ++m) {
                    const int row = row0 + ai * HALF + m * 16; const float rs = rsc ? rsc[row - rbase] : rstd[row];
                    float v[8];
#pragma unroll
                    for (int i = 0; i < 4; ++i) { v[i] = acc[ai][bj][m][0][i] * rs; v[4 + i] = acc[ai][bj][m][1][i] * rs; }
                    if (seg == 0) {
#pragma unroll
                        for (int i = 0; i < 8; ++i) v[i] = v[i] * __builtin_amdgcn_rcpf(1.0f + __expf(-v[i])) * 0.08838834764831845f;
                    } else if (seg == 1) {
#pragma unroll
                        for (int i = 0; i < 8; ++i) { const float s = __builtin_amdgcn_rcpf(1.0f + __expf(-v[i])); v[i] = __logf(lb[i] + (1.0f - lb[i]) * s); }
                    } else if (seg == 3) {
#pragma unroll
                        for (int i = 0; i < 8; ++i) v[i] = v[i] * __builtin_amdgcn_rcpf(1.0f + __expf(-v[i]));
                    }
                    u32x4 w; w.x = cvt_pk_bf16(v[0], v[1]); w.y = cvt_pk_bf16(v[2], v[3]); w.z = cvt_pk_bf16(v[4], v[5]); w.w = cvt_pk_bf16(v[6], v[7]);
                    *(u32x4*)(O + (size_t)row * 2816 + col0) = w;
                }
        }
    }
};
struct EpiOut {
    static constexpr bool PERM = true, AFTER_DRAIN = false;
    const bf16_t* x; float* out; bf16_t* hb; float* part;
    __device__ __forceinline__ void operator()(const f32x4 (&acc)[2][2][4][2], const Unit& u, int wr, int wc, int fr, int fq) const {
        const int row0 = u.pm * BM + wr * 64 + fr;
#pragma unroll
        for (int ai = 0; ai < 2; ++ai)
#pragma unroll
            for (int m = 0; m < 4; ++m) {
                const int row = row0 + ai * HALF + m * 16; float ss = 0.f;
#pragma unroll
                for (int bj = 0; bj < 2; ++bj) {
                    const size_t off = (size_t)row * 1024 + u.pn * BM + bj * HALF + wc * 32 + 8 * fq;
                    const u32x4 xw = *(const u32x4*)(x + off);
                    f32x4 x0, x1;
                    x0[0] = __builtin_bit_cast(float, xw.x << 16); x0[1] = __builtin_bit_cast(float, xw.x & 0xffff0000u); x0[2] = __builtin_bit_cast(float, xw.y << 16); x0[3] = __builtin_bit_cast(float, xw.y & 0xffff0000u);
                    x1[0] = __builtin_bit_cast(float, xw.z << 16); x1[1] = __builtin_bit_cast(float, xw.z & 0xffff0000u); x1[2] = __builtin_bit_cast(float, xw.w << 16); x1[3] = __builtin_bit_cast(float, xw.w & 0xffff0000u);
                    const f32x4 h0 = x0 + acc[ai][bj][m][0], h1 = x1 + acc[ai][bj][m][1];
                    u32x4 w; w.x = cvt_pk_bf16(h0[0], h0[1]); w.y = cvt_pk_bf16(h0[2], h0[3]); w.z = cvt_pk_bf16(h1[0], h1[1]); w.w = cvt_pk_bf16(h1[2], h1[3]);
                    *(u32x4*)(hb + off) = w;
                    ss += ((h0[0] * h0[0] + h0[1] * h0[1]) + (h0[2] * h0[2] + h0[3] * h0[3])) + ((h1[0] * h1[0] + h1[1] * h1[1]) + (h1[2] * h1[2] + h1[3] * h1[3]));
                }
                ss += __shfl_xor(ss, 16); ss += __shfl_xor(ss, 32);
                if (fq == 0) part[(size_t)row * 16 + u.pn * 4 + wc] = ss;
            }
    }
};
struct EpiGU {
    static constexpr bool PERM = true, AFTER_DRAIN = false;
    bf16_t* O; const float* part; const LAS float* rsc; int rbase;
    __device__ __forceinline__ void operator()(const f32x4 (&acc)[2][2][4][2], const Unit& u, int wr, int wc, int fr, int fq) const {
        const int row0 = u.pm * BM + wr * 64 + fr;
#pragma unroll
        for (int ai = 0; ai < 2; ++ai)
#pragma unroll
            for (int m = 0; m < 4; ++m) {
                const int row = row0 + ai * HALF + m * 16;
                float rs;
                if (rsc) rs = rsc[row - rbase];
                else {
                    const f32x4* pp = (const f32x4*)(part + (size_t)row * 16);
                    const f32x4 p0 = pp[0], p1 = pp[1], p2 = pp[2], p3 = pp[3];
                    const float ssq = ((p0[0] + p0[1]) + (p0[2] + p0[3])) + ((p1[0] + p1[1]) + (p1[2] + p1[3])) + ((p2[0] + p2[1]) + (p2[2] + p2[3])) + ((p3[0] + p3[1]) + (p3[2] + p3[3]));
                    rs = __builtin_amdgcn_rsqf(ssq * (1.0f / 1024.0f) + 1e-6f);
                }
                float v[8];
#pragma unroll
                for (int n = 0; n < 2; ++n)
#pragma unroll
                    for (int i = 0; i < 4; ++i) { const float g = acc[ai][0][m][n][i] * rs, up = acc[ai][1][m][n][i] * rs; v[4 * n + i] = g * __builtin_amdgcn_rcpf(1.0f + __expf(-g)) * up; }
                u32x4 w; w.x = cvt_pk_bf16(v[0], v[1]); w.y = cvt_pk_bf16(v[2], v[3]); w.z = cvt_pk_bf16(v[4], v[5]); w.w = cvt_pk_bf16(v[6], v[7]);
                *(u32x4*)(O + (size_t)row * 2816 + u.pn * HALF + wc * 32 + 8 * fq) = w;
            }
    }
};
struct EpiDown {
    static constexpr bool PERM = true, AFTER_DRAIN = false;
    float* out; const bf16_t* hb;
    __device__ __forceinline__ void operator()(const f32x4 (&acc)[2][2][4][2], const Unit& u, int wr, int wc, int fr, int fq) const {
        const int row0 = u.pm * BM + wr * 64 + fr;
#pragma unroll
        for (int ai = 0; ai < 2; ++ai)
#pragma unroll
            for (int m = 0; m < 4; ++m) {
                const int row = row0 + ai * HALF + m * 16;
#pragma unroll
                for (int bj = 0; bj < 2; ++bj) {
                    const size_t off = (size_t)row * 1024 + u.pn * BM + bj * HALF + wc * 32 + 8 * fq;
                    const u32x4 hw = *(const u32x4*)(hb + off);
                    f32x4 h0, h1;
                    h0[0] = __builtin_bit_cast(float, hw.x << 16); h0[1] = __builtin_bit_cast(float, hw.x & 0xffff0000u); h0[2] = __builtin_bit_cast(float, hw.y << 16); h0[3] = __builtin_bit_cast(float, hw.y & 0xffff0000u);
                    h1[0] = __builtin_bit_cast(float, hw.z << 16); h1[1] = __builtin_bit_cast(float, hw.z & 0xffff0000u); h1[2] = __builtin_bit_cast(float, hw.w << 16); h1[3] = __builtin_bit_cast(float, hw.w & 0xffff0000u);
                    __builtin_nontemporal_store(h0 + acc[ai][bj][m][0], (f32x4*)(out + off));
                    __builtin_nontemporal_store(h1 + acc[ai][bj][m][1], (f32x4*)(out + off + 4));
                }
            }
    }
};
}

__device__ __forceinline__ void p0_transpose_item(const float* W, int K, int N, bf16* WT, const float* gain, int mode, LAS float* scr, int item, int lane) {
    const int nblk = N / 32, kb = item / nblk, nb = item % nblk, k0 = 64 * kb, n0 = 32 * nb;
#pragma unroll 8
    for (int i = 0; i < 32; ++i) { const int kk = 2 * i + (lane >> 5); scr[kk * 33 + (lane & 31)] = __builtin_nontemporal_load(W + (size_t)(k0 + kk) * N + n0 + (lane & 31)); }
    LDS_WAIT(); asm volatile("" ::: "memory");
    const int c = lane & 7;
    float g[8];
#pragma unroll
    for (int i = 0; i < 8; ++i) g[i] = gain ? gain[k0 + 8 * c + i] : 1.0f;
    const int rbase = (mode == 0) ? n0 : (256 * (n0 >> 7) + (n0 & 127) + (mode == 2 ? 128 : 0));
#pragma unroll
    for (int j = 0; j < 4; ++j) { const int n = (lane >> 3) + 8 * j; const LAS float* s = scr + (8 * c) * 33 + n;
        v4u o; o.x = pk2(s[0 * 33] * g[0], s[1 * 33] * g[1]); o.y = pk2(s[2 * 33] * g[2], s[3 * 33] * g[3]); o.z = pk2(s[4 * 33] * g[4], s[5 * 33] * g[5]); o.w = pk2(s[6 * 33] * g[6], s[7 * 33] * g[7]);
        *(GAS v4u*)(WT + (size_t)(rbase + n) * K + k0 + 8 * c) = o; }
    LDS_WAIT(); asm volatile("" ::: "memory");
}
__device__ __forceinline__ void p0_weights_late(Frame& F, int first_block, int which) {
    int wv = threadIdx.x >> 6, ln = threadIdx.x & 63;
    asm volatile("" : "+v"(wv), "+v"(ln));
    wv = __builtin_amdgcn_readfirstlane(wv);
    LAS float* scr = (LAS float*)(F.lds + wv * 16384);
    const int gw = (blockIdx.x - first_block) * NWAVES + wv, NGW = (F.G - first_block) * NWAVES;
    constexpr int I_OUT = (D / 64) * (D / 32), I_G = (D / 64) * (FF / 32), I_DN = (FF / 64) * (D / 32);
    if (which == 0) {
        for (int it = gw; it < I_OUT + 2 * I_G; it += NGW) {
            int r = it;
            if (r < I_OUT) { p0_transpose_item(F.w_out, D, D, F.WOUT, nullptr, 0, scr, r, ln); continue; } r -= I_OUT;
            if (r < I_G) { p0_transpose_item(F.w_gate, D, FF, F.WGU, F.g2, 1, scr, r, ln); continue; } r -= I_G;
            p0_transpose_item(F.w_up, D, FF, F.WGU, F.g2, 2, scr, r, ln);
        }
    } else {
        for (int it = gw; it < I_DN; it += NGW) p0_transpose_item(F.w_down, FF, D, F.WDN, nullptr, 0, scr, it, ln);
    }
}
__device__ __forceinline__ void p0_prologue(Frame& F) {
    LAS float* scr = (LAS float*)(F.lds + F.wave * 16384);
    const int gw = blockIdx.x * NWAVES + F.wave, NGW = F.G * NWAVES;
    constexpr int I_IN = (D / 64) * (PW / 32);
    for (int it = gw; it < I_IN; it += NGW) p0_transpose_item(F.w_in, D, PW, F.WIN, F.g1, 0, scr, it, F.lane);
    for (int m = gw; m < M; m += NGW) {
        const GAS f32x4* xr = (const GAS f32x4*)(F.x + (size_t)m * D) + F.lane;
        f32x4 v[4]; float s = 0.f;
#pragma unroll
        for (int j = 0; j < 4; ++j) { v[j] = __builtin_nontemporal_load(xr + 64 * j); s += (v[j].x * v[j].x + v[j].y * v[j].y) + (v[j].z * v[j].z + v[j].w * v[j].w); }
        s = wave_sum(s);
        if (F.lane == 0) F.RSTD1[m] = 1.0f / sqrtf(s * (1.0f / D) + EPS);
        GAS unsigned long long* o8 = (GAS unsigned long long*)(F.XB + (size_t)m * D) + F.lane;
#pragma unroll
        for (int j = 0; j < 4; ++j) o8[64 * j] = (unsigned long long)pk2(v[j].x, v[j].y) | ((unsigned long long)pk2(v[j].z, v[j].w) << 32);
    }
}

#define XB_TMO      128
#define XB_XCNT(j)  (256  + 64 * (j))
#define XB_XSUB(j)  (1280 + 64 * (j))
#define XB_XGEN(j)  (2304 + 64 * (j))
#define XB_TOP      3328
#define XB_TOPGEN   3392
#define XCD_BAR_WORDS 3456
#define XB_SPIN_CAP (1u << 18)

__device__ __forceinline__ unsigned xb_ld(unsigned* p)              { return __hip_atomic_load(p, __ATOMIC_RELAXED, __HIP_MEMORY_SCOPE_AGENT); }
__device__ __forceinline__ unsigned xb_add(unsigned* p, unsigned v) { return __hip_atomic_fetch_add(p, v, __ATOMIC_RELAXED, __HIP_MEMORY_SCOPE_AGENT); }
__device__ __forceinline__ unsigned xb_xcc_id() { return (unsigned)__builtin_amdgcn_s_getreg((3 << 11) | 20) & 0xFu; }
#define XB_SPIN(cond, bar) do { unsigned _sp = 0; while (cond) { __builtin_amdgcn_s_sleep(1); \
    if ((++_sp & 255u) == 0u) { if (xb_ld(&(bar)[XB_TMO])) break; if (_sp > XB_SPIN_CAP) { atomicAdd(&(bar)[XB_TMO], 1u); break; } } } } while (0)

struct XcdBarrier {
    unsigned* bar; unsigned x;
    volatile LAS unsigned* st;
};

__device__ __forceinline__ XcdBarrier xcd_barrier_post(unsigned* bar, volatile LAS unsigned* st) {
    XcdBarrier b; b.bar = bar; b.x = xb_xcc_id(); b.st = st;
    if (threadIdx.x == 0) (void)xb_add(&bar[XB_XCNT(b.x)], 1u);
    return b;
}
__device__ __forceinline__ void xcd_barrier_complete(unsigned* bar, unsigned x, unsigned& nloc, unsigned& nx) {
    const unsigned G = gridDim.x * gridDim.y * gridDim.z;
    unsigned sum, cnt, mine, sp = 0u;
    for (;;) {
        sum = 0u; cnt = 0u; mine = 0u;
#pragma unroll
        for (unsigned j = 0; j < 16; ++j) { const unsigned c = xb_ld(&bar[XB_XCNT(j)]); sum += c; cnt += (c > 0u) ? 1u : 0u; mine = (j == x) ? c : mine; }
        if (sum == G) break;
        __builtin_amdgcn_s_sleep(1);
        if ((++sp & 255u) == 0u) { if (xb_ld(&bar[XB_TMO])) break; if (sp > XB_SPIN_CAP) { atomicAdd(&bar[XB_TMO], 1u); break; } }
    }
    nloc = mine > 0u ? mine : 1u; nx = cnt > 0u ? cnt : 1u;
}

__device__ __forceinline__ void xcd_barrier(const XcdBarrier& b) {
    asm volatile("s_waitcnt vmcnt(0)" ::: "memory");
    __syncthreads();
    if (threadIdx.x == 0) {
        unsigned* bar = b.bar;
        __builtin_amdgcn_s_waitcnt(0);
        unsigned nloc = b.st[0], nx = b.st[1];
        if (nloc == 0u) { xcd_barrier_complete(bar, b.x, nloc, nx); b.st[0] = nloc; b.st[1] = nx; }
        const unsigned old = xb_add(&bar[XB_XSUB(b.x)], 1u);
        const unsigned gen = old / nloc;
        if (old + 1u == (gen + 1u) * nloc) {
            __builtin_amdgcn_fence(__ATOMIC_RELEASE, "agent");
            asm volatile("s_waitcnt vmcnt(0)" ::: "memory");
            const unsigned og = xb_add(&bar[XB_TOP], 1u);
            const unsigned tg = og / nx;
            if (og + 1u == (tg + 1u) * nx) xb_add(&bar[XB_TOPGEN], 1u);
            else XB_SPIN(xb_ld(&bar[XB_TOPGEN]) == tg, bar);
            __builtin_amdgcn_fence(__ATOMIC_ACQUIRE, "agent");
            xb_add(&bar[XB_XGEN(b.x)], 1u);
            asm volatile("s_waitcnt vmcnt(0)" ::: "memory");
        } else {
            XB_SPIN(xb_ld(&bar[XB_XGEN(b.x)]) == gen, bar);
            __builtin_amdgcn_fence(__ATOMIC_ACQUIRE, "agent");
            asm volatile("s_waitcnt vmcnt(0)" ::: "memory");
        }
    }
    __syncthreads();
}
#define NAIVE_ATTN 0
#define NAIVE_HGRN 0

__device__ __forceinline__ void hgrn_naive(Frame& F) {
    if (blockIdx.x >= 64 || F.wave != 0) return;
    const int item = blockIdx.x; const int b = item >> 3, h = (item >> 1) & 3, v = (item & 1) * 64 + F.lane;
    float S[128];
#pragma unroll
    for (int c = 0; c < 128; ++c) S[c] = 0.f;
    for (int t = 0; t < SEQ; ++t) {
        const size_t row = (size_t)b * SEQ + t; const bf16* pr = F.PROJ + row * PW;
        const float vv = bf2f(pr[C_I + h * 128 + v]);
        float o = 0.f;
#pragma unroll
        for (int c8 = 0; c8 < 16; ++c8) {
            const v4u qw = *(const v4u*)(pr + C_Q + h * 128 + c8 * 8); const v4u fw = *(const v4u*)(pr + C_F + h * 128 + c8 * 8);
#pragma unroll
            for (int i = 0; i < 4; ++i) {
                const float q0 = bflo(qw[i]), q1 = bfhi(qw[i]); const float f0 = __expf(bflo(fw[i])), f1 = __expf(bfhi(fw[i]));
                S[c8 * 8 + 2 * i] = f0 * S[c8 * 8 + 2 * i] + (1.0f - f0) * vv; o += q0 * S[c8 * 8 + 2 * i];
                S[c8 * 8 + 2 * i + 1] = f1 * S[c8 * 8 + 2 * i + 1] + (1.0f - f1) * vv; o += q1 * S[c8 * 8 + 2 * i + 1];
            }
        }
        F.OLOC[row * 512 + h * 128 + v] = o;
    }
}
__device__ __forceinline__ void attn_naive(Frame& F) {
    for (int id = blockIdx.x * 512 + F.tid; id < NB * AH * SEQ; id += F.G * 512) {
        const int t = id & 2047, qh = (id >> 11) & 7, b = id >> 14, kvh = qh >> 2;
        const size_t row = (size_t)b * SEQ + t;
        float q[64]; float ss = 0.f;
        { const bf16* qr = F.PROJ + row * PW + C_AQ + qh * 64;
#pragma unroll
          for (int d8 = 0; d8 < 8; ++d8) { const v4u w = *(const v4u*)(qr + d8 * 8);
#pragma unroll
              for (int i = 0; i < 4; ++i) { q[d8 * 8 + 2 * i] = bflo(w[i]); q[d8 * 8 + 2 * i + 1] = bfhi(w[i]); } }
#pragma unroll
          for (int d = 0; d < 64; ++d) ss += q[d] * q[d];
          const float rs = 1.0f / sqrtf(ss * (1.0f / 64.0f) + EPS);
#pragma unroll
          for (int d = 0; d < 64; ++d) q[d] = q[d] * rs * F.qg[d] * 0.125f * F.kg[d]; }
        float m = F.sinks[qh], l = 1.0f; float acc[64];
#pragma unroll
        for (int d = 0; d < 64; ++d) acc[d] = 0.f;
        const int k0 = t - 127 < 0 ? 0 : t - 127;
        for (int kp = k0; kp <= t; ++kp) {
            const bf16* kr = F.PROJ + ((size_t)b * SEQ + kp) * PW + C_AK + kvh * 64;
            float kss = 0.f, dot = 0.f;
#pragma unroll
            for (int d8 = 0; d8 < 8; ++d8) { const v4u w = *(const v4u*)(kr + d8 * 8);
#pragma unroll
                for (int i = 0; i < 4; ++i) { const float a = bflo(w[i]), c = bfhi(w[i]); kss += a * a + c * c; dot += q[d8 * 8 + 2 * i] * a + q[d8 * 8 + 2 * i + 1] * c; } }
            const float s = dot / sqrtf(kss * (1.0f / 64.0f) + EPS);
            const float mn = fmaxf(m, s), sc = __expf(m - mn), p = __expf(s - mn);
            l = l * sc + p; m = mn;
            const bf16* vr = F.PROJ + ((size_t)b * SEQ + kp) * PW + C_AV + kvh * 64;
#pragma unroll
            for (int d8 = 0; d8 < 8; ++d8) { const v4u w = *(const v4u*)(vr + d8 * 8);
#pragma unroll
                for (int i = 0; i < 4; ++i) { acc[d8 * 8 + 2 * i] = acc[d8 * 8 + 2 * i] * sc + p * bflo(w[i]); acc[d8 * 8 + 2 * i + 1] = acc[d8 * 8 + 2 * i + 1] * sc + p * bfhi(w[i]); } }
        }
        const float il = 1.0f / l;
        bf16* orow = F.MIXED + row * D + 512 + qh * 64;
#pragma unroll
        for (int d8 = 0; d8 < 8; ++d8) { v4u w;
#pragma unroll
            for (int i = 0; i < 4; ++i) w[i] = pk2(acc[d8 * 8 + 2 * i] * il, acc[d8 * 8 + 2 * i + 1] * il);
            *(v4u*)(orow + d8 * 8) = w; }
    }
}
__device__ __forceinline__ void hgrn_norm_naive(Frame& F) {
    const int gw = blockIdx.x * NWAVES + F.wave, NGW = F.G * NWAVES;
    for (int it = gw; it < M * 4; it += NGW) {
        const int row = it >> 2, h = it & 3;
        const float* o = F.OLOC + (size_t)row * 512 + h * 128;
        const float a = o[F.lane], c = o[64 + F.lane];
        const float ss = wave_sum(a * a + c * c); const float rs = 1.0f / sqrtf(ss * (1.0f / 128.0f) + EPS);
        const bf16* gr = F.PROJ + (size_t)row * PW + C_G + h * 128;
        bf16* mr = F.MIXED + (size_t)row * D + h * 128;
        mr[F.lane] = (bf16)f2bf(a * rs * F.ogain[F.lane] * bf2f(gr[F.lane]));
        mr[64 + F.lane] = (bf16)f2bf(c * rs * F.ogain[64 + F.lane] * bf2f(gr[64 + F.lane]));
    }
}

#ifndef PROBE_DUP
#define PROBE_DUP 0
#endif
#ifndef HGRN_WS
#define HGRN_WS 1
#endif
__device__ __forceinline__ bf16x8 pack8(const f32x4 a, const f32x4 b) {
    v4u w; w.x = pg8::cvt_pk_native(a[0], a[1]); w.y = pg8::cvt_pk_native(a[2], a[3]); w.z = pg8::cvt_pk_native(b[0], b[1]); w.w = pg8::cvt_pk_native(b[2], b[3]);
    return __builtin_bit_cast(bf16x8, w);
}
__device__ __forceinline__ bf16x8 join8(const v2u lo, const v2u hi) { v4u w; w.x = lo.x; w.y = lo.y; w.z = hi.x; w.w = hi.y; return __builtin_bit_cast(bf16x8, w); }
#define MFMA16(a, b, c) __builtin_amdgcn_mfma_f32_16x16x32_bf16((a), (b), (c), 0, 0, 0)
#define LDS_BARRIER() do { asm volatile("s_waitcnt lgkmcnt(0)" ::: "memory"); __builtin_amdgcn_s_barrier(); asm volatile("" ::: "memory"); } while (0)

constexpr int KS_STRIDE = 72, VT2_STRIDE = 264;
constexpr int AT_KS = 0, AT_VT = 256 * KS_STRIDE * 2;
__device__ __forceinline__ void attn_item(Frame& F, int item) {
    const int b = item >> 5, kvh = (item >> 4) & 1, qb = item & 15, p0 = qb * 128;
    const int tid = F.tid, lane = F.lane, w = F.wave, quad = lane >> 4, l15 = lane & 15;
    LAS bf16* Ks = (LAS bf16*)(F.lds + AT_KS); LAS bf16* Vt = (LAS bf16*)(F.lds + AT_VT);
    const size_t row = (size_t)b * SEQ + p0 + 16 * w + l15;
    {
        const int key = tid >> 1, half = tid & 1, pos = p0 - 128 + key;
        v4u kw[4], vw[4];
        if (pos >= 0) {
            const v4u* kr = (const v4u*)(F.PROJ + ((size_t)b * SEQ + pos) * PW + C_AK + kvh * 64 + half * 32);
            const v4u* vr = (const v4u*)(F.PROJ + ((size_t)b * SEQ + pos) * PW + C_AV + kvh * 64 + half * 32);
#pragma unroll
            for (int i = 0; i < 4; ++i) { kw[i] = kr[i]; vw[i] = vr[i]; }
        } else {
#pragma unroll
            for (int i = 0; i < 4; ++i) { kw[i] = (v4u){0u, 0u, 0u, 0u}; vw[i] = (v4u){0u, 0u, 0u, 0u}; }
        }
        float ss = 0.f;
#pragma unroll
        for (int i = 0; i < 4; ++i)
#pragma unroll
            for (int j = 0; j < 4; ++j) { const float a = bflo(kw[i][j]), c = bfhi(kw[i][j]); ss += a * a + c * c; }
        ss += __shfl_xor(ss, 1);
        const float rs = __builtin_amdgcn_rsqf(ss * (1.0f / 64.0f) + EPS);
#pragma unroll
        for (int i = 0; i < 4; ++i) {
            const f32x4 g0 = *(const f32x4*)(F.kg + half * 32 + 8 * i), g1 = *(const f32x4*)(F.kg + half * 32 + 8 * i + 4);
            v4u o;
            o.x = pk2(bflo(kw[i][0]) * rs * g0[0], bfhi(kw[i][0]) * rs * g0[1]); o.y = pk2(bflo(kw[i][1]) * rs * g0[2], bfhi(kw[i][1]) * rs * g0[3]);
            o.z = pk2(bflo(kw[i][2]) * rs * g1[0], bfhi(kw[i][2]) * rs * g1[1]); o.w = pk2(bflo(kw[i][3]) * rs * g1[2], bfhi(kw[i][3]) * rs * g1[3]);
            *(LAS v4u*)(Ks + key * KS_STRIDE + half * 32 + 8 * i) = o;
#pragma unroll
            for (int j = 0; j < 4; ++j) {
                Vt[(half * 32 + 8 * i + 2 * j) * VT2_STRIDE + key] = (bf16)(vw[i][j] & 0xffffu);
                Vt[(half * 32 + 8 * i + 2 * j + 1) * VT2_STRIDE + key] = (bf16)(vw[i][j] >> 16);
            }
        }
    }
    __syncthreads();
    bf16x8 kf[9][2];
#pragma unroll
    for (int kt = 0; kt < 9; ++kt)
#pragma unroll
        for (int ks = 0; ks < 2; ++ks) kf[kt][ks] = *(const LAS bf16x8*)(Ks + (16 * w + 16 * kt + l15) * KS_STRIDE + 32 * ks + 8 * quad);
    const float NEG = -1e30f;
    for (int g = 0; g < AG; ++g) {
        const int qh = kvh * AG + g;
        bf16x8 bq[2];
        {
            v4u qw[2]; float ss = 0.f;
#pragma unroll
            for (int ks = 0; ks < 2; ++ks) { qw[ks] = *(const v4u*)(F.PROJ + row * PW + C_AQ + qh * 64 + 32 * ks + 8 * quad);
#pragma unroll
                for (int j = 0; j < 4; ++j) { const float a = bflo(qw[ks][j]), c = bfhi(qw[ks][j]); ss += a * a + c * c; } }
            ss += __shfl_xor(ss, 16); ss += __shfl_xor(ss, 32);
            const float rs = 0.125f * __builtin_amdgcn_rsqf(ss * (1.0f / 64.0f) + EPS);
#pragma unroll
            for (int ks = 0; ks < 2; ++ks) {
                const f32x4 g0 = *(const f32x4*)(F.qg + 32 * ks + 8 * quad), g1 = *(const f32x4*)(F.qg + 32 * ks + 8 * quad + 4);
                v4u o;
                o.x = pk2(bflo(qw[ks][0]) * rs * g0[0], bfhi(qw[ks][0]) * rs * g0[1]); o.y = pk2(bflo(qw[ks][1]) * rs * g0[2], bfhi(qw[ks][1]) * rs * g0[3]);
                o.z = pk2(bflo(qw[ks][2]) * rs * g1[0], bfhi(qw[ks][2]) * rs * g1[1]); o.w = pk2(bflo(qw[ks][3]) * rs * g1[2], bfhi(qw[ks][3]) * rs * g1[3]);
                bq[ks] = __builtin_bit_cast(bf16x8, o);
            }
        }
        f32x4 sc[9];
#pragma unroll
        for (int kt = 0; kt < 9; ++kt) { sc[kt] = (f32x4){0.f, 0.f, 0.f, 0.f};
#pragma unroll
            for (int ks = 0; ks < 2; ++ks) sc[kt] = MFMA16(kf[kt][ks], bq[ks], sc[kt]); }
#pragma unroll
        for (int r = 0; r < 4; ++r) { if (!(l15 < 4 * quad + r)) sc[0][r] = NEG; if (!(l15 >= 4 * quad + r)) sc[8][r] = NEG; }
        if (qb == 0) {
#pragma unroll
            for (int kt = 0; kt < 9; ++kt)
#pragma unroll
                for (int r = 0; r < 4; ++r) if (16 * w + 16 * kt + 4 * quad + r < 128) sc[kt][r] = NEG;
        }
        const float sink = F.sinks[qh];
        float m = sink;
#pragma unroll
        for (int kt = 0; kt < 9; ++kt)
#pragma unroll
            for (int r = 0; r < 4; ++r) m = fmaxf(m, sc[kt][r]);
        m = fmaxf(m, __shfl_xor(m, 16)); m = fmaxf(m, __shfl_xor(m, 32));
        float l = 0.f;
#pragma unroll
        for (int kt = 0; kt < 9; ++kt)
#pragma unroll
            for (int r = 0; r < 4; ++r) { const float p = __expf(sc[kt][r] - m); sc[kt][r] = p; l += p; }
        l += __shfl_xor(l, 16); l += __shfl_xor(l, 32);
        l += __expf(sink - m);
        const float il = __builtin_amdgcn_rcpf(l);
        bf16x8 pf[5];
#pragma unroll
        for (int kk = 0; kk < 4; ++kk) pf[kk] = pack8(sc[2 * kk], sc[2 * kk + 1]);
        pf[4] = pack8(sc[8], (f32x4){0.f, 0.f, 0.f, 0.f});
#pragma unroll
        for (int dt = 0; dt < 4; ++dt) {
            f32x4 o = (f32x4){0.f, 0.f, 0.f, 0.f};
            const LAS bf16* vrow = Vt + (16 * dt + l15) * VT2_STRIDE + 16 * w + 4 * quad;
#pragma unroll
            for (int kk = 0; kk < 5; ++kk) {
                const v2u lo = *(const LAS v2u*)(vrow + 32 * kk);
                v2u hi = (v2u){0u, 0u}; if (kk < 4) hi = *(const LAS v2u*)(vrow + 32 * kk + 16);
                o = MFMA16(join8(lo, hi), pf[kk], o);
            }
            v2u ow; ow.x = pk2(o[0] * il, o[1] * il); ow.y = pk2(o[2] * il, o[3] * il);
            *(v2u*)(F.MIXED + row * D + 512 + qh * 64 + 16 * dt + 4 * quad) = ow;
        }
    }
    __syncthreads();
}

constexpr int QD_STRIDE = 136, KT_STRIDE = 40;
#define QDOFF(t) ((t) * QD_STRIDE + ((t) >> 3) * 16)
#define VTOFF(v) ((v) * KT_STRIDE + ((v) >> 3) * 32)
constexpr int HB_QD = 0, HB_KH = 8832, HB_KDT = 17664, HB_VT = 27904, HB_DEC = 39104, HB_BYTES = 39616;
static_assert(31 * QD_STRIDE + 3 * 16 + 128 <= (HB_KH - HB_QD) / 2 && 127 * KT_STRIDE + 15 * 32 + 32 <= (HB_DEC - HB_VT) / 2 && 128 * KT_STRIDE * 2 <= HB_VT - HB_KDT && 2 * HB_BYTES <= 131072, "HGRN LDS map");
__device__ __forceinline__ void hgrn_local(Frame& F, int item) {
    const int b = item >> 5, h = (item >> 3) & 3, seg = item & 7;
    const int tid = F.tid, lane = F.lane, w = F.wave, quad = lane >> 4, l15 = lane & 15;
    const int c = tid >> 2, part = tid & 3;
    const int vt_t = tid & 31, vt_v8 = tid >> 5;
    const size_t row0 = (size_t)b * SEQ + seg * 256;
    const bf16* pq = F.PROJ + row0 * PW + C_Q + h * 128 + c;
    const bf16* pf = F.PROJ + row0 * PW + C_F + h * 128 + c;
    const bf16* pv = F.PROJ + row0 * PW + C_I + h * 128 + vt_v8 * 8;
    f32x4 S[8];
#pragma unroll
    for (int i = 0; i < 8; ++i) S[i] = (f32x4){0.f, 0.f, 0.f, 0.f};
    float Bprev = 0.f;
    bf16 rq[8], rf[8]; v4u rv;
#define HG_LOAD_RAW(ch) do { _Pragma("unroll") for (int j = 0; j < 8; ++j) { const size_t t_ = (size_t)((ch) * 32 + 8 * part + j); rq[j] = pq[t_ * PW]; rf[j] = pf[t_ * PW]; } \
        rv = *(const v4u*)(pv + (size_t)((ch) * 32 + vt_t) * PW); } while (0)
#define HG_ELEM(ch) do { \
        LAS unsigned char* bb_ = F.lds + ((ch) & 1) * HB_BYTES; \
        LAS bf16* QD_ = (LAS bf16*)(bb_ + HB_QD); LAS bf16* KH_ = (LAS bf16*)(bb_ + HB_KH); LAS bf16* KDT_ = (LAS bf16*)(bb_ + HB_KDT); LAS bf16* VT_ = (LAS bf16*)(bb_ + HB_VT); LAS float* DEC_ = (LAS float*)(bb_ + HB_DEC); \
        float lf_[8], bl_[8]; float run_ = 0.f; \
        _Pragma("unroll") for (int j = 0; j < 8; ++j) { lf_[j] = bf2f(rf[j]); run_ += lf_[j]; bl_[j] = run_; } \
        const int b4_ = lane & ~3; \
        const float t0_ = __shfl(run_, b4_), t1_ = __shfl(run_, b4_ + 1), t2_ = __shfl(run_, b4_ + 2), t3_ = __shfl(run_, b4_ + 3); \
        const float pre_ = (part > 0 ? t0_ : 0.f) + (part > 1 ? t1_ : 0.f) + (part > 2 ? t2_ : 0.f); \
        const float btot_ = (t0_ + t1_) + (t2_ + t3_); \
        const float eprev_ = __expf(Bprev); \
        float kd_[8]; const float ebtot_ = __expf(btot_); float eip_ = __builtin_amdgcn_rcpf(__expf(pre_)); \
        _Pragma("unroll") for (int j = 0; j < 8; ++j) { const int t_ = 8 * part + j; const float bt_ = pre_ + bl_[j]; \
            const float e_ = __expf(bt_), ei_ = __builtin_amdgcn_rcpf(e_); \
            const float k_ = 1.0f - e_ * eip_; eip_ = ei_; const float qd_ = bf2f(rq[j]) * e_; const float kh_ = k_ * ei_; \
            const unsigned pw_ = pg8::cvt_pk_native(qd_, kh_); \
            QD_[QDOFF(t_) + c] = (bf16)(pw_ & 0xffffu); KH_[QDOFF(t_) + c] = (bf16)(pw_ >> 16); kd_[j] = kh_ * ebtot_; \
            F.QDS[(row0 + (size_t)((ch) * 32 + t_)) * 512 + h * 128 + c] = (bf16)f2bf(qd_ * eprev_); } \
        { v4u o_; o_.x = pk2(kd_[0], kd_[1]); o_.y = pk2(kd_[2], kd_[3]); o_.z = pk2(kd_[4], kd_[5]); o_.w = pk2(kd_[6], kd_[7]); *(LAS v4u*)(KDT_ + c * KT_STRIDE + 8 * part) = o_; } \
        if (part == 0) DEC_[c] = ebtot_; \
        Bprev += btot_; \
        _Pragma("unroll") for (int i = 0; i < 4; ++i) { VT_[VTOFF(8 * vt_v8 + 2 * i) + vt_t] = (bf16)(rv[i] & 0xffffu); VT_[VTOFF(8 * vt_v8 + 2 * i + 1) + vt_t] = (bf16)(rv[i] >> 16); } \
    } while (0)

    HG_LOAD_RAW(0);
    HG_ELEM(0);
    HG_LOAD_RAW(1);
    LDS_BARRIER();
    for (int ch = 0; ch < 8; ++ch) {
        if (ch + 1 < 8) { HG_ELEM(ch + 1); if (ch + 2 < 8) HG_LOAD_RAW(ch + 2); }
        const LAS unsigned char* bb = F.lds + (ch & 1) * HB_BYTES;
        const LAS bf16* QD = (const LAS bf16*)(bb + HB_QD); const LAS bf16* KH = (const LAS bf16*)(bb + HB_KH); const LAS bf16* KDT = (const LAS bf16*)(bb + HB_KDT);
        const LAS bf16* VT = (const LAS bf16*)(bb + HB_VT); const LAS float* DEC = (const LAS float*)(bb + HB_DEC);
        f32x4 T00 = (f32x4){0.f, 0.f, 0.f, 0.f}, T01 = T00, T11 = T00;
#pragma unroll
        for (int kk = 0; kk < 4; ++kk) {
            const bf16x8 kh0 = *(const LAS bf16x8*)(KH + QDOFF(l15) + 32 * kk + 8 * quad), kh1 = *(const LAS bf16x8*)(KH + QDOFF(16 + l15) + 32 * kk + 8 * quad);
            const bf16x8 q0 = *(const LAS bf16x8*)(QD + QDOFF(l15) + 32 * kk + 8 * quad), q1 = *(const LAS bf16x8*)(QD + QDOFF(16 + l15) + 32 * kk + 8 * quad);
            T00 = MFMA16(kh0, q0, T00); T01 = MFMA16(kh0, q1, T01); T11 = MFMA16(kh1, q1, T11);
        }
#pragma unroll
        for (int r = 0; r < 4; ++r) { if (4 * quad + r > l15) { T00[r] = 0.f; T11[r] = 0.f; } }
        const bf16x8 a0 = pack8(T00, (f32x4){0.f, 0.f, 0.f, 0.f}), a1 = pack8(T01, T11);
        const LAS bf16* vrow = VT + VTOFF(16 * w + l15);
        const bf16x8 bv = join8(*(const LAS v2u*)(vrow + 4 * quad), *(const LAS v2u*)(vrow + 16 + 4 * quad));
        f32x4 O0 = (f32x4){0.f, 0.f, 0.f, 0.f}, O1 = O0;
#pragma unroll
        for (int kk = 0; kk < 4; ++kk) {
            const bf16x8 aq0 = join8(*(const LAS v2u*)(QD + QDOFF(l15) + 32 * kk + 4 * quad), *(const LAS v2u*)(QD + QDOFF(l15) + 32 * kk + 16 + 4 * quad));
            const bf16x8 aq1 = join8(*(const LAS v2u*)(QD + QDOFF(16 + l15) + 32 * kk + 4 * quad), *(const LAS v2u*)(QD + QDOFF(16 + l15) + 32 * kk + 16 + 4 * quad));
            const bf16x8 bs = pack8(S[2 * kk], S[2 * kk + 1]);
            O0 = MFMA16(aq0, bs, O0); O1 = MFMA16(aq1, bs, O1);
        }
        O0 = MFMA16(a0, bv, O0); O1 = MFMA16(a1, bv, O1);
        {
            float* op = F.OLOC + (row0 + (size_t)(ch * 32 + 4 * quad)) * 512 + h * 128 + 16 * w + l15;
#pragma unroll
            for (int r = 0; r < 4; ++r) { op[(size_t)r * 512] = O0[r]; op[(size_t)(16 + r) * 512] = O1[r]; }
        }
        const bf16x8 bvn = *(const LAS bf16x8*)(vrow + 8 * quad);
#pragma unroll
        for (int tc = 0; tc < 8; ++tc) {
            const f32x4 dec = *(const LAS f32x4*)(DEC + 16 * tc + 4 * quad);
            S[tc] = S[tc] * dec;
            const bf16x8 ak = *(const LAS bf16x8*)(KDT + (16 * tc + l15) * KT_STRIDE + 8 * quad);
            S[tc] = MFMA16(ak, bvn, S[tc]);
        }
        LDS_BARRIER();
    }
#undef HG_LOAD_RAW
#undef HG_ELEM
    {
        f32x4* Lp = (f32x4*)F.LBUF + (size_t)(item * 8 + w) * 8 * 64 + lane;
#pragma unroll
        for (int tc = 0; tc < 8; ++tc) {
            const f32x4 val = S[tc] + 0.0f;
            asm volatile("global_store_dwordx4 %0, %1, off sc0 sc1\n\ts_nop 1" :: "v"(Lp + tc * 64), "v"(val) : "memory");
        }
        if (part == 0) { const float val = __expf(Bprev); asm volatile("global_store_dword %0, %1, off sc0 sc1" :: "v"(F.DTOT + item * 128 + c), "v"(val) : "memory"); }
    }
}
__device__ __forceinline__ void hgrn_local_ws2(Frame& F, int item) {
    const int b = item >> 5, h = (item >> 3) & 3, seg = item & 7;
    const int tid = F.tid, lane = F.lane, w = F.wave, quad = lane >> 4, l15 = lane & 15;
    const int c = tid >> 2, part = tid & 3;
    const int vt_t = tid & 31, vt_v8 = tid >> 5;
    const size_t row0 = (size_t)b * SEQ + seg * 256;
    const bf16* pq = F.PROJ + row0 * PW + C_Q + h * 128 + c;
    const bf16* pf = F.PROJ + row0 * PW + C_F + h * 128 + c;
    const bf16* pv = F.PROJ + row0 * PW + C_I + h * 128 + vt_v8 * 8;
    f32x4 S[2][8];
#pragma unroll
    for (int g = 0; g < 2; ++g)
#pragma unroll
        for (int i = 0; i < 8; ++i) S[g][i] = (f32x4){0.f, 0.f, 0.f, 0.f};
    float Bprev = 0.f;
    bf16 rq[8], rf[8]; v4u rv;
#define HG_LOAD_RAW(ch) do { _Pragma("unroll") for (int j = 0; j < 8; ++j) { const size_t t_ = (size_t)((ch) * 32 + 8 * part + j); rq[j] = pq[t_ * PW]; rf[j] = pf[t_ * PW]; } \
        rv = *(const v4u*)(pv + (size_t)((ch) * 32 + vt_t) * PW); } while (0)
#define HG_ELEM(ch) do { \
        LAS unsigned char* bb_ = F.lds + ((ch) & 1) * HB_BYTES; \
        LAS bf16* QD_ = (LAS bf16*)(bb_ + HB_QD); LAS bf16* KH_ = (LAS bf16*)(bb_ + HB_KH); LAS bf16* KDT_ = (LAS bf16*)(bb_ + HB_KDT); LAS bf16* VT_ = (LAS bf16*)(bb_ + HB_VT); LAS float* DEC_ = (LAS float*)(bb_ + HB_DEC); \
        float lf_[8], bl_[8]; float run_ = 0.f; \
        _Pragma("unroll") for (int j = 0; j < 8; ++j) { lf_[j] = bf2f(rf[j]); run_ += lf_[j]; bl_[j] = run_; } \
        const int b4_ = lane & ~3; \
        const float t0_ = __shfl(run_, b4_), t1_ = __shfl(run_, b4_ + 1), t2_ = __shfl(run_, b4_ + 2), t3_ = __shfl(run_, b4_ + 3); \
        const float pre_ = (part > 0 ? t0_ : 0.f) + (part > 1 ? t1_ : 0.f) + (part > 2 ? t2_ : 0.f); \
        const float btot_ = (t0_ + t1_) + (t2_ + t3_); \
        const float eprev_ = __expf(Bprev); \
        float kd_[8]; const float ebtot_ = __expf(btot_); float eip_ = __builtin_amdgcn_rcpf(__expf(pre_)); \
        _Pragma("unroll") for (int j = 0; j < 8; ++j) { const int t_ = 8 * part + j; const float bt_ = pre_ + bl_[j]; \
            const float e_ = __expf(bt_), ei_ = __builtin_amdgcn_rcpf(e_); \
            const float k_ = 1.0f - e_ * eip_; eip_ = ei_; const float qd_ = bf2f(rq[j]) * e_; const float kh_ = k_ * ei_; \
            const unsigned pw_ = pg8::cvt_pk_native(qd_, kh_); \
            QD_[QDOFF(t_) + c] = (bf16)(pw_ & 0xffffu); KH_[QDOFF(t_) + c] = (bf16)(pw_ >> 16); kd_[j] = kh_ * ebtot_; \
            F.QDS[(row0 + (size_t)((ch) * 32 + t_)) * 512 + h * 128 + c] = (bf16)f2bf(qd_ * eprev_); } \
        { v4u o_; o_.x = pk2(kd_[0], kd_[1]); o_.y = pk2(kd_[2], kd_[3]); o_.z = pk2(kd_[4], kd_[5]); o_.w = pk2(kd_[6], kd_[7]); *(LAS v4u*)(KDT_ + c * KT_STRIDE + 8 * part) = o_; } \
        if (part == 0) DEC_[c] = ebtot_; \
        Bprev += btot_; \
        _Pragma("unroll") for (int i = 0; i < 4; ++i) { VT_[VTOFF(8 * vt_v8 + 2 * i) + vt_t] = (bf16)(rv[i] & 0xffffu); VT_[VTOFF(8 * vt_v8 + 2 * i + 1) + vt_t] = (bf16)(rv[i] >> 16); } \
    } while (0)

    HG_LOAD_RAW(0);
    HG_ELEM(0);
    HG_LOAD_RAW(1);
    LDS_BARRIER();
    for (int ch = 0; ch < 8; ++ch) {
        if (w >= 4) { if (ch + 1 < 8) { HG_ELEM(ch + 1); if (ch + 2 < 8) HG_LOAD_RAW(ch + 2); } }
        if (w < 4) {
            const LAS unsigned char* bb = F.lds + (ch & 1) * HB_BYTES;
            const LAS bf16* QD = (const LAS bf16*)(bb + HB_QD); const LAS bf16* KH = (const LAS bf16*)(bb + HB_KH); const LAS bf16* KDT = (const LAS bf16*)(bb + HB_KDT);
            const LAS bf16* VT = (const LAS bf16*)(bb + HB_VT); const LAS float* DEC = (const LAS float*)(bb + HB_DEC);
            f32x4 T00 = (f32x4){0.f, 0.f, 0.f, 0.f}, T01 = T00, T11 = T00;
#pragma unroll
            for (int kk = 0; kk < 4; ++kk) {
                const bf16x8 kh0 = *(const LAS bf16x8*)(KH + QDOFF(l15) + 32 * kk + 8 * quad), kh1 = *(const LAS bf16x8*)(KH + QDOFF(16 + l15) + 32 * kk + 8 * quad);
                const bf16x8 q0 = *(const LAS bf16x8*)(QD + QDOFF(l15) + 32 * kk + 8 * quad), q1 = *(const LAS bf16x8*)(QD + QDOFF(16 + l15) + 32 * kk + 8 * quad);
                T00 = MFMA16(kh0, q0, T00); T01 = MFMA16(kh0, q1, T01); T11 = MFMA16(kh1, q1, T11);
            }
#pragma unroll
            for (int r = 0; r < 4; ++r) { if (4 * quad + r > l15) { T00[r] = 0.f; T11[r] = 0.f; } }
            const bf16x8 a0 = pack8(T00, (f32x4){0.f, 0.f, 0.f, 0.f}), a1 = pack8(T01, T11);
            f32x4 O[2][2];
#pragma unroll
            for (int g = 0; g < 2; ++g) { O[g][0] = (f32x4){0.f, 0.f, 0.f, 0.f}; O[g][1] = O[g][0]; }
#pragma unroll
            for (int kk = 0; kk < 4; ++kk) {
                const bf16x8 aq0 = join8(*(const LAS v2u*)(QD + QDOFF(l15) + 32 * kk + 4 * quad), *(const LAS v2u*)(QD + QDOFF(l15) + 32 * kk + 16 + 4 * quad));
                const bf16x8 aq1 = join8(*(const LAS v2u*)(QD + QDOFF(16 + l15) + 32 * kk + 4 * quad), *(const LAS v2u*)(QD + QDOFF(16 + l15) + 32 * kk + 16 + 4 * quad));
#pragma unroll
                for (int g = 0; g < 2; ++g) { const bf16x8 bs = pack8(S[g][2 * kk], S[g][2 * kk + 1]); O[g][0] = MFMA16(aq0, bs, O[g][0]); O[g][1] = MFMA16(aq1, bs, O[g][1]); }
            }
#pragma unroll
            for (int g = 0; g < 2; ++g) {
                const LAS bf16* vrow = VT + VTOFF(32 * w + 16 * g + l15);
                const bf16x8 bv = join8(*(const LAS v2u*)(vrow + 4 * quad), *(const LAS v2u*)(vrow + 16 + 4 * quad));
                O[g][0] = MFMA16(a0, bv, O[g][0]); O[g][1] = MFMA16(a1, bv, O[g][1]);
                float* op = F.OLOC + (row0 + (size_t)(ch * 32 + 4 * quad)) * 512 + h * 128 + 32 * w + 16 * g + l15;
#pragma unroll
                for (int r = 0; r < 4; ++r) { op[(size_t)r * 512] = O[g][0][r]; op[(size_t)(16 + r) * 512] = O[g][1][r]; }
            }
            const bf16x8 bvn0 = *(const LAS bf16x8*)(VT + VTOFF(32 * w + l15) + 8 * quad), bvn1 = *(const LAS bf16x8*)(VT + VTOFF(32 * w + 16 + l15) + 8 * quad);
#pragma unroll
            for (int tc = 0; tc < 8; ++tc) {
                const f32x4 dec = *(const LAS f32x4*)(DEC + 16 * tc + 4 * quad);
                const bf16x8 ak = *(const LAS bf16x8*)(KDT + (16 * tc + l15) * KT_STRIDE + 8 * quad);
                S[0][tc] = S[0][tc] * dec; S[1][tc] = S[1][tc] * dec;
                S[0][tc] = MFMA16(ak, bvn0, S[0][tc]); S[1][tc] = MFMA16(ak, bvn1, S[1][tc]);
            }
            if (ch + 1 < 8) { HG_ELEM(ch + 1); if (ch + 2 < 8) HG_LOAD_RAW(ch + 2); }
        }
        LDS_BARRIER();
    }
#undef HG_LOAD_RAW
#undef HG_ELEM
    if (w < 4) {
#pragma unroll
        for (int g = 0; g < 2; ++g) {
            f32x4* Lp = (f32x4*)F.LBUF + (size_t)(item * 8 + 2 * w + g) * 8 * 64 + lane;
#pragma unroll
            for (int tc = 0; tc < 8; ++tc) {
                const f32x4 val = S[g][tc] + 0.0f;
                asm volatile("global_store_dwordx4 %0, %1, off sc0 sc1\n\ts_nop 1" :: "v"(Lp + tc * 64), "v"(val) : "memory");
            }
        }
    }
    if (part == 0) { const float val = __expf(Bprev); asm volatile("global_store_dword %0, %1, off sc0 sc1" :: "v"(F.DTOT + item * 128 + c), "v"(val) : "memory"); }
}
__device__ __forceinline__ void hgrn_publish(Frame& F, unsigned* cnt, int item) {
    asm volatile("s_waitcnt vmcnt(0)" ::: "memory");
    __syncthreads();
    if (F.tid == 0) __hip_atomic_fetch_add(cnt + 64 * (item >> 3), 1u, __ATOMIC_RELAXED, __HIP_MEMORY_SCOPE_AGENT);
}
__device__ __forceinline__ void hgrn_wait(Frame& F, unsigned* cnt, int item) {
    if (F.tid == 0) {
        unsigned sp = 0;
        while (__hip_atomic_load(cnt + 64 * (item >> 3), __ATOMIC_RELAXED, __HIP_MEMORY_SCOPE_AGENT) < 8u) { __builtin_amdgcn_s_sleep(2); if (++sp > (1u << 22)) break; }
        __builtin_amdgcn_fence(__ATOMIC_ACQUIRE, "agent");
        asm volatile("s_waitcnt vmcnt(0)" ::: "memory");
    }
    __syncthreads();
}

constexpr int ST_STRIDE = 136;
__device__ __forceinline__ void hgrn_correct(Frame& F, int item) {
    const int b = item >> 5, h = (item >> 3) & 3, seg = item & 7;
    const int lane = F.lane, w = F.wave, quad = lane >> 4, l15 = lane & 15;
    const size_t row0 = (size_t)b * SEQ + seg * 256;
    LAS bf16* ST = (LAS bf16*)F.lds;
    v4u qf[2][4];
    if (seg > 0) {
#pragma unroll
        for (int tt = 0; tt < 2; ++tt)
#pragma unroll
            for (int kk = 0; kk < 4; ++kk) qf[tt][kk] = *(const v4u*)(F.QDS + (row0 + 32 * w + 16 * tt + l15) * 512 + h * 128 + 32 * kk + 8 * quad);
    }
    if (seg > 0) {
        f32x4 S[8];
#pragma unroll
        for (int i = 0; i < 8; ++i) S[i] = (f32x4){0.f, 0.f, 0.f, 0.f};
        f32x4 Lc[8], Dc[8];
        {
            const int im = item - seg;
            const f32x4* Lp = (const f32x4*)F.LBUF + (size_t)(im * 8 + w) * 8 * 64 + lane; const float* Dp = F.DTOT + im * 128;
#pragma unroll
            for (int tc = 0; tc < 8; ++tc) { Dc[tc] = *(const f32x4*)(Dp + 16 * tc + 4 * quad); Lc[tc] = Lp[tc * 64]; }
        }
        for (int m = 0; m < seg; ++m) {
            f32x4 Ln[8], Dn[8];
            const int im = item - seg + (m + 1 < seg ? m + 1 : m);
            const f32x4* Lp = (const f32x4*)F.LBUF + (size_t)(im * 8 + w) * 8 * 64 + lane; const float* Dp = F.DTOT + im * 128;
#pragma unroll
            for (int tc = 0; tc < 8; ++tc) { Dn[tc] = *(const f32x4*)(Dp + 16 * tc + 4 * quad); Ln[tc] = Lp[tc * 64]; }
#pragma unroll
            for (int tc = 0; tc < 8; ++tc) { S[tc] = Dc[tc] * S[tc] + Lc[tc]; Lc[tc] = Ln[tc]; Dc[tc] = Dn[tc]; }
        }
#pragma unroll
        for (int tc = 0; tc < 8; ++tc) { v2u o; o.x = pg8::cvt_pk_native(S[tc][0], S[tc][1]); o.y = pg8::cvt_pk_native(S[tc][2], S[tc][3]);
            *(LAS v2u*)(ST + (16 * w + l15) * ST_STRIDE + 16 * tc + 4 * quad) = o; }
    }
    f32x4 OL[2][8]; v2u GW[2][8];
#pragma unroll
    for (int tt = 0; tt < 2; ++tt) {
        const size_t row = row0 + 32 * w + 16 * tt + l15;
#pragma unroll
        for (int vt = 0; vt < 8; ++vt) { OL[tt][vt] = *(const f32x4*)(F.OLOC + row * 512 + h * 128 + 4 * quad + 16 * vt); GW[tt][vt] = *(const v2u*)(F.PROJ + row * PW + C_G + h * 128 + 4 * quad + 16 * vt); }
    }
    __syncthreads();
    f32x4 O[8][2];
#pragma unroll
    for (int vt = 0; vt < 8; ++vt) { O[vt][0] = (f32x4){0.f, 0.f, 0.f, 0.f}; O[vt][1] = O[vt][0]; }
    if (seg > 0) {
#pragma unroll
        for (int vt = 0; vt < 8; ++vt)
#pragma unroll
            for (int kk = 0; kk < 4; ++kk) {
                const bf16x8 a = *(const LAS bf16x8*)(ST + (16 * vt + l15) * ST_STRIDE + 32 * kk + 8 * quad);
                O[vt][0] = MFMA16(a, __builtin_bit_cast(bf16x8, qf[0][kk]), O[vt][0]);
                O[vt][1] = MFMA16(a, __builtin_bit_cast(bf16x8, qf[1][kk]), O[vt][1]);
            }
    }
#pragma unroll
    for (int tt = 0; tt < 2; ++tt) {
        const size_t row = row0 + 32 * w + 16 * tt + l15;
        float ss = 0.f;
#pragma unroll
        for (int vt = 0; vt < 8; ++vt) { const f32x4 o = O[vt][tt] + OL[tt][vt]; O[vt][tt] = o; ss += (o[0] * o[0] + o[1] * o[1]) + (o[2] * o[2] + o[3] * o[3]); }
        ss += __shfl_xor(ss, 16); ss += __shfl_xor(ss, 32);
        const float rs = __builtin_amdgcn_rsqf(ss * (1.0f / 128.0f) + EPS);
        bf16* mp = F.MIXED + row * D + h * 128 + 4 * quad;
#pragma unroll
        for (int vt = 0; vt < 8; ++vt) {
            const v2u gw = GW[tt][vt];
            const f32x4 og = *(const f32x4*)(F.ogain + 16 * vt + 4 * quad);
            const f32x4 o = O[vt][tt];
            v2u ow; ow.x = pk2(o[0] * rs * og[0] * bflo(gw.x), o[1] * rs * og[1] * bfhi(gw.x)); ow.y = pk2(o[2] * rs * og[2] * bflo(gw.y), o[3] * rs * og[3] * bfhi(gw.y));
            *(v2u*)(mp + 16 * vt) = ow;
        }
    }
    __syncthreads();
}
__device__ __forceinline__ int mix_first_item(const Frame& F) { const int bx = blockIdx.x; return (F.G == 256) ? (bx & 7) * 32 + (bx >> 3) : bx; }
__device__ __forceinline__ void mix_phase_a(Frame& F, bool handoff, unsigned* cnt) {
#if !NAIVE_HGRN
    for (int it = mix_first_item(F); it < NB * HH * 8; it += F.G) {
#if HGRN_WS
        hgrn_local_ws2(F, it);
#else
        hgrn_local(F, it);
#endif
        if (handoff) hgrn_publish(F, cnt, it); }
    __syncthreads();
#else
    hgrn_naive(F); __syncthreads();
#endif
#if !NAIVE_ATTN
    for (int it = mix_first_item(F); it < NB * KVH * 16; it += F.G) attn_item(F, it);
#else
    attn_naive(F); __syncthreads();
#endif
}
__device__ __forceinline__ void mix_phase_b(Frame& F, bool handoff, unsigned* cnt) {
#if !NAIVE_HGRN
    for (int it = mix_first_item(F); it < NB * HH * 8; it += F.G) { if (handoff) hgrn_wait(F, cnt, it); hgrn_correct(F, it); }
#else
    hgrn_norm_naive(F);
#endif
}
#define MK_N_LAUNCHES 1
#define NAIVE_MIX 0

#ifndef MK_N_LAUNCHES
#define MK_N_LAUNCHES 1
#endif
#ifndef NAIVE_MIX
#define NAIVE_MIX 0
#endif
constexpr int N_PHASES = 7;
struct Args { const float* in[13]; float* out; unsigned char* ws; int ph_lo, ph_hi; };
template <bool COOP>
__global__ void __launch_bounds__(NWAVES * 64, 2) fwd(Args args) {
    extern __shared__ __attribute__((aligned(16))) unsigned char lds[];
    Frame F;
    F.lds = (LAS unsigned char*)lds;
    F.tid = threadIdx.x; F.lane = F.tid & 63; F.wave = __builtin_amdgcn_readfirstlane(F.tid >> 6); F.G = gridDim.x;
    unsigned char* ws = args.ws;
    F.x = args.in[0]; F.g1 = args.in[1]; F.w_in = args.in[2]; F.lbl = args.in[3]; F.ogain = args.in[4]; F.qg = args.in[5]; F.kg = args.in[6];
    F.sinks = args.in[7]; F.w_out = args.in[8]; F.g2 = args.in[9]; F.w_gate = args.in[10]; F.w_up = args.in[11]; F.w_down = args.in[12]; F.out = args.out;
    F.WIN = (bf16*)(ws + WS_WIN); F.WOUT = (bf16*)(ws + WS_WOUT); F.WGU = (bf16*)(ws + WS_WGU); F.WDN = (bf16*)(ws + WS_WDN);
    F.XB = (bf16*)(ws + WS_XB); F.PROJ = (bf16*)(ws + WS_PROJ); F.ACT = (bf16*)(ws + WS_ACT); F.MIXED = (bf16*)(ws + WS_MIXED); F.HB = (bf16*)(ws + WS_HB); F.QDS = (bf16*)(ws + WS_QDS);
    F.RSTD1 = (float*)(ws + WS_RSTD1); F.PART = (float*)(ws + WS_PART); F.DTOT = (float*)(ws + WS_DTOT); F.OLOC = (float*)(ws + WS_OLOC); F.LBUF = (float*)(ws + WS_LBUF);
    const int lo = args.ph_lo, hi = args.ph_hi;
#define IN(k) (lo <= (k) && (k) < hi)
#ifndef USE_CG_SYNC
#define USE_CG_SYNC 0
#endif
    XcdBarrier bar; bar.bar = (unsigned*)(ws + WS_CTL) + 4096; bar.x = 0; bar.st = nullptr;
    if constexpr (COOP) {
        for (int u = F.tid; u < (LDS_BYTES - 131072) / 4; u += NWAVES * 64) ((LAS unsigned*)(F.lds + 131072))[u] = 0u;
        __syncthreads();
        bar = xcd_barrier_post((unsigned*)(ws + WS_CTL) + 4096, (volatile LAS unsigned*)(F.lds + 131072 + 352));
    }
#define SEAM(k) do { if constexpr (COOP) { if (IN(k) && IN((k) + 1)) { if (USE_CG_SYNC) cg::this_grid().sync(); else xcd_barrier(bar); } } } while (0)

#ifndef PROBE_DUP
#define PROBE_DUP 0
#endif
#ifndef PROBE_SYNC
#define PROBE_SYNC 0
#endif
    const bool handoff23 = COOP && !NAIVE_MIX && !NAIVE_HGRN && (F.G == NB * HH * 8) && IN(2) && IN(3);
    unsigned* cnt23 = (unsigned*)(ws + WS_CTL) + 8192;
    if (IN(0)) { p0_prologue(F); if (PROBE_DUP & 1) { __syncthreads(); p0_prologue(F); } SEAM(0); if constexpr (COOP) { for (int i_ = 0; i_ < PROBE_SYNC; ++i_) xcd_barrier(bar); } }
    if (IN(1)) {
        pg8::Gemm g{F.XB, F.WIN, M, PW, D}; pg8::StaticOrder S; S.init(M, PW, F.G, (int)blockIdx.x);
        LAS float* rsc1 = (LAS float*)(F.lds + 131072 + 1024); const int rbase1 = (int)(blockIdx.x & 7) * 2048; const bool rs1_cached = (F.G == 256);
        if (rs1_cached) { for (int r = F.tid; r < 2048; r += NWAVES * 64) rsc1[r] = F.RSTD1[rbase1 + r]; __syncthreads(); }
        pg8::EpiProj E{F.PROJ, F.RSTD1, F.lbl, rs1_cached ? (const LAS float*)rsc1 : (const LAS float*)nullptr, rbase1};
        pg8::gemm_phase<pg8::EpiProj, pg8::StaticOrder, true, true>(F.lds, g, S, E);
        if (PROBE_DUP & 2) { __syncthreads(); pg8::gemm_phase<pg8::EpiProj, pg8::StaticOrder, true, true>(F.lds, g, S, E); }
        {
            const int nwg = (M / 256) * (PW / 256), rem = nwg % F.G;
            const int first_late = (rem == 0) ? 0 : rem;
            if ((int)blockIdx.x >= first_late) { __syncthreads(); p0_weights_late(F, first_late, 0); }
        }
        SEAM(1);
    }
    if (IN(2)) {
#if NAIVE_MIX
        attn_naive(F); hgrn_naive(F);
#else
        mix_phase_a(F, handoff23, cnt23);
#endif
        if (!handoff23) SEAM(2);
    }
    if (IN(3)) {
#if NAIVE_MIX
        hgrn_norm_naive(F);
#else
        mix_phase_b(F, handoff23, cnt23);
#endif

        SEAM(3);
    }
    if (IN(4)) {
        pg8::Gemm g{F.MIXED, F.WOUT, M, D, D}; pg8::StaticOrder S; S.init(M, D, F.G, (int)blockIdx.x);
        pg8::EpiOut E{F.XB, F.out, F.HB, F.PART};
        pg8::gemm_phase<pg8::EpiOut, pg8::StaticOrder, true, true>(F.lds, g, S, E);
        if (PROBE_DUP & 16) { __syncthreads(); pg8::gemm_phase<pg8::EpiOut, pg8::StaticOrder, true, true>(F.lds, g, S, E); }
        SEAM(4);
    }
    if (IN(5)) {
        pg8::Gemm g{F.HB, F.WGU, M, NGU, D}; pg8::StaticOrder S; S.init(M, NGU, F.G, (int)blockIdx.x);
        LAS float* rsc = (LAS float*)(F.lds + 131072 + 1024); const int rbase = (int)(blockIdx.x & 7) * 2048; const bool rs_cached = (F.G == 256);
        if (rs_cached) {
            for (int r = F.tid; r < 2048; r += NWAVES * 64) {
                const f32x4* pp = (const f32x4*)(F.PART + (size_t)(rbase + r) * 16);
                const f32x4 p0 = pp[0], p1 = pp[1], p2 = pp[2], p3 = pp[3];
                const float ssq = ((p0[0] + p0[1]) + (p0[2] + p0[3])) + ((p1[0] + p1[1]) + (p1[2] + p1[3])) + ((p2[0] + p2[1]) + (p2[2] + p2[3])) + ((p3[0] + p3[1]) + (p3[2] + p3[3]));
                rsc[r] = __builtin_amdgcn_rsqf(ssq * (1.0f / 1024.0f) + 1e-6f);
            }
            __syncthreads();
        }
        pg8::EpiGU E{F.ACT, F.PART, rs_cached ? (const LAS float*)rsc : (const LAS float*)nullptr, rbase};
        pg8::gemm_phase<pg8::EpiGU, pg8::StaticOrder, true, true>(F.lds, g, S, E);
        if (PROBE_DUP & 32) { __syncthreads(); pg8::gemm_phase<pg8::EpiGU, pg8::StaticOrder, true, true>(F.lds, g, S, E); }
        {
            const int nwg = (M / 256) * (NGU / 256), rem = nwg % F.G;
            const int first_late = (rem == 0) ? 0 : rem;
            if ((int)blockIdx.x >= first_late) { __syncthreads(); p0_weights_late(F, first_late, 1); }
        }
        SEAM(5);
    }
    if (IN(6)) {
        pg8::Gemm g{F.ACT, F.WDN, M, D, FF}; pg8::StaticOrder S; S.init(M, D, F.G, (int)blockIdx.x);
        pg8::EpiDown E{F.out, F.HB};
        pg8::gemm_phase<pg8::EpiDown, pg8::StaticOrder, true, true>(F.lds, g, S, E);
        if (PROBE_DUP & 256) { __syncthreads(); pg8::gemm_phase<pg8::EpiDown, pg8::StaticOrder, true, true>(F.lds, g, S, E); }
    }
#undef IN
#undef SEAM
}

extern "C" void kernel_launch(void* const* d_in, const int* in_sizes, int n_in, void* d_out, int out_size, void* d_ws, size_t ws_size, hipStream_t stream) {
    static int grid = 0;
    if (grid == 0) {
        if (n_in != 13 || in_sizes[0] != M * D || out_size != M * D || ws_size < WS_END) { fprintf(stderr, "kernel_launch: unexpected shapes (n_in %d, in0 %d, out %d, ws %zu)\n", n_in, n_in > 0 ? in_sizes[0] : -1, out_size, ws_size); grid = -1; return; }
        int dev = 0, cus = 0, per_cu = 0;
        if (hipGetDevice(&dev) != hipSuccess || hipDeviceGetAttribute(&cus, hipDeviceAttributeMultiprocessorCount, dev) != hipSuccess) { grid = -1; return; }
        (void)hipFuncSetAttribute((const void*)fwd<true>, hipFuncAttributeMaxDynamicSharedMemorySize, LDS_BYTES);
        (void)hipFuncSetAttribute((const void*)fwd<false>, hipFuncAttributeMaxDynamicSharedMemorySize, LDS_BYTES);
        if (hipOccupancyMaxActiveBlocksPerMultiprocessor(&per_cu, (const void*)fwd<true>, NWAVES * 64, LDS_BYTES) != hipSuccess || per_cu < 1) {
            fprintf(stderr, "kernel_launch: occupancy query reports %d blocks per CU\n", per_cu); per_cu = 1; }
        (void)hipGetLastError();
        grid = cus;
    }
    if (grid < 0) return;
    if (hipMemsetAsync((char*)d_ws + WS_CTL, 0, 65536, stream) != hipSuccess) { fprintf(stderr, "kernel_launch: memset of the barrier words failed\n"); return; }
    Args a{};
    for (int i = 0; i < 13; ++i) a.in[i] = (const float*)d_in[i];
    a.out = (float*)d_out; a.ws = (unsigned char*)d_ws;
#if MK_N_LAUNCHES == 1
    a.ph_lo = 0; a.ph_hi = N_PHASES;
    void* params[] = {&a};
    hipError_t e = hipLaunchCooperativeKernel((const void*)fwd<true>, dim3(grid), dim3(NWAVES * 64), params, LDS_BYTES, stream);
    if (e != hipSuccess) fprintf(stderr, "cooperative launch failed: %s (grid %d)\n", hipGetErrorString(e), grid);
#else
    for (int ph = 0; ph < N_PHASES; ++ph) {
        a.ph_lo = ph; a.ph_hi = ph + 1;
        hipLaunchKernelGGL(fwd<false>, dim3(grid), dim3(NWAVES * 64), LDS_BYTES, stream, a);
    }
#endif
}
```
